# Optimizing an MI355X kernel written in HIP

```python
import math
import jax
import jax.numpy as jnp
from jax import lax
import numpy as np

D_MODEL = 1024
BATCH = 16
SEQ = 4096
DEPTH = 2

HG_HEADS = 4
HG_DK = 128
HG_DV = 128
HG_K = HG_HEADS * HG_DK
HG_V = HG_HEADS * HG_DV
HG_CHUNK = 64
NSA_HEADS = 8
NSA_KV = 2
NSA_DH = 64
NSA_HPG = NSA_HEADS // NSA_KV
NSA_Q = NSA_HEADS * NSA_DH
NSA_KVW = NSA_KV * NSA_DH
CMP_BLOCK = 32
CMP_STRIDE = 16
CMP_HID = 128
SEL_BLOCK = 64
SEL_TOPK = 8
WINDOW = 512
Q_BLOCK = 128
FORCE_BONUS = 1000.0
REL_BUCKETS = 32
REL_MAX_DIST = 1024
D_FF = 4 * D_MODEL
EPS = 1e-6
NEG_BIG = -1e30

_SPLITS = (HG_K, HG_K, HG_V, HG_V, NSA_Q, NSA_KVW, NSA_KVW, NSA_KVW, NSA_KVW, NSA_KVW, NSA_KVW, 3 * NSA_HEADS, D_MODEL, D_MODEL)
IN_COLS = sum(_SPLITS)

kernel_name = "hybrid_hgrn2_nsa_block"


def rms_norm(x, gain):
    xf = x.astype(jnp.float32)
    xf = xf * lax.rsqrt(jnp.mean(xf * xf, axis=-1, keepdims=True) + EPS)
    return xf.astype(x.dtype) * gain


def rel_bucket(dist):
    max_exact = REL_BUCKETS // 2
    d = jnp.maximum(dist, 0)
    df = jnp.maximum(d, 1).astype(jnp.float32)
    large = max_exact + (jnp.log(df / max_exact) / math.log(REL_MAX_DIST / max_exact) * (REL_BUCKETS - max_exact)).astype(jnp.int32)
    return jnp.where(d < max_exact, d, jnp.minimum(large, REL_BUCKETS - 1))


def masked_softmax(s, valid, axis):
    s = jnp.where(valid, s.astype(jnp.float32), NEG_BIG)
    p = jax.nn.softmax(s, axis=axis)
    return jnp.where(valid, p, 0.0)


def hgrn2_mixer(q, f_logit, i_in, g, lb, out_gain):
    dt = q.dtype
    B, S, _ = q.shape
    nc = S // HG_CHUNK
    z = f_logit.astype(jnp.float32)
    lbf = lb.astype(jnp.float32)
    log_f = jnp.logaddexp(jnp.log(lbf), jnp.log1p(-lbf) + jax.nn.log_sigmoid(z))
    k = (1.0 - lbf) * jax.nn.sigmoid(-z)

    def chunks(t, d):
        return t.astype(jnp.float32).reshape(B, nc, HG_CHUNK, HG_HEADS, d).transpose(1, 0, 3, 2, 4)

    xs = (chunks(q, HG_DK), chunks(k, HG_DK), chunks(log_f, HG_DK), chunks(i_in, HG_DV))
    causal = jnp.tril(jnp.ones((HG_CHUNK, HG_CHUNK), dtype=bool))[:, :, None]

    def step(state, inp):
        qb, kb, gb, vb = inp
        b = jnp.cumsum(gb, axis=2)
        diff = b[:, :, :, None, :] - b[:, :, None, :, :]
        decay = jnp.exp(jnp.where(causal, diff, -jnp.inf))
        scores = jnp.einsum('bhtd,bhsd,bhtsd->bhts', qb, kb, decay)
        o = jnp.einsum('bhtd,bhdv->bhtv', qb * jnp.exp(b), state) + jnp.einsum('bhts,bhsv->bhtv', scores, vb)
        b_last = b[:, :, -1:, :]
        new_state = jnp.exp(b_last[:, :, 0, :, None]) * state + jnp.einsum('bhsd,bhsv->bhdv', kb * jnp.exp(b_last - b), vb)
        return new_state, o

    state0 = jnp.zeros((B, HG_HEADS, HG_DK, HG_DV), jnp.float32)
    _, o = lax.scan(step, state0, xs)
    o = o.transpose(1, 0, 3, 2, 4).reshape(B, S, HG_HEADS, HG_DV)
    o = rms_norm(o, out_gain.astype(jnp.float32)) * jax.nn.silu(g.astype(jnp.float32).reshape(B, S, HG_HEADS, HG_DV))
    return o.reshape(B, S, HG_V).astype(dt)


def nsa_mixer(q, k_c, v_c, k_s, v_s, k_w, v_w, gate_logit, qk_gain, cmp_pos, cmp_w1, cmp_b1, cmp_w2, rel_bias):
    dt = q.dtype
    B, S, _ = q.shape
    G, HPG, DH = NSA_KV, NSA_HPG, NSA_DH
    scale = DH ** -0.5
    q = rms_norm(q.reshape(B, S, G, HPG, DH), qk_gain[0]).transpose(0, 2, 3, 1, 4)
    gates = jax.nn.sigmoid(gate_logit.astype(jnp.float32)).reshape(B, S, G, HPG, 3).transpose(0, 2, 3, 1, 4)

    def heads(t):
        return t.reshape(B, S, G, DH).transpose(0, 2, 1, 3)

    k_s = rms_norm(heads(k_s), qk_gain[2])
    v_s = heads(v_s)
    k_w = rms_norm(heads(k_w), qk_gain[3])
    v_w = heads(v_w)

    n_cmp = (S - CMP_BLOCK) // CMP_STRIDE + 1
    cmp_tok = np.arange(n_cmp)[:, None] * CMP_STRIDE + np.arange(CMP_BLOCK)[None, :]

    def compress(t, j):
        blk = heads(t)[:, :, cmp_tok] + cmp_pos[j]
        blk = blk.reshape(B, G, n_cmp, CMP_BLOCK * DH)
        return jax.nn.gelu(blk @ cmp_w1[j] + cmp_b1[j]) @ cmp_w2[j]

    k_cmp = rms_norm(compress(k_c, 0), qk_gain[1])
    v_cmp = compress(v_c, 1)
    cmp_end = jnp.asarray(cmp_tok[:, -1], jnp.int32)

    n_sel = S // SEL_BLOCK
    sel_start = np.arange(n_sel) * SEL_BLOCK
    overlap = jnp.asarray(((cmp_tok[:, 0][:, None] < sel_start[None, :] + SEL_BLOCK) & (cmp_tok[:, -1][:, None] >= sel_start[None, :])).astype(np.float32))
    sel_start_j = jnp.asarray(sel_start, jnp.int32)
    k_blk = k_s.reshape(B, G, n_sel, SEL_BLOCK, DH)
    v_blk = v_s.reshape(B, G, n_sel, SEL_BLOCK, DH)
    n_top = min(SEL_TOPK, n_sel)
    bi = jnp.arange(B)[:, None, None, None]
    gi = jnp.arange(G)[None, :, None, None]
    g6 = jnp.arange(G)[None, :, None, None, None, None]
    h6 = jnp.arange(HPG)[None, None, :, None, None, None]
    jj = jnp.arange(n_sel, dtype=jnp.int32)

    k_wp = jnp.pad(k_w, ((0, 0), (0, 0), (WINDOW, 0), (0, 0)))
    v_wp = jnp.pad(v_w, ((0, 0), (0, 0), (WINDOW, 0), (0, 0)))
    bias_gh = rel_bias.reshape(REL_BUCKETS, G, HPG).transpose(1, 2, 0)

    def block(qi):
        start = qi * Q_BLOCK
        qb = lax.dynamic_slice_in_dim(q, start, Q_BLOCK, axis=3)
        gb = lax.dynamic_slice_in_dim(gates, start, Q_BLOCK, axis=3)
        t = start + jnp.arange(Q_BLOCK, dtype=jnp.int32)
        dist_c = t[:, None] - cmp_end[None, :]
        s_c = jnp.einsum('bghqd,bgcd->bghqc', qb, k_cmp) * scale + bias_gh[:, :, rel_bucket(dist_c)]
        p_c = masked_softmax(s_c, dist_c >= 0, -1)
        o_c = jnp.einsum('bghqc,bgcd->bghqd', p_c, v_cmp)
        imp = jnp.einsum('bghqc,cj->bgqj', p_c, overlap)
        j_cur = t // SEL_BLOCK
        forced = (jj[None, :] == 0) | (jj[None, :] == j_cur[:, None]) | (jj[None, :] == j_cur[:, None] - 1)
        imp = jnp.where(sel_start_j[None, :] <= t[:, None], imp + FORCE_BONUS * forced, -1.0)
        _, idx = lax.top_k(imp, n_top)
        k_g = k_blk[bi, gi, idx]
        v_g = v_blk[bi, gi, idx]
        pos = idx[..., None] * SEL_BLOCK + jnp.arange(SEL_BLOCK, dtype=jnp.int32)
        dist_s = t[None, None, :, None, None] - pos
        bias_s = bias_gh[g6, h6, rel_bucket(dist_s)[:, :, None]]
        s_s = jnp.einsum('bghqd,bgqnkd->bghqnk', qb, k_g) * scale + bias_s
        p_s = masked_softmax(s_s, (dist_s >= 0)[:, :, None], (-2, -1))
        o_s = jnp.einsum('bghqnk,bgqnkd->bghqd', p_s, v_g)
        kw = lax.dynamic_slice_in_dim(k_wp, start, WINDOW + Q_BLOCK, axis=2)
        vw = lax.dynamic_slice_in_dim(v_wp, start, WINDOW + Q_BLOCK, axis=2)
        key_pos = start - WINDOW + jnp.arange(WINDOW + Q_BLOCK, dtype=jnp.int32)
        dist_w = t[:, None] - key_pos[None, :]
        valid_w = (dist_w >= 0) & (dist_w < WINDOW) & (key_pos[None, :] >= 0)
        s_w = jnp.einsum('bghqd,bgkd->bghqk', qb, kw) * scale + bias_gh[:, :, rel_bucket(dist_w)]
        p_w = masked_softmax(s_w, valid_w, -1)
        o_w = jnp.einsum('bghqk,bgkd->bghqd', p_w, vw)
        return gb[..., 0:1] * o_c + gb[..., 1:2] * o_s + gb[..., 2:3] * o_w

    out = lax.map(block, jnp.arange(S // Q_BLOCK))
    return out.transpose(1, 0, 4, 2, 3, 5).reshape(B, S, NSA_Q).astype(dt)


def setup_inputs(seed: int = 0) -> dict:
    key = jax.random.key(seed)
    ks = jax.random.split(key, 17)
    f32 = jnp.float32

    def nrm(k, shape, scale):
        return jax.random.normal(k, shape, f32) * scale

    def gain(k, shape):
        return 1.0 + 0.02 * jax.random.normal(k, shape, f32)

    return {
        "x": nrm(ks[0], (BATCH, SEQ, D_MODEL), 1.0),
        "rel_bias": nrm(ks[1], (REL_BUCKETS, NSA_HEADS), 0.5),
        "hg_lb_logits": nrm(ks[2], (DEPTH, HG_K), 0.5),
        "norm_mix": gain(ks[3], (DEPTH, D_MODEL)),
        "w_in": nrm(ks[4], (DEPTH, D_MODEL, IN_COLS), D_MODEL ** -0.5),
        "hg_out_gain": gain(ks[5], (DEPTH, HG_DV)),
        "nsa_qk_gain": gain(ks[6], (DEPTH, 4, NSA_DH)),
        "cmp_pos": nrm(ks[7], (DEPTH, 2, CMP_BLOCK, NSA_DH), 0.02),
        "cmp_w1": nrm(ks[8], (DEPTH, 2, CMP_BLOCK * NSA_DH, CMP_HID), (CMP_BLOCK * NSA_DH) ** -0.5),
        "cmp_b1": nrm(ks[9], (DEPTH, 2, CMP_HID), 0.01),
        "cmp_w2": nrm(ks[10], (DEPTH, 2, CMP_HID, NSA_DH), CMP_HID ** -0.5),
        "w_branch_a": nrm(ks[11], (DEPTH, HG_V, D_MODEL), HG_V ** -0.5),
        "w_branch_b": nrm(ks[12], (DEPTH, NSA_Q, D_MODEL), NSA_Q ** -0.5),
        "w_out": nrm(ks[13], (DEPTH, D_MODEL, D_MODEL), D_MODEL ** -0.5),
        "norm_mlp": gain(ks[14], (DEPTH, D_MODEL)),
        "w_up": nrm(ks[15], (DEPTH, D_MODEL, D_FF), D_MODEL ** -0.5),
        "w_down": nrm(ks[16], (DEPTH, D_FF, D_MODEL), 0.5 * D_FF ** -0.5),
    }


def reference(x, rel_bias, hg_lb_logits, norm_mix, w_in, hg_out_gain, nsa_qk_gain, cmp_pos, cmp_w1, cmp_b1, cmp_w2, w_branch_a, w_branch_b, w_out, norm_mlp, w_up, w_down):
    lb_cum = jnp.cumsum(jax.nn.softmax(hg_lb_logits.astype(jnp.float32), axis=0), axis=0)
    lower_bounds = lb_cum - lb_cum[0:1]
    offsets = np.cumsum(_SPLITS)[:-1].tolist()
    for l in range(DEPTH):
        h = rms_norm(x, norm_mix[l])
        (hq, hf, hi, hg, nq, kc, vc, ksl, vsl, kwn, vwn, ngate, gate_a, gate_b) = jnp.split(h @ w_in[l], offsets, axis=-1)
        y_a = hgrn2_mixer(hq, hf, hi, hg, lower_bounds[l], hg_out_gain[l]) @ w_branch_a[l]
        y_b = nsa_mixer(nq, kc, vc, ksl, vsl, kwn, vwn, ngate, nsa_qk_gain[l], cmp_pos[l], cmp_w1[l], cmp_b1[l], cmp_w2[l], rel_bias) @ w_branch_b[l]
        mixed = jax.nn.sigmoid(gate_a) * y_a + jax.nn.sigmoid(gate_b) * y_b
        x = x + mixed @ w_out[l]
        h = rms_norm(x, norm_mlp[l])
        x = x + jnp.square(jax.nn.relu(h @ w_up[l])) @ w_down[l]
    return x
```

```cpp
#include <hip/hip_runtime.h>
#include <hip/hip_cooperative_groups.h>
#include <cstdio>
#include <cstdint>
namespace cg = cooperative_groups;
namespace pg8 {
#define PG8_LAS __attribute__((address_space(3)))
typedef unsigned short bf16_t;
typedef short bf16x8 __attribute__((ext_vector_type(8)));
typedef float f32x4 __attribute__((ext_vector_type(4)));
typedef unsigned u32x4 __attribute__((ext_vector_type(4)));
constexpr int BM = 256, BK = 64, HALF = 128, HTB = HALF * BK * 2  , STAGE_BYTES = 8 * HTB, NXCD = 8, WGM = 8;

__host__ __device__ __forceinline__ int lds_byte(int r, int c) { const int st = (r >> 4) * 2 + (c >> 5), rr = r & 15, cc = c & 31, ob = rr * 64 + cc * 2; return st * 1024 + (ob ^ (((ob >> 9) & 1) << 5)); }
__host__ __device__ __forceinline__ void stage_rc(int b, int& R, int& C) { const int st = b / 1024, sb = b % 1024, swz = sb ^ (((sb >> 9) & 1) << 5); R = (st >> 1) * 16 + swz / 64; C = (st & 1) * 32 + (swz % 64) / 2; }
__host__ __device__ __forceinline__ int perm32(int rho) { const int n = rho >> 4, i = rho & 15; return 8 * (i >> 2) + 4 * n + (i & 3); }

struct Unit { int pm, pn; };
struct Gemm { const bf16_t* A; const bf16_t* Bt; int M, N, K; };

struct StaticOrder {
    int nM, nN, nwg, G, c;
    __host__ __device__ void init(int M, int N, int G_, int c_) { nM = M / BM; nN = N / BM; nwg = nM * nN; G = G_; c = c_; }
    __host__ __device__ bool next(int i, Unit& u) const {
        const long L = (long)i * G + c; if (L >= nwg) return false;
        int wgid = (int)L; { const int q = nwg / NXCD, r = nwg % NXCD, xcd = wgid % NXCD, off = wgid / NXCD; wgid = (xcd < r ? xcd * (q + 1) : r * (q + 1) + (xcd - r) * q) + off; }
        const int nig = WGM * nN, gid = wgid / nig, fm = gid * WGM, gsz = (nM - fm) < WGM ? (nM - fm) : WGM;
        u.pm = fm + ((wgid % nig) % gsz); u.pn = (wgid % nig) / gsz; return true;
    }
    __device__ __forceinline__ void a_ready(const Unit&) const {}
    __device__ __forceinline__ void done(const Unit&) const {}
};

typedef float f32x2c __attribute__((ext_vector_type(2)));
typedef __bf16 bf16x2c __attribute__((ext_vector_type(2)));
__device__ __forceinline__ unsigned cvt_pk_bf16(float lo, float hi) { const f32x2c v = {lo, hi}; const bf16x2c b = __builtin_convertvector(v, bf16x2c); return __builtin_bit_cast(unsigned, b); }
__device__ __forceinline__ float bf_lo(unsigned w) { return __uint_as_float(w << 16); }
__device__ __forceinline__ float bf_hi(unsigned w) { return __uint_as_float(w & 0xffff0000u); }
__device__ __forceinline__ float sigm(float v) { return 1.0f / (1.0f + __expf(-v)); }

__device__ __forceinline__ void row_rstd8(const float* sumsq, const Unit& u, int wr, int fr, int fq, float (&rs)[2][4]) {
#pragma unroll
    for (int ai = 0; ai < 2; ++ai)
#pragma unroll
        for (int m = 0; m < 4; ++m) {
            const int row = u.pm * BM + ai * HALF + wr * 64 + m * 16 + fr;
            const f32x4 v = *(const f32x4*)(sumsq + (size_t)row * 16 + fq * 4);
            float s = (v[0] + v[1]) + (v[2] + v[3]);
            s += __shfl_xor(s, 16); s += __shfl_xor(s, 32);
            rs[ai][m] = rsqrtf(s * (1.0f / 1024.0f) + 1e-6f);
            if (m == 3) asm volatile("" ::: "memory");
        }
}

struct EpiIn {
    static constexpr bool PERM = true, AFTER_DRAIN = false;
    const float* sumsq; bf16_t *HQ, *NQ, *KV, *NG, *SGA, *VST, *VWT;
    __device__ __forceinline__ void operator()(const f32x4 (&acc)[2][2][4][2], const Unit& u, int wr, int wc, int fr, int fq) const {
        float rs[2][4]; row_rstd8(sumsq, u, wr, fr, fq, rs);
        const int pn = u.pn; bf16_t* base; int ldc, colt; bool sg = false;
        if (pn < 8) { base = HQ + (size_t)(pn >> 1) * ((size_t)65536 * 512); ldc = 512; colt = (pn & 1) * 256; }
        else if (pn < 10) { base = NQ; ldc = 512; colt = (pn - 8) * 256; }
        else if (pn < 13) { base = KV; ldc = 768; colt = (pn - 10) * 256; }
        else if (pn == 13) { base = NG; ldc = 256; colt = 0; sg = true; }
        else { const int q = pn - 14; base = SGA + (size_t)(q >> 2) * ((size_t)65536 * 1024); ldc = 1024; colt = (q & 3) * 256; sg = true; }
        const int col0 = colt + wc * 32 + 8 * fq;
        bf16_t* vt = (pn == 11) ? VST : ((pn == 12) ? VWT : nullptr);
#pragma unroll
        for (int ai = 0; ai < 2; ++ai)
#pragma unroll
            for (int m = 0; m < 4; ++m) {
                const int row = u.pm * BM + ai * HALF + wr * 64 + m * 16 + fr;
                bf16_t* rowp = base + (size_t)row * ldc + col0; const float r = rs[ai][m];
#pragma unroll
                for (int bj = 0; bj < 2; ++bj) {
                    f32x4 v0 = acc[ai][bj][m][0] * r, v1 = acc[ai][bj][m][1] * r;
                    if (sg) {
#pragma unroll
                        for (int e = 0; e < 4; ++e) { v0[e] = sigm(v0[e]); v1[e] = sigm(v1[e]); }
                    }
                    u32x4 w; w.x = cvt_pk_bf16(v0[0], v0[1]); w.y = cvt_pk_bf16(v0[2], v0[3]); w.z = cvt_pk_bf16(v1[0], v1[1]); w.w = cvt_pk_bf16(v1[2], v1[3]);
                    *(u32x4*)(rowp + bj * HALF) = w;
                    if (vt != nullptr && bj == 1) {
                        const int cv = wc * 32 + 8 * fq, g = cv >> 6, d0 = cv & 63, b = row >> 12, t = row & 4095;
                        bf16_t* tp = vt + (((size_t)(b * 2 + g) * 64 + d0) << 12) + t;
                        tp[0 * 4096] = (bf16_t)(w.x & 0xffffu); tp[1 * 4096] = (bf16_t)(w.x >> 16); tp[2 * 4096] = (bf16_t)(w.y & 0xffffu); tp[3 * 4096] = (bf16_t)(w.y >> 16);
                        tp[4 * 4096] = (bf16_t)(w.z & 0xffffu); tp[5 * 4096] = (bf16_t)(w.z >> 16); tp[6 * 4096] = (bf16_t)(w.w & 0xffffu); tp[7 * 4096] = (bf16_t)(w.w >> 16);
                    }
                }
                asm volatile("" ::: "memory");
            }
    }
};

template <bool ACCUM> struct EpiMix {
    static constexpr bool PERM = true, AFTER_DRAIN = false;
    const bf16_t* gate; bf16_t* mixed;
    __device__ __forceinline__ void operator()(const f32x4 (&acc)[2][2][4][2], const Unit& u, int wr, int wc, int fr, int fq) const {
        const int col0 = u.pn * BM + wc * 32 + 8 * fq;
#pragma unroll
        for (int ai = 0; ai < 2; ++ai)
#pragma unroll
            for (int m = 0; m < 4; ++m) {
                const size_t off = (size_t)(u.pm * BM + ai * HALF + wr * 64 + m * 16 + fr) * 1024 + col0;
#pragma unroll
                for (int bj = 0; bj < 2; ++bj) {
                    const u32x4 gq = *(const u32x4*)(gate + off + bj * HALF);
                    f32x4 v0 = acc[ai][bj][m][0], v1 = acc[ai][bj][m][1];
                    v0[0] *= bf_lo(gq.x); v0[1] *= bf_hi(gq.x); v0[2] *= bf_lo(gq.y); v0[3] *= bf_hi(gq.y);
                    v1[0] *= bf_lo(gq.z); v1[1] *= bf_hi(gq.z); v1[2] *= bf_lo(gq.w); v1[3] *= bf_hi(gq.w);
                    if (ACCUM) {
                        const u32x4 mq = *(const u32x4*)(mixed + off + bj * HALF);
                        v0[0] += bf_lo(mq.x); v0[1] += bf_hi(mq.x); v0[2] += bf_lo(mq.y); v0[3] += bf_hi(mq.y);
                        v1[0] += bf_lo(mq.z); v1[1] += bf_hi(mq.z); v1[2] += bf_lo(mq.w); v1[3] += bf_hi(mq.w);
                    }
                    u32x4 w; w.x = cvt_pk_bf16(v0[0], v0[1]); w.y = cvt_pk_bf16(v0[2], v0[3]); w.z = cvt_pk_bf16(v1[0], v1[1]); w.w = cvt_pk_bf16(v1[2], v1[3]);
                    *(u32x4*)(mixed + off + bj * HALF) = w;
                }
                asm volatile("" ::: "memory");
            }
    }
};

struct EpiRes {
    static constexpr bool PERM = true, AFTER_DRAIN = false;
    const float* xres; float* out; bf16_t* xb; float* sumsq;
    __device__ __forceinline__ void operator()(const f32x4 (&acc)[2][2][4][2], const Unit& u, int wr, int wc, int fr, int fq) const {
        const int col0 = u.pn * BM + wc * 32 + 8 * fq;
#pragma unroll
        for (int ai = 0; ai < 2; ++ai)
#pragma unroll
            for (int m = 0; m < 4; ++m) {
                const int row = u.pm * BM + ai * HALF + wr * 64 + m * 16 + fr;
                const size_t off = (size_t)row * 1024 + col0; float ss = 0.f;
#pragma unroll
                for (int bj = 0; bj < 2; ++bj) {
                    const f32x4 x0 = *(const f32x4*)(xres + off + bj * HALF), x1 = *(const f32x4*)(xres + off + bj * HALF + 4);
                    const f32x4 v0 = acc[ai][bj][m][0] + x0, v1 = acc[ai][bj][m][1] + x1;
                    *(f32x4*)(out + off + bj * HALF) = v0; *(f32x4*)(out + off + bj * HALF + 4) = v1;
                    u32x4 w; w.x = cvt_pk_bf16(v0[0], v0[1]); w.y = cvt_pk_bf16(v0[2], v0[3]); w.z = cvt_pk_bf16(v1[0], v1[1]); w.w = cvt_pk_bf16(v1[2], v1[3]);
                    *(u32x4*)(xb + off + bj * HALF) = w;
                    ss += (v0[0] * v0[0] + v0[1] * v0[1]) + (v0[2] * v0[2] + v0[3] * v0[3]) + (v1[0] * v1[0] + v1[1] * v1[1]) + (v1[2] * v1[2] + v1[3] * v1[3]);
                }
                ss += __shfl_xor(ss, 16); ss += __shfl_xor(ss, 32);
                if (fq == 0) sumsq[(size_t)row * 16 + u.pn * 4 + wc] = ss;
                asm volatile("" ::: "memory");
            }
    }
};

struct EpiUp {
    static constexpr bool PERM = true, AFTER_DRAIN = false;
    const float* sumsq; bf16_t* hid;
    __device__ __forceinline__ void operator()(const f32x4 (&acc)[2][2][4][2], const Unit& u, int wr, int wc, int fr, int fq) const {
        float rs[2][4]; row_rstd8(sumsq, u, wr, fr, fq, rs);
        const int col0 = u.pn * BM + wc * 32 + 8 * fq;
#pragma unroll
        for (int ai = 0; ai < 2; ++ai)
#pragma unroll
            for (int m = 0; m < 4; ++m) {
                bf16_t* rowp = hid + (size_t)(u.pm * BM + ai * HALF + wr * 64 + m * 16 + fr) * 4096 + col0; const float r = rs[ai][m];
#pragma unroll
                for (int bj = 0; bj < 2; ++bj) {
                    f32x4 v0 = acc[ai][bj][m][0] * r, v1 = acc[ai][bj][m][1] * r;
#pragma unroll
                    for (int e = 0; e < 4; ++e) { const float a = fmaxf(v0[e], 0.f), b = fmaxf(v1[e], 0.f); v0[e] = a * a; v1[e] = b * b; }
                    u32x4 w; w.x = cvt_pk_bf16(v0[0], v0[1]); w.y = cvt_pk_bf16(v0[2], v0[3]); w.z = cvt_pk_bf16(v1[0], v1[1]); w.w = cvt_pk_bf16(v1[2], v1[3]);
                    *(u32x4*)(rowp + bj * HALF) = w;
                }
                asm volatile("" ::: "memory");
            }
    }
};

template <class Epi, class Sched, bool ALIGN_EPI = false, bool SP2 = false>
__device__ __forceinline__ void gemm_phase(PG8_LAS unsigned char* lds, const Gemm g, const Sched& S, const Epi& E) {
    int tid_ = threadIdx.x; asm volatile("" : "+v"(tid_));
    const int tid = tid_, wid = __builtin_amdgcn_readfirstlane(tid >> 6), lane = tid & 63, wr = wid >> 2, wc = wid & 3, fr = lane & 15, fq = lane >> 4;
    const int K = g.K, nt = K / BK;
    unsigned voffA[2], voffB[2];
#pragma unroll
    for (int i = 0; i < 2; ++i) { int R, C; stage_rc(tid * 16 + i * 8192, R, C); const int Rb = Epi::PERM ? ((R & ~31) + perm32(R & 31)) : R;
        voffA[i] = (unsigned)(R * K + C) * 2u; voffB[i] = (unsigned)(Rb * K + C) * 2u; }
    const size_t kstep = (size_t)(BK * 2);
    const size_t hstep = (size_t)HALF * K * 2;
    const size_t tstep = 2 * hstep;
    const unsigned ldsw = (unsigned)wid * 1024u;
    const int aoff = lds_byte(wr * 64 + fr, fq * 8), boff = lds_byte(wc * 32 + fr, fq * 8);
#define PG8_SA(b, h) (((b) * 2 + (h)) * HTB)
#define PG8_SB(b, h) ((4 + (b) * 2 + (h)) * HTB)
#define PG8_STAGE(bufoff, gbase, voff) do { _Pragma("unroll") for (int _i = 0; _i < 2; ++_i) \
        __builtin_amdgcn_global_load_lds((const unsigned*)((const char*)(gbase) + (voff)[_i]), (PG8_LAS unsigned*)(lds + (bufoff) + ldsw + _i * 8192), 16, 0, 0); } while (0)
#define PG8_LDA(dst, b, h) do { _Pragma("unroll") for (int m = 0; m < 4; ++m) _Pragma("unroll") for (int k = 0; k < 2; ++k) dst[m][k] = *(const PG8_LAS bf16x8*)(lds + PG8_SA(b, h) + aoff + m * 2048 + k * 1024); } while (0)
#define PG8_LDB(dst, b, h) do { _Pragma("unroll") for (int n = 0; n < 2; ++n) _Pragma("unroll") for (int k = 0; k < 2; ++k) dst[n][k] = *(const PG8_LAS bf16x8*)(lds + PG8_SB(b, h) + boff + n * 2048 + k * 1024); } while (0)
#define PG8_MMA(ai, bj, At, Bt) do { __builtin_amdgcn_s_setprio(1); _Pragma("unroll") for (int m = 0; m < 4; ++m) _Pragma("unroll") for (int n = 0; n < 2; ++n) _Pragma("unroll") for (int k = 0; k < 2; ++k) \
        acc[ai][bj][m][n] = __builtin_amdgcn_mfma_f32_16x16x32_bf16(Bt[n][k], At[m][k], acc[ai][bj][m][n], 0, 0, 0); __builtin_amdgcn_s_setprio(0); } while (0)
#define PG8_WAIT_V(n) asm volatile("s_waitcnt vmcnt(" #n ")" ::: "memory")
#define PG8_WAIT_L(n) asm volatile("s_waitcnt lgkmcnt(" #n ")" ::: "memory")
#define PG8_BAR __builtin_amdgcn_s_barrier()
#define PG8_SCHED __builtin_amdgcn_sched_barrier(0)
    Unit cur, nxt; int ui = 0;
    if (!S.next(0, cur)) return;
    f32x4 acc[2][2][4][2];
#pragma unroll
    for (int a = 0; a < 2; ++a)
#pragma unroll
        for (int b = 0; b < 2; ++b)
#pragma unroll
            for (int m = 0; m < 4; ++m)
#pragma unroll
                for (int n = 0; n < 2; ++n) acc[a][b][m][n] = (f32x4){0.f, 0.f, 0.f, 0.f};
    bf16x8 At[4][2], B0[2][2], B1[2][2];
    const char* cA = (const char*)g.A + (size_t)cur.pm * tstep; const char* cB = (const char*)g.Bt + (size_t)cur.pn * tstep;
    S.a_ready(cur);
    if constexpr (SP2) {
        PG8_STAGE(PG8_SB(0, 0), cB, voffB); PG8_STAGE(PG8_SB(0, 1), cB + hstep, voffB); PG8_STAGE(PG8_SA(0, 0), cA, voffA); PG8_STAGE(PG8_SA(0, 1), cA + hstep, voffA);
        if (wr == 1) PG8_BAR;
        PG8_WAIT_V(2); PG8_BAR;
        PG8_STAGE(PG8_SB(1, 0), cB + kstep, voffB); PG8_STAGE(PG8_SA(1, 0), cA + kstep, voffA); PG8_STAGE(PG8_SB(1, 1), cB + hstep + kstep, voffB);
        PG8_WAIT_V(6); PG8_BAR;
    } else {
        PG8_STAGE(PG8_SB(0, 0), cB, voffB); PG8_STAGE(PG8_SA(0, 0), cA, voffA); PG8_STAGE(PG8_SB(0, 1), cB + hstep, voffB); PG8_STAGE(PG8_SA(0, 1), cA + hstep, voffA);
        if (wr == 1) PG8_BAR;
        PG8_WAIT_V(4); PG8_BAR;
        PG8_STAGE(PG8_SB(1, 0), cB + kstep, voffB); PG8_STAGE(PG8_SA(1, 0), cA + kstep, voffA); PG8_STAGE(PG8_SB(1, 1), cB + hstep + kstep, voffB);
        PG8_WAIT_V(6); PG8_BAR;
    }
    for (;;) {
        const bool has_next = S.next(ui + 1, nxt);
        const char* nA = has_next ? (const char*)g.A + (size_t)nxt.pm * tstep : cA; const char* nB = has_next ? (const char*)g.Bt + (size_t)nxt.pn * tstep : cB;
        for (int t = 0; t < nt; t += 2) {
            const bool last = (t == nt - 2);
            const char* a1 = cA + (size_t)(t + 1) * kstep;
            const char* a2 = last ? nA : cA + (size_t)(t + 2) * kstep; const char* b2 = last ? nB : cB + (size_t)(t + 2) * kstep;
            const char* a3 = a2 + kstep; const char* b3 = b2 + kstep;
            if (last && has_next) S.a_ready(nxt);
            if constexpr (SP2) {
            PG8_LDB(B0, 0, 0); PG8_LDB(B1, 0, 1); PG8_SCHED; PG8_LDA(At, 0, 0); PG8_STAGE(PG8_SA(1, 1), a1 + hstep, voffA);
            PG8_WAIT_V(8); PG8_WAIT_L(0); PG8_BAR; PG8_MMA(0, 0, At, B0); PG8_MMA(0, 1, At, B1); PG8_BAR; PG8_SCHED;
            PG8_LDA(At, 0, 1); PG8_STAGE(PG8_SB(0, 0), b2, voffB); PG8_STAGE(PG8_SB(0, 1), b2 + hstep, voffB); PG8_STAGE(PG8_SA(0, 0), a2, voffA);
            PG8_WAIT_V(8); PG8_WAIT_L(0); PG8_BAR; PG8_MMA(1, 0, At, B0); PG8_MMA(1, 1, At, B1); PG8_BAR; PG8_SCHED;
            PG8_LDB(B0, 1, 0); PG8_LDB(B1, 1, 1); PG8_SCHED; PG8_LDA(At, 1, 0); PG8_STAGE(PG8_SA(0, 1), a2 + hstep, voffA);
            PG8_WAIT_V(8); PG8_WAIT_L(0); PG8_BAR; PG8_MMA(0, 0, At, B0); PG8_MMA(0, 1, At, B1); PG8_BAR; PG8_SCHED;
            PG8_LDA(At, 1, 1); PG8_STAGE(PG8_SB(1, 0), b3, voffB); PG8_STAGE(PG8_SB(1, 1), b3 + hstep, voffB); PG8_STAGE(PG8_SA(1, 0), a3, voffA);
            PG8_WAIT_V(8); PG8_WAIT_L(0); PG8_BAR; PG8_MMA(1, 0, At, B0); PG8_MMA(1, 1, At, B1); PG8_BAR; PG8_SCHED;
            } else {
            PG8_LDB(B0, 0, 0); PG8_SCHED; PG8_LDA(At, 0, 0); PG8_STAGE(PG8_SA(1, 1), a1 + hstep, voffA);
            PG8_WAIT_L(8); PG8_BAR; PG8_WAIT_L(0); PG8_MMA(0, 0, At, B0); PG8_BAR; PG8_SCHED;
            PG8_LDB(B1, 0, 1); PG8_STAGE(PG8_SB(0, 0), b2, voffB);
            PG8_BAR; PG8_WAIT_L(0); PG8_MMA(0, 1, At, B1); PG8_BAR;
            PG8_LDA(At, 0, 1); PG8_STAGE(PG8_SA(0, 0), a2, voffA);
            PG8_BAR; PG8_WAIT_L(0); PG8_MMA(1, 0, At, B0); PG8_BAR; PG8_SCHED;
            PG8_STAGE(PG8_SB(0, 1), b2 + hstep, voffB);
            PG8_WAIT_V(6); PG8_BAR; PG8_MMA(1, 1, At, B1); PG8_BAR;
            PG8_LDB(B0, 1, 0); PG8_SCHED; PG8_LDA(At, 1, 0); PG8_STAGE(PG8_SA(0, 1), a2 + hstep, voffA);
            PG8_WAIT_L(8); PG8_BAR; PG8_WAIT_L(0); PG8_MMA(0, 0, At, B0); PG8_BAR; PG8_SCHED;
            PG8_LDB(B1, 1, 1); PG8_STAGE(PG8_SB(1, 0), b3, voffB);
            PG8_BAR; PG8_WAIT_L(0); PG8_MMA(0, 1, At, B1); PG8_BAR;
            PG8_LDA(At, 1, 1); PG8_STAGE(PG8_SA(1, 0), a3, voffA);
            PG8_BAR; PG8_WAIT_L(0); PG8_MMA(1, 0, At, B0); PG8_BAR; PG8_SCHED;
            PG8_STAGE(PG8_SB(1, 1), b3 + hstep, voffB);
            PG8_WAIT_V(6); PG8_BAR; PG8_MMA(1, 1, At, B1); PG8_BAR;
            }
        }
        if constexpr (ALIGN_EPI) { if (wr == 0) PG8_BAR; }
        if constexpr (!Epi::AFTER_DRAIN) { E(acc, cur, wr, wc, fr, fq); S.done(cur); }
        if (!has_next) break;
#pragma unroll
        for (int a = 0; a < 2; ++a)
#pragma unroll
            for (int b = 0; b < 2; ++b)
#pragma unroll
                for (int m = 0; m < 4; ++m)
#pragma unroll
                    for (int n = 0; n < 2; ++n) acc[a][b][m][n] = (f32x4){0.f, 0.f, 0.f, 0.f};
        cur = nxt; cA = nA; cB = nB; ++ui;
        if constexpr (ALIGN_EPI) { if (wr == 1) PG8_BAR; }
    }
    PG8_WAIT_V(0);
    if constexpr (!ALIGN_EPI) { if (wr == 0) PG8_BAR; }
    PG8_BAR;
    if constexpr (Epi::AFTER_DRAIN) { E.fused(acc, cur, wr, wc, fr, fq, lds, wid, lane); S.done(cur); }
#undef PG8_SA
#undef PG8_SB
#undef PG8_STAGE
#undef PG8_LDA
#undef PG8_LDB
#undef PG8_MMA
#undef PG8_WAIT_V
#undef PG8_WAIT_L
#undef PG8_BAR
#undef PG8_SCHED
}
}

#define LAS __attribute__((address_space(3)))
typedef unsigned short bf16_t;
typedef short bf16x8 __attribute__((ext_vector_type(8)));
typedef short bf16x4 __attribute__((ext_vector_type(4)));
typedef float f32x4 __attribute__((ext_vector_type(4)));
typedef unsigned u32x4 __attribute__((ext_vector_type(4)));
typedef unsigned u32x2 __attribute__((ext_vector_type(2)));
using pg8::cvt_pk_bf16; using pg8::bf_lo; using pg8::bf_hi; using pg8::sigm;

constexpr int T_TOK = 65536, DM = 1024, SEQ = 4096, NB = 16, DFF = 4096, NP_IN = 5632, IN_COLS = 5400;
constexpr int LDS_BYTES = 147456;
constexpr size_t MiB = (size_t)1 << 20;
constexpr size_t WS_CBIAS = 1 * MiB, WS_CW2T = 1 * MiB + 65536;
constexpr size_t WS_WIN = 2 * MiB, WS_WA = 24 * MiB, WS_WB = 26 * MiB, WS_WO = 28 * MiB, WS_WUP = 32 * MiB, WS_WDN = 48 * MiB, WS_CW1T = 64 * MiB;
constexpr size_t WS_SUMSQ = 66 * MiB, WS_KCMP = 70 * MiB, WS_VCMPT = 71 * MiB, WS_VST = 72 * MiB, WS_VWT = 88 * MiB, WS_XB = 104 * MiB;
constexpr size_t WS_HQ = 232 * MiB, WS_HF = 296 * MiB, WS_HI = 360 * MiB, WS_HG = 424 * MiB, WS_NQ = 488 * MiB, WS_KV = 552 * MiB, WS_NG = 648 * MiB, WS_SGA = 680 * MiB, WS_SGB = 808 * MiB;
constexpr size_t WS_MIXED = 232 * MiB, WS_HID = 232 * MiB, WS_EX = 936 * MiB, WS_END = 942 * MiB;
constexpr size_t EX_H = 0, EX_PP = 1 * MiB, EX_OAB = 2 * MiB + 524288, EX_YP = EX_OAB + 65536, EX_XP = EX_OAB + 524288, EX_UP = 3 * MiB + 524288, EX_DP = 4 * MiB + 524288;

struct Params {
    const float *x, *rel_bias, *lb_logits, *norm_mix, *w_in, *hg_gain, *qk_gain, *cmp_pos, *cmp_w1, *cmp_b1, *cmp_w2, *w_a, *w_b, *w_out, *norm_mlp, *w_up, *w_down;
    float* out; unsigned char* ws; int ph_lo, ph_hi;
};

__device__ __forceinline__ bf16x8 lds_ld8(const LAS unsigned char* p) { return *(const LAS bf16x8*)p; }
__device__ __forceinline__ bf16x8 lds_ld4x2(const LAS unsigned char* p0, const LAS unsigned char* p1) {
    const bf16x4 a = *(const LAS bf16x4*)p0, b = *(const LAS bf16x4*)p1; bf16x8 r;
    r[0] = a[0]; r[1] = a[1]; r[2] = a[2]; r[3] = a[3]; r[4] = b[0]; r[5] = b[1]; r[6] = b[2]; r[7] = b[3]; return r;
}
__device__ __forceinline__ bf16x8 pack8(const f32x4& a, const f32x4& b) {
    u32x4 w; w.x = cvt_pk_bf16(a[0], a[1]); w.y = cvt_pk_bf16(a[2], a[3]); w.z = cvt_pk_bf16(b[0], b[1]); w.w = cvt_pk_bf16(b[2], b[3]);
    return __builtin_bit_cast(bf16x8, w);
}
__device__ __forceinline__ unsigned short bf1(float v) { return (unsigned short)(cvt_pk_bf16(v, 0.f) & 0xffffu); }
__device__ __forceinline__ float bfu(unsigned short h) { return __uint_as_float(((unsigned)h) << 16); }
__device__ __forceinline__ int tid_opaque() { int t = threadIdx.x; asm volatile("" : "+v"(t)); return t; }
#define MFMA16(a, b, c) __builtin_amdgcn_mfma_f32_16x16x32_bf16((a), (b), (c), 0, 0, 0)

__device__ __forceinline__ float block_sum(float v, LAS float* red, int tid);
__device__ __forceinline__ void conv_matrix(const float* W, int K, int N, bf16_t* WT, const float* scale, int nshift_from, int nshift, LAS unsigned char* lds) {
    LAS float* tile = (LAS float*)lds;
    const int tid = tid_opaque(), nnb = (N + 63) / 64, items = (K / 64) * nnb;
#pragma unroll 1
    for (int it = blockIdx.x; it < items; it += gridDim.x) {
        const int kb = it / nnb, nb = it % nnb, k0 = kb * 64, n0 = nb * 64;
#pragma unroll
        for (int i = 0; i < 8; ++i) {
            const int k = i * 8 + (tid >> 6), n = tid & 63;
            float v = 0.f;
            if (n0 + n < N) { v = W[(size_t)(k0 + k) * N + n0 + n]; if (scale) v *= scale[k0 + k]; }
            tile[k * 65 + n] = v;
        }
        __syncthreads();
        {
            const int n = tid >> 3, kc = tid & 7;
            if (n0 + n < N) {
                const LAS float* s = tile + (kc * 8) * 65 + n;
                u32x4 o; o.x = cvt_pk_bf16(s[0], s[65]); o.y = cvt_pk_bf16(s[2 * 65], s[3 * 65]); o.z = cvt_pk_bf16(s[4 * 65], s[5 * 65]); o.w = cvt_pk_bf16(s[6 * 65], s[7 * 65]);
                int nn = n0 + n; if (nn >= nshift_from) nn += nshift;
                *(u32x4*)(WT + (size_t)nn * K + k0 + kc * 8) = o;
            }
        }
        __syncthreads();
    }
}

__device__ __forceinline__ void prologue(const Params& p, LAS unsigned char* lds) {
    unsigned char* ws = p.ws;
    const int tid = tid_opaque(), lane = tid & 63, wave = tid >> 6;
#pragma unroll 1
    for (int mj = 0; mj < 20; ++mj) {
        const int l = mj / 10, m = mj % 10;
        const float* W; int K, N; bf16_t* WT; const float* scale = nullptr; int sfrom = 1 << 30, sh = 0;
        if (m == 0) { W = p.w_in + (size_t)l * DM * IN_COLS; K = DM; N = IN_COLS; WT = (bf16_t*)(ws + WS_WIN) + (size_t)l * NP_IN * DM; scale = p.norm_mix + l * DM; sfrom = 3352; sh = 232; }
        else if (m == 1) { W = p.w_a + (size_t)l * 512 * DM; K = 512; N = DM; WT = (bf16_t*)(ws + WS_WA) + (size_t)l * DM * 512; }
        else if (m == 2) { W = p.w_b + (size_t)l * 512 * DM; K = 512; N = DM; WT = (bf16_t*)(ws + WS_WB) + (size_t)l * DM * 512; }
        else if (m == 3) { W = p.w_out + (size_t)l * DM * DM; K = DM; N = DM; WT = (bf16_t*)(ws + WS_WO) + (size_t)l * DM * DM; }
        else if (m == 4) { W = p.w_up + (size_t)l * DM * DFF; K = DM; N = DFF; WT = (bf16_t*)(ws + WS_WUP) + (size_t)l * DFF * DM; scale = p.norm_mlp + l * DM; }
        else if (m == 5) { W = p.w_down + (size_t)l * DFF * DM; K = DFF; N = DM; WT = (bf16_t*)(ws + WS_WDN) + (size_t)l * DM * DFF; }
        else if (m < 8) { const int j = m - 6; W = p.cmp_w1 + (size_t)(l * 2 + j) * 2048 * 128; K = 2048; N = 128; WT = (bf16_t*)(ws + WS_CW1T) + (size_t)(l * 2 + j) * 128 * 2048; }
        else { const int j = m - 8; W = p.cmp_w2 + (size_t)(l * 2 + j) * 128 * 64; K = 128; N = 64; WT = (bf16_t*)(ws + WS_CW2T) + (size_t)(l * 2 + j) * 64 * 128; }
        conv_matrix(W, K, N, WT, scale, sfrom, sh, lds);
    }
    for (int l = 0; l < 2; ++l) {
        u32x4* z = (u32x4*)((bf16_t*)(ws + WS_WIN) + (size_t)l * NP_IN * DM + (size_t)3352 * DM);
        for (int i = blockIdx.x * 512 + tid; i < 232 * DM / 8; i += gridDim.x * 512) z[i] = (u32x4){0u, 0u, 0u, 0u};
    }
    if (blockIdx.x < 4) {
        const int lj = blockIdx.x, n = tid & 127, kq = tid >> 7;
        const float* W1 = p.cmp_w1 + (size_t)lj * 2048 * 128; const float* pos = p.cmp_pos + (size_t)lj * 2048;
        float s = 0.f;
#pragma unroll 4
        for (int k = kq * 512; k < kq * 512 + 512; ++k) s += pos[k] * W1[(size_t)k * 128 + n];
        LAS float* red = (LAS float*)(lds + 32768);
        red[kq * 128 + n] = s;
        __syncthreads();
        if (tid < 128) ((float*)(ws + WS_CBIAS))[lj * 128 + tid] = p.cmp_b1[lj * 128 + tid] + (red[tid] + red[128 + tid]) + (red[256 + tid] + red[384 + tid]);
        __syncthreads();
    }
    if (blockIdx.x >= 16 && blockIdx.x < 32) {
        const int r = blockIdx.x - 16; float* EH = (float*)(ws + WS_EX + EX_H);
        const float xa = p.x[(size_t)r * SEQ * DM + tid], xb2 = p.x[(size_t)r * SEQ * DM + 512 + tid];
        const float ss = block_sum(xa * xa + xb2 * xb2, (LAS float*)(lds + 32768), tid);
        const float rstd = rsqrtf(ss * (1.0f / 1024.0f) + 1e-6f);
        EH[r * 1024 + tid] = xa * rstd * p.norm_mix[tid]; EH[r * 1024 + 512 + tid] = xb2 * rstd * p.norm_mix[512 + tid];
        __syncthreads();
    }
    {
        bf16_t* xb = (bf16_t*)(ws + WS_XB); float* sumsq = (float*)(ws + WS_SUMSQ);
#pragma unroll 1
        for (int row = blockIdx.x * 8 + wave; row < T_TOK; row += gridDim.x * 8) {
            const f32x4* xr = (const f32x4*)(p.x + (size_t)row * DM) + lane;
            f32x4 v[4]; float s = 0.f;
#pragma unroll
            for (int j = 0; j < 4; ++j) { v[j] = xr[64 * j]; s += (v[j][0] * v[j][0] + v[j][1] * v[j][1]) + (v[j][2] * v[j][2] + v[j][3] * v[j][3]); }
#pragma unroll
            for (int o = 1; o < 64; o <<= 1) s += __shfl_xor(s, o);
            u32x2* o8 = (u32x2*)(xb + (size_t)row * DM) + lane;
#pragma unroll
            for (int j = 0; j < 4; ++j) { u32x2 w; w.x = cvt_pk_bf16(v[j][0], v[j][1]); w.y = cvt_pk_bf16(v[j][2], v[j][3]); o8[64 * j] = w; }
            if (lane < 16) sumsq[(size_t)row * 16 + lane] = (lane == 0) ? s : 0.f;
        }
    }
}

template <class InFn>
__device__ __forceinline__ void exact_stage(const float* W0, const float* W1, int wsplit, int K, int N, float* part, InFn in_fn, LAS unsigned char* lds) {
    const int tid = tid_opaque(), lane = tid & 63, wave = tid >> 6;
    const int nsl = K / 256, ncg = (N + 511) / 512, ntasks = nsl * ncg;
    LAS float* IN = (LAS float*)lds;
#pragma unroll 1
    for (int task = blockIdx.x; task < ntasks; task += gridDim.x) {
        const int sl = task % nsl, cg = task / nsl;
        __syncthreads();
#pragma unroll 1
        for (int idx = tid; idx < 4096; idx += 512) IN[idx] = in_fn(idx >> 8, sl * 256 + (idx & 255));
        __syncthreads();
        const int col = (cg * 8 + wave) * 64 + lane;
        if (col < N) {
            const float* Wp = ((sl < wsplit) ? W0 + (size_t)sl * 256 * N : W1 + (size_t)(sl - wsplit) * 256 * N) + col;
            float acc[16];
#pragma unroll
            for (int r = 0; r < 16; ++r) acc[r] = 0.f;
#pragma unroll 2
            for (int k = 0; k < 256; k += 4) {
                const float w0 = Wp[(size_t)k * N], w1 = Wp[(size_t)(k + 1) * N], w2 = Wp[(size_t)(k + 2) * N], w3 = Wp[(size_t)(k + 3) * N];
#pragma unroll
                for (int r = 0; r < 16; ++r) { const f32x4 v = *(const LAS f32x4*)(IN + r * 256 + k); acc[r] += (v[0] * w0 + v[1] * w1) + (v[2] * w2 + v[3] * w3); }
            }
#pragma unroll
            for (int r = 0; r < 16; ++r) part[((size_t)sl * 16 + r) * N + col] = acc[r];
        }
    }
    __syncthreads();
}
__device__ __forceinline__ float block_sum(float v, LAS float* red, int tid) {
#pragma unroll
    for (int o = 1; o < 64; o <<= 1) v += __shfl_xor(v, o);
    __syncthreads();
    if ((tid & 63) == 0) red[tid >> 6] = v;
    __syncthreads();
    float s = 0.f;
#pragma unroll
    for (int i = 0; i < 8; ++i) s += red[i];
    return s;
}
__device__ __forceinline__ float ex_pp(const float* PP, int r, int c) { return (PP[(size_t)r * IN_COLS + c] + PP[(size_t)(16 + r) * IN_COLS + c]) + (PP[(size_t)(32 + r) * IN_COLS + c] + PP[(size_t)(48 + r) * IN_COLS + c]); }
__device__ __forceinline__ void exact_mixers(const Params& p, int r, LAS unsigned char* lds) {
    const int tid = tid_opaque();
    const float* PP = (const float*)(p.ws + WS_EX + EX_PP); float* OAB = (float*)(p.ws + WS_EX + EX_OAB);
    LAS float* red = (LAS float*)(lds + 32768);
    const int j = tid, h = j >> 7, e = j & 127;
    const float q = ex_pp(PP, r, j), z = ex_pp(PP, r, 512 + j), iv = ex_pp(PP, r, 1024 + j), g = ex_pp(PP, r, 1536 + j);
    float pr = q * (1.0f / (1.0f + __expf(z)));
#pragma unroll
    for (int o = 1; o < 64; o <<= 1) pr += __shfl_xor(pr, o);
    __syncthreads();
    if ((tid & 63) == 0) red[tid >> 6] = pr;
    __syncthreads();
    const float sh = red[2 * h] + red[2 * h + 1];
    const float o = sh * iv;
    float sq = o * o;
#pragma unroll
    for (int o2 = 1; o2 < 64; o2 <<= 1) sq += __shfl_xor(sq, o2);
    __syncthreads();
    if ((tid & 63) == 0) red[tid >> 6] = sq;
    __syncthreads();
    const float rstd = rsqrtf((red[2 * h] + red[2 * h + 1]) * (1.0f / 128.0f) + 1e-6f);
    OAB[(size_t)r * 1024 + j] = o * rstd * p.hg_gain[e] * (g / (1.0f + __expf(-g)));
    const int hh = j >> 6, d = j & 63, gg = hh >> 2, hp = hh & 3;
    const float vs = ex_pp(PP, r, 2944 + gg * 64 + d), vw = ex_pp(PP, r, 3200 + gg * 64 + d);
    const float gs = ex_pp(PP, r, 3328 + gg * 12 + hp * 3 + 1), gw = ex_pp(PP, r, 3328 + gg * 12 + hp * 3 + 2);
    OAB[(size_t)r * 1024 + 512 + j] = vs / (1.0f + __expf(-gs)) + vw / (1.0f + __expf(-gw));
    __syncthreads();
}
__device__ __forceinline__ float ex_x1(const Params& p, int r, int k) {
    const float* XP = (const float*)(p.ws + WS_EX + EX_XP);
    return p.x[(size_t)r * SEQ * DM + k] + ((XP[(size_t)r * 1024 + k] + XP[(size_t)(16 + r) * 1024 + k]) + (XP[(size_t)(32 + r) * 1024 + k] + XP[(size_t)(48 + r) * 1024 + k]));
}
__device__ __forceinline__ float ex_x2(const Params& p, int r, int k) {
    const float* DP = (const float*)(p.ws + WS_EX + EX_DP);
    float s = 0.f;
#pragma unroll
    for (int i = 0; i < 16; ++i) s += DP[((size_t)i * 16 + r) * 1024 + k];
    return ex_x1(p, r, k) + s;
}

constexpr int HG_TOT = 0, HG_DEC = 2048, HG_QB = 2560, HG_QS = HG_QB + 17408, HG_KVER = HG_QS + 17408, HG_KHT = HG_KVER + 43520, HG_VT = HG_KHT + 18432, HG_AM = HG_VT + 4608, HG_END = HG_AM + 9216;
static_assert(HG_END <= LDS_BYTES, "hgrn lds");
__device__ __forceinline__ void hgrn_unit(const Params& p, int layer, int unit, LAS unsigned char* lds) {
    unsigned char* ws = p.ws;
    const int tid = tid_opaque(), lane = tid & 63, wave = tid >> 6, l16 = lane & 15, quad = lane >> 4;
    const int b = unit >> 4, h = (unit >> 2) & 3, sl = unit & 3;
    const int d = tid & 127, tq = tid >> 7;
    const bf16_t* qg = (const bf16_t*)(ws + WS_HQ) + (size_t)b * SEQ * 512 + h * 128 + d;
    const bf16_t* zg = (const bf16_t*)(ws + WS_HF) + (size_t)b * SEQ * 512 + h * 128 + d;
    bf16_t* vg = (bf16_t*)(ws + WS_HI) + (size_t)b * SEQ * 512 + h * 128 + sl * 32;
    float lb = 0.f;
    if (layer == 1) lb = sigm(p.lb_logits[512 + h * 128 + d] - p.lb_logits[h * 128 + d]);
    const float omlb = 1.0f - lb;
    const int vv = tid & 31, sq = tid >> 5;
    const int tt = wave & 3, vt = wave >> 2;
    LAS float* TOT = (LAS float*)(lds + HG_TOT); LAS float* DEC = (LAS float*)(lds + HG_DEC);
    f32x4 S[8];
#pragma unroll
    for (int i = 0; i < 8; ++i) S[i] = (f32x4){0.f, 0.f, 0.f, 0.f};
    float s00;
    {
        LAS float* XR = (LAS float*)(lds + HG_KVER);
        LAS float* red0 = (LAS float*)(lds + HG_TOT);
        const float* nm = p.norm_mix + layer * DM;
        const float xa = (layer == 0) ? p.x[(size_t)b * SEQ * DM + tid] : ex_x2(p, b, tid);
        const float xb2 = (layer == 0) ? p.x[(size_t)b * SEQ * DM + 512 + tid] : ex_x2(p, b, 512 + tid);
        XR[tid] = xa * nm[tid]; XR[512 + tid] = xb2 * nm[512 + tid];
        const float ss = block_sum(xa * xa + xb2 * xb2, red0, tid);
        const float rstd = rsqrtf(ss * (1.0f / 1024.0f) + 1e-6f);
        __syncthreads();
        const float* W = p.w_in + (size_t)layer * DM * IN_COLS + h * 128 + d;
        float q0 = 0.f, z0 = 0.f;
#pragma unroll 4
        for (int k = tq * 256; k < tq * 256 + 256; ++k) { const float hk = XR[k]; q0 += hk * W[(size_t)k * IN_COLS]; z0 += hk * W[(size_t)k * IN_COLS + 512]; }
        LAS float* RED = (LAS float*)(lds + HG_QB);
        RED[tq * 128 + d] = q0; RED[512 + tq * 128 + d] = z0;
        __syncthreads();
        q0 = (RED[d] + RED[128 + d]) + (RED[256 + d] + RED[384 + d]); z0 = (RED[512 + d] + RED[640 + d]) + (RED[768 + d] + RED[896 + d]);
        q0 *= rstd; z0 *= rstd;
        float pr = q0 * (omlb / (1.0f + __expf(z0)));
#pragma unroll
        for (int o = 1; o < 64; o <<= 1) pr += __shfl_xor(pr, o);
        __syncthreads();
        if (lane == 0) RED[wave] = pr;
        __syncthreads();
        s00 = RED[0] + RED[1];
#ifdef DIAG_S00
        if (layer == 1 && tid == 0) atomicMin((unsigned*)(ws + 512), __float_as_uint(fabsf(s00)));
#endif
        __syncthreads();
    }
    typedef unsigned short us2 __attribute__((ext_vector_type(2)));
    us2 qz[16]; unsigned short vr[4];
#pragma unroll
    for (int i = 0; i < 16; ++i) { qz[i].x = qg[(size_t)(16 * tq + i) * 512]; qz[i].y = zg[(size_t)(16 * tq + i) * 512]; }
#pragma unroll
    for (int i = 0; i < 4; ++i) vr[i] = vg[(size_t)(4 * sq + i) * 512 + vv];
    for (int c = 0; c < 64; ++c) {
        float q[16], kk[16], bl[16]; unsigned short vcur[4];
        {
            float run = 0.f;
#pragma unroll
            for (int i = 0; i < 16; ++i) {
                q[i] = bfu(qz[i].x); const float z = bfu(qz[i].y);
                const float ez = __expf(-z);
                const float inv = 1.0f / (1.0f + ez);
                const float f = lb + omlb * inv;
                kk[i] = omlb * (ez * inv);
                run += __logf(f); bl[i] = run;
            }
#pragma unroll
            for (int i = 0; i < 4; ++i) vcur[i] = vr[i];
        }
        TOT[tq * 128 + d] = bl[15];
        __syncthreads();
        const float t0 = TOT[d], t1 = TOT[128 + d], t2 = TOT[256 + d], t3 = TOT[384 + d];
        const float r1 = t0, r2 = t0 + t1, r3 = r2 + t2, r4 = r3 + t3;
        const float rJ = (tq == 0) ? 0.f : ((tq == 1) ? r1 : ((tq == 2) ? r2 : r3));
        if (tq == 0) DEC[d] = __expf(r4);
        {
            LAS bf16_t* QB = (LAS bf16_t*)(lds + HG_QB); LAS bf16_t* QS = (LAS bf16_t*)(lds + HG_QS); LAS bf16_t* KV_ = (LAS bf16_t*)(lds + HG_KVER);
            float kh[16];
#pragma unroll
            for (int i = 0; i < 16; ++i) {
                const int t = 16 * tq + i; const float bg = rJ + bl[i];
                QB[t * 136 + d] = bf1(q[i] * __expf(bg));
                QS[t * 136 + d] = bf1(q[i] * __expf(bl[i]));
                kh[i] = kk[i] * __expf(r4 - bg);
            }
#pragma unroll
            for (int I = 0; I < 4; ++I) {
                if (I >= tq) {
                    const float rI = (I == 0) ? 0.f : ((I == 1) ? r1 : ((I == 2) ? r2 : r3));
                    const int voff = (I == 0) ? 0 : ((I == 1) ? 16 : ((I == 2) ? 48 : 96));
                    const float sh = rI - rJ;
#pragma unroll
                    for (int i = 0; i < 16; ++i) KV_[(voff + 16 * tq + i) * 136 + d] = bf1(kk[i] * __expf(sh - bl[i]));
                }
            }
            LAS unsigned char* KHT = lds + HG_KHT;
            u32x4 w0, w1;
            w0.x = cvt_pk_bf16(kh[0], kh[1]); w0.y = cvt_pk_bf16(kh[2], kh[3]); w0.z = cvt_pk_bf16(kh[4], kh[5]); w0.w = cvt_pk_bf16(kh[6], kh[7]);
            w1.x = cvt_pk_bf16(kh[8], kh[9]); w1.y = cvt_pk_bf16(kh[10], kh[11]); w1.z = cvt_pk_bf16(kh[12], kh[13]); w1.w = cvt_pk_bf16(kh[14], kh[15]);
            *(LAS u32x4*)(KHT + d * 144 + tq * 32) = w0; *(LAS u32x4*)(KHT + d * 144 + tq * 32 + 16) = w1;
            LAS unsigned char* VT = lds + HG_VT;
            u32x2 wv; wv.x = (unsigned)vcur[0] | ((unsigned)vcur[1] << 16); wv.y = (unsigned)vcur[2] | ((unsigned)vcur[3] << 16);
            *(LAS u32x2*)(VT + vv * 144 + sq * 8) = wv;
            LAS u32x4* AMz = (LAS u32x4*)(lds + HG_AM);
            AMz[tid] = (u32x4){0u, 0u, 0u, 0u}; if (tid < 64) AMz[512 + tid] = (u32x4){0u, 0u, 0u, 0u};
        }
        __syncthreads();
        if (c + 1 < 64) {
            const size_t ro = (size_t)(c + 1) * 64 * 512;
#pragma unroll
            for (int i = 0; i < 16; ++i) { qz[i].x = qg[ro + (size_t)(16 * tq + i) * 512]; qz[i].y = zg[ro + (size_t)(16 * tq + i) * 512]; }
#pragma unroll
            for (int i = 0; i < 4; ++i) vr[i] = vg[ro + (size_t)(4 * sq + i) * 512 + vv];
        }
        for (int pi = wave; pi < 10; pi += 8) {
            int I, J;
            if (pi == 0) { I = 0; J = 0; } else if (pi < 3) { I = 1; J = pi - 1; } else if (pi < 6) { I = 2; J = pi - 3; } else { I = 3; J = pi - 6; }
            const int voff = (I == 0) ? 0 : ((I == 1) ? 16 : ((I == 2) ? 48 : 96));
            const LAS unsigned char* qa = lds + HG_QS + (16 * I + l16) * 272 + quad * 16;
            const LAS unsigned char* kb = lds + HG_KVER + (voff + 16 * J + l16) * 272 + quad * 16;
            f32x4 a = (f32x4){0.f, 0.f, 0.f, 0.f};
#pragma unroll
            for (int ks = 0; ks < 4; ++ks) a = MFMA16(lds_ld8(qa + ks * 64), lds_ld8(kb + ks * 64), a);
            LAS bf16_t* AM = (LAS bf16_t*)(lds + HG_AM);
#pragma unroll
            for (int j = 0; j < 4; ++j) {
                float v = a[j]; if (I == J && l16 > quad * 4 + j) v = 0.f;
                if (c == 0 && pi == 0 && lane == 0 && j == 0) v = s00;
                AM[(16 * I + quad * 4 + j) * 72 + 16 * J + l16] = bf1(v);
            }
        }
        __syncthreads();
        {
            f32x4 o = (f32x4){0.f, 0.f, 0.f, 0.f};
            const LAS unsigned char* qb = lds + HG_QB + (16 * tt + l16) * 272 + quad * 8;
#pragma unroll
            for (int s2 = 0; s2 < 4; ++s2) o = MFMA16(lds_ld4x2(qb + s2 * 64, qb + s2 * 64 + 32), pack8(S[2 * s2], S[2 * s2 + 1]), o);
            const LAS unsigned char* am = lds + HG_AM + (16 * tt + l16) * 144 + quad * 16;
            const LAS unsigned char* vb = lds + HG_VT + (16 * vt + l16) * 144 + quad * 16;
            const bf16x8 vb0 = lds_ld8(vb), vb1 = lds_ld8(vb + 64);
            o = MFMA16(lds_ld8(am), vb0, o); o = MFMA16(lds_ld8(am + 64), vb1, o);
            bf16_t* og = vg + (size_t)(c * 64 + 16 * tt + quad * 4) * 512 + 16 * vt + l16;
#pragma unroll
            for (int j = 0; j < 4; ++j) og[(size_t)j * 512] = bf1(o[j]);
#pragma unroll
            for (int dt = 0; dt < 8; ++dt) {
                const f32x4 dc = *(const LAS f32x4*)(DEC + 16 * dt + quad * 4);
                const LAS unsigned char* ka = lds + HG_KHT + (16 * dt + l16) * 144 + quad * 16;
                f32x4 s = S[dt] * dc;
                s = MFMA16(lds_ld8(ka), vb0, s); s = MFMA16(lds_ld8(ka + 64), vb1, s);
                S[dt] = s;
            }
        }
        __syncthreads();
    }
}

__device__ __forceinline__ void hgrn_finalize(const Params& p, int layer) {
    unsigned char* ws = p.ws;
    const int tid = tid_opaque(), lane = tid & 63, wave = tid >> 6;
    const float* gain = p.hg_gain + layer * 128 + (lane & 15) * 8;
    float gn[8];
#pragma unroll
    for (int e = 0; e < 8; ++e) gn[e] = gain[e];
    for (int row = blockIdx.x * 8 + wave; row < T_TOK; row += gridDim.x * 8) {
        u32x4* op = (u32x4*)((bf16_t*)(ws + WS_HI) + (size_t)row * 512) + lane;
        const u32x4 ov = *op, gv = *((const u32x4*)((const bf16_t*)(ws + WS_HG) + (size_t)row * 512) + lane);
        float o[8], g[8];
        o[0] = bf_lo(ov.x); o[1] = bf_hi(ov.x); o[2] = bf_lo(ov.y); o[3] = bf_hi(ov.y); o[4] = bf_lo(ov.z); o[5] = bf_hi(ov.z); o[6] = bf_lo(ov.w); o[7] = bf_hi(ov.w);
        g[0] = bf_lo(gv.x); g[1] = bf_hi(gv.x); g[2] = bf_lo(gv.y); g[3] = bf_hi(gv.y); g[4] = bf_lo(gv.z); g[5] = bf_hi(gv.z); g[6] = bf_lo(gv.w); g[7] = bf_hi(gv.w);
        float s = 0.f;
#pragma unroll
        for (int e = 0; e < 8; ++e) s += o[e] * o[e];
        s += __shfl_xor(s, 1); s += __shfl_xor(s, 2); s += __shfl_xor(s, 4); s += __shfl_xor(s, 8);
        const float rstd = rsqrtf(s * (1.0f / 128.0f) + 1e-6f);
#pragma unroll
        for (int e = 0; e < 8; ++e) o[e] = o[e] * rstd * gn[e] * (g[e] * sigm(g[e]));
        u32x4 w; w.x = cvt_pk_bf16(o[0], o[1]); w.y = cvt_pk_bf16(o[2], o[3]); w.z = cvt_pk_bf16(o[4], o[5]); w.w = cvt_pk_bf16(o[6], o[7]);
        *op = w;
    }
}

constexpr int CM_A = 0, CM_W = 9216, CM_H = CM_W + 18432, CM_W2 = CM_H + 17408, CM_END = CM_W2 + 17408;
__device__ __forceinline__ void cmp_unit(const Params& p, int layer, int unit, LAS unsigned char* lds) {
    unsigned char* ws = p.ws;
    const int tid = tid_opaque(), lane = tid & 63, wave = tid >> 6, l16 = lane & 15, quad = lane >> 4;
    const int ct = unit & 3, kv = (unit >> 2) & 1, g = (unit >> 3) & 1, b = unit >> 4;
    const bf16_t* src = (const bf16_t*)(ws + WS_KV) + (size_t)b * SEQ * 768 + kv * 128 + g * 64;
    const bf16_t* W1T = (const bf16_t*)(ws + WS_CW1T) + (size_t)(layer * 2 + kv) * 128 * 2048;
    const bf16_t* W2T = (const bf16_t*)(ws + WS_CW2T) + (size_t)(layer * 2 + kv) * 64 * 128;
    const float* cbias = (const float*)(ws + WS_CBIAS) + (layer * 2 + kv) * 128;
    {
        const int n = tid >> 3, ch = tid & 7;
        *(LAS u32x4*)(lds + CM_W2 + n * 272 + ch * 32) = *(const u32x4*)(W2T + n * 128 + ch * 16);
        *(LAS u32x4*)(lds + CM_W2 + n * 272 + ch * 32 + 16) = *(const u32x4*)(W2T + n * 128 + ch * 16 + 8);
    }
    const int arow = tid >> 3, ach = tid & 7, ac = ct * 64 + arow;
    const bool aval = ac < 255;
    const bf16_t* ap = src + (size_t)(16 * (aval ? ac : 0)) * 768 + ach * 8;
    const int mi = wave & 3, nh = wave >> 2;
    f32x4 acc[4];
#pragma unroll
    for (int i = 0; i < 4; ++i) acc[i] = (f32x4){0.f, 0.f, 0.f, 0.f};
    u32x4 ar, wr0, wr1;
    ar = aval ? *(const u32x4*)ap : (u32x4){0u, 0u, 0u, 0u};
    wr0 = *(const u32x4*)(W1T + (size_t)(tid >> 3) * 2048 + (tid & 7) * 8);
    wr1 = *(const u32x4*)(W1T + (size_t)(64 + (tid >> 3)) * 2048 + (tid & 7) * 8);
    for (int tok = 0; tok < 32; ++tok) {
        __syncthreads();
        *(LAS u32x4*)(lds + CM_A + arow * 144 + ach * 16) = ar;
        *(LAS u32x4*)(lds + CM_W + (tid >> 3) * 144 + (tid & 7) * 16) = wr0;
        *(LAS u32x4*)(lds + CM_W + (64 + (tid >> 3)) * 144 + (tid & 7) * 16) = wr1;
        __syncthreads();
        if (tok + 1 < 32) {
            ar = aval ? *(const u32x4*)(ap + (size_t)(tok + 1) * 768) : (u32x4){0u, 0u, 0u, 0u};
            wr0 = *(const u32x4*)(W1T + (size_t)(tid >> 3) * 2048 + (tok + 1) * 64 + (tid & 7) * 8);
            wr1 = *(const u32x4*)(W1T + (size_t)(64 + (tid >> 3)) * 2048 + (tok + 1) * 64 + (tid & 7) * 8);
        }
#pragma unroll
        for (int ks = 0; ks < 2; ++ks) {
            const bf16x8 a = lds_ld8(lds + CM_A + (mi * 16 + l16) * 144 + ks * 64 + quad * 16);
#pragma unroll
            for (int ni = 0; ni < 4; ++ni) acc[ni] = MFMA16(a, lds_ld8(lds + CM_W + ((nh * 4 + ni) * 16 + l16) * 144 + ks * 64 + quad * 16), acc[ni]);
        }
    }
    {
        LAS bf16_t* H = (LAS bf16_t*)(lds + CM_H);
#pragma unroll
        for (int ni = 0; ni < 4; ++ni) {
            const int n = (nh * 4 + ni) * 16 + l16; const float cb = cbias[n];
#pragma unroll
            for (int j = 0; j < 4; ++j) {
                const float x = acc[ni][j] + cb;
                const float u = 0.7978845608028654f * (x + 0.044715f * x * x * x);
                const float th = 1.0f - 2.0f / (__expf(2.0f * u) + 1.0f);
                H[(mi * 16 + quad * 4 + j) * 136 + n] = bf1(0.5f * x * (1.0f + th));
            }
        }
    }
    __syncthreads();
    if (wave < 4) {
        f32x4 a2[4];
#pragma unroll
        for (int i = 0; i < 4; ++i) a2[i] = (f32x4){0.f, 0.f, 0.f, 0.f};
#pragma unroll
        for (int ks = 0; ks < 4; ++ks) {
            const bf16x8 a = lds_ld8(lds + CM_H + (wave * 16 + l16) * 272 + ks * 64 + quad * 16);
#pragma unroll
            for (int ni = 0; ni < 4; ++ni) a2[ni] = MFMA16(a, lds_ld8(lds + CM_W2 + (ni * 16 + l16) * 272 + ks * 64 + quad * 16), a2[ni]);
        }
        if (kv == 0) {
            bf16_t* KC = (bf16_t*)(ws + WS_KCMP) + (size_t)(b * 2 + g) * 256 * 64;
            const float* gain = p.qk_gain + (layer * 4 + 1) * 64;
#pragma unroll
            for (int j = 0; j < 4; ++j) {
                float s = (a2[0][j] * a2[0][j] + a2[1][j] * a2[1][j]) + (a2[2][j] * a2[2][j] + a2[3][j] * a2[3][j]);
                s += __shfl_xor(s, 1); s += __shfl_xor(s, 2); s += __shfl_xor(s, 4); s += __shfl_xor(s, 8);
                const float rstd = rsqrtf(s * (1.0f / 64.0f) + 1e-6f);
                const int c = ct * 64 + wave * 16 + quad * 4 + j;
#pragma unroll
                for (int ni = 0; ni < 4; ++ni) KC[(size_t)c * 64 + ni * 16 + l16] = (c < 255) ? bf1(a2[ni][j] * rstd * gain[ni * 16 + l16]) : (bf16_t)0;
            }
        } else {
            bf16_t* VC = (bf16_t*)(ws + WS_VCMPT) + (size_t)(b * 2 + g) * 64 * 256;
#pragma unroll
            for (int j = 0; j < 4; ++j) {
                const int c = ct * 64 + wave * 16 + quad * 4 + j;
#pragma unroll
                for (int ni = 0; ni < 4; ++ni) VC[(size_t)(ni * 16 + l16) * 256 + c] = (c < 255) ? bf1(a2[ni][j]) : (bf16_t)0;
            }
        }
    }
    __syncthreads();
}

constexpr int AT_TAB = 0, AT_K = 12800, AT_V = AT_K + 18432, AT_PS = AT_V + 18432, AT_MASK = AT_PS + 65536, AT_END = AT_MASK + 512;
static_assert(AT_END <= LDS_BYTES, "attn lds");

struct AttnCtx {
    const bf16_t* ksrc; const bf16_t* vsrc; int ldk, ldv; const float* kgain;
    int tpos[2]; int h;
};

template <int BR>
__device__ __forceinline__ void attn_branch(const AttnCtx& cx, const bf16x8 (&qf)[2][2], int qt, unsigned long long selu, const unsigned long long (&selm)[2],
                                            f32x4 (&of)[2][4], const float (&gate)[2], LAS unsigned char* lds, float (&m_out)[2], float (&il_out)[2]) {
    const int tid = tid_opaque(), lane = tid & 63, l16 = lane & 15, quad = lane >> 4;
    const int srow = tid >> 3, sch = tid & 7;
    float kg[8];
    if (BR != 0) {
#pragma unroll
        for (int e = 0; e < 8; ++e) kg[e] = cx.kgain[sch * 8 + e];
    }
    unsigned long long rem;
    if (BR == 0) rem = 0xFull;
    else if (BR == 1) rem = selu & ((qt >= 63) ? ~0ull : ((2ull << qt) - 1ull));
    else { const int lo = qt > 8 ? qt - 8 : 0; rem = ((qt >= 63) ? ~0ull : ((2ull << qt) - 1ull)) & ~((1ull << lo) - 1ull); }
    f32x4 o[2][4]; float m[2], l[2];
#pragma unroll
    for (int mi = 0; mi < 2; ++mi) { m[mi] = -INFINITY; l[mi] = 0.f;
#pragma unroll
        for (int di = 0; di < 4; ++di) o[mi][di] = (f32x4){0.f, 0.f, 0.f, 0.f}; }
    int cur = rem ? __builtin_ctzll(rem) : -1; if (rem) rem &= rem - 1ull;
    u32x4 kr, vr;
    auto gload = [&](int jt) {
        kr = *(const u32x4*)(cx.ksrc + (size_t)(jt * 64 + srow) * cx.ldk + sch * 8);
        vr = *(const u32x4*)(cx.vsrc + (size_t)srow * cx.ldv + jt * 64 + sch * 8);
    };
    auto lstore = [&](int buf) {
        u32x4 kw = kr;
        if (BR != 0) {
            float f[8]; f[0] = bf_lo(kr.x); f[1] = bf_hi(kr.x); f[2] = bf_lo(kr.y); f[3] = bf_hi(kr.y); f[4] = bf_lo(kr.z); f[5] = bf_hi(kr.z); f[6] = bf_lo(kr.w); f[7] = bf_hi(kr.w);
            float s = 0.f;
#pragma unroll
            for (int e = 0; e < 8; ++e) s += f[e] * f[e];
            s += __shfl_xor(s, 1); s += __shfl_xor(s, 2); s += __shfl_xor(s, 4);
            const float rstd = rsqrtf(s * (1.0f / 64.0f) + 1e-6f);
#pragma unroll
            for (int e = 0; e < 8; ++e) f[e] = f[e] * rstd * kg[e];
            kw.x = cvt_pk_bf16(f[0], f[1]); kw.y = cvt_pk_bf16(f[2], f[3]); kw.z = cvt_pk_bf16(f[4], f[5]); kw.w = cvt_pk_bf16(f[6], f[7]);
        }
        *(LAS u32x4*)(lds + AT_K + buf * 9216 + srow * 144 + sch * 16) = kw;
        *(LAS u32x4*)(lds + AT_V + buf * 9216 + srow * 144 + sch * 16) = vr;
    };
    if (cur >= 0) { gload(cur); lstore(0); }
    __syncthreads();
    int buf = 0;
    const LAS f32x4* TAB = (const LAS f32x4*)(lds + AT_TAB);
    const LAS float* TABf = (const LAS float*)(lds + AT_TAB);
    while (cur >= 0) {
        const int nxt = rem ? __builtin_ctzll(rem) : -1; if (rem) rem &= rem - 1ull;
        if (nxt >= 0) gload(nxt);
        const LAS unsigned char* Kb = lds + AT_K + buf * 9216; const LAS unsigned char* Vb = lds + AT_V + buf * 9216;
        f32x4 st[2][4];
#pragma unroll
        for (int ni = 0; ni < 4; ++ni) {
            const bf16x8 k0 = lds_ld8(Kb + (ni * 16 + l16) * 144 + quad * 16), k1 = lds_ld8(Kb + (ni * 16 + l16) * 144 + 64 + quad * 16);
#pragma unroll
            for (int mi = 0; mi < 2; ++mi) { f32x4 a = (f32x4){0.f, 0.f, 0.f, 0.f}; a = MFMA16(k0, qf[mi][0], a); a = MFMA16(k1, qf[mi][1], a); st[mi][ni] = a; }
        }
        bf16x8 pb[2][2];
#pragma unroll
        for (int mi = 0; mi < 2; ++mi) {
            const int tp = cx.tpos[mi];
            const bool blk_ok = (BR != 1) || ((selm[mi] >> cur) & 1ull);
            float mx = -INFINITY;
#pragma unroll
            for (int ni = 0; ni < 4; ++ni)
#pragma unroll
                for (int j = 0; j < 4; ++j) {
                    const int kidx = cur * 64 + ni * 16 + quad * 4 + j;
                    const int dist = (BR == 0) ? (tp - (16 * kidx + 31)) : (tp - kidx);
                    const bool valid = blk_ok && dist >= 0 && (BR != 2 || dist < 512);
                    const int di_ = dist < 0 ? 0 : (dist > 799 ? 799 : dist);
                    const float sc = valid ? st[mi][ni][j] + TABf[di_ * 4 + cx.h] : -INFINITY;
                    st[mi][ni][j] = sc; mx = fmaxf(mx, sc);
                }
            mx = fmaxf(mx, __shfl_xor(mx, 16)); mx = fmaxf(mx, __shfl_xor(mx, 32));
            const float mn = fmaxf(m[mi], mx);
            const float mu = (mn == -INFINITY) ? 0.f : mn;
            const float alpha = __expf(m[mi] - mu);
            m[mi] = mn;
            float ls = 0.f;
#pragma unroll
            for (int ni = 0; ni < 4; ++ni)
#pragma unroll
                for (int j = 0; j < 4; ++j) { const float pv = __expf(st[mi][ni][j] - mu); st[mi][ni][j] = pv; ls += pv; }
            l[mi] = l[mi] * alpha + ls;
#pragma unroll
            for (int di = 0; di < 4; ++di) o[mi][di] = o[mi][di] * alpha;
            pb[mi][0] = pack8(st[mi][0], st[mi][1]); pb[mi][1] = pack8(st[mi][2], st[mi][3]);
        }
#pragma unroll
        for (int di = 0; di < 4; ++di)
#pragma unroll
            for (int s2 = 0; s2 < 2; ++s2) {
                const LAS unsigned char* vp = Vb + (di * 16 + l16) * 144 + s2 * 64 + quad * 8;
                const bf16x8 vf = lds_ld4x2(vp, vp + 32);
#pragma unroll
                for (int mi = 0; mi < 2; ++mi) o[mi][di] = MFMA16(vf, pb[mi][s2], o[mi][di]);
            }
        if (nxt >= 0) lstore(buf ^ 1);
        __syncthreads();
        cur = nxt; buf ^= 1;
    }
#pragma unroll
    for (int mi = 0; mi < 2; ++mi) {
        float lt = l[mi]; lt += __shfl_xor(lt, 16); lt += __shfl_xor(lt, 32);
        const float il = lt > 0.f ? 1.0f / lt : 0.f;
        const float sc = il * gate[mi];
#pragma unroll
        for (int di = 0; di < 4; ++di) of[mi][di] = of[mi][di] + o[mi][di] * sc;
        m_out[mi] = (m[mi] == -INFINITY) ? 0.f : m[mi]; il_out[mi] = il;
    }
    (void)TAB;
}

__device__ __forceinline__ void attn_cmp_probs(const AttnCtx& cx, const bf16x8 (&qf)[2][2], const float (&mrow)[2], const float (&ilrow)[2], LAS unsigned char* lds) {
    const int tid = tid_opaque(), lane = tid & 63, wave = tid >> 6, l16 = lane & 15, quad = lane >> 4;
    const int srow = tid >> 3, sch = tid & 7;
    const LAS float* TABf = (const LAS float*)(lds + AT_TAB);
    LAS float* PS = (LAS float*)(lds + AT_PS);
    for (int jt = 0; jt < 4; ++jt) {
        const u32x4 kr = *(const u32x4*)(cx.ksrc + (size_t)(jt * 64 + srow) * cx.ldk + sch * 8);
        __syncthreads();
        *(LAS u32x4*)(lds + AT_K + srow * 144 + sch * 16) = kr;
        __syncthreads();
        const LAS unsigned char* Kb = lds + AT_K;
#pragma unroll
        for (int ni = 0; ni < 4; ++ni) {
            const bf16x8 k0 = lds_ld8(Kb + (ni * 16 + l16) * 144 + quad * 16), k1 = lds_ld8(Kb + (ni * 16 + l16) * 144 + 64 + quad * 16);
#pragma unroll
            for (int mi = 0; mi < 2; ++mi) {
                f32x4 a = (f32x4){0.f, 0.f, 0.f, 0.f}; a = MFMA16(k0, qf[mi][0], a); a = MFMA16(k1, qf[mi][1], a);
                const int tp = cx.tpos[mi];
                f32x4 pr;
#pragma unroll
                for (int j = 0; j < 4; ++j) {
                    const int kidx = jt * 64 + ni * 16 + quad * 4 + j;
                    const int dist = tp - (16 * kidx + 31);
                    const int di_ = dist < 0 ? 0 : (dist > 799 ? 799 : dist);
                    float pv = (dist >= 0) ? __expf(a[j] + TABf[di_ * 4 + cx.h] - mrow[mi]) * ilrow[mi] : 0.f;
                    pv += __shfl_xor(pv, 1); pv += __shfl_xor(pv, 2);
                    pr[j] = pv;
                }
                if ((l16 & 3) == 0) *(LAS f32x4*)(PS + (wave * 8 + mi * 4 + (l16 >> 2)) * 256 + jt * 64 + ni * 16 + quad * 4) = pr;
            }
        }
    }
    __syncthreads();
}

__device__ __forceinline__ void attn_unit(const Params& p, int layer, int b, int g, int qt, LAS unsigned char* lds) {
    unsigned char* ws = p.ws;
    const int tid = tid_opaque(), lane = tid & 63, wave = tid >> 6, l16 = lane & 15, quad = lane >> 4;
    const int t0 = qt * 64;
    __syncthreads();
    {
        LAS float* TABw = (LAS float*)(lds + AT_TAB);
        for (int i = tid; i < 3200; i += 512) {
            const int dist = i >> 2, hh = i & 3;
            int bk;
            if (dist < 16) bk = dist;
            else { bk = 16 + (dist >= 21) + (dist >= 27) + (dist >= 35) + (dist >= 46) + (dist >= 59) + (dist >= 77) + (dist >= 99) + (dist >= 128) + (dist >= 166) + (dist >= 216) + (dist >= 280) + (dist >= 363) + (dist >= 470) + (dist >= 609) + (dist >= 790); }
            TABw[i] = p.rel_bias[bk * 8 + g * 4 + hh];
        }
    }
    AttnCtx cx; cx.h = l16 & 3;
    bf16x8 qf[2][2]; float gates[3][2];
    bf16_t* nq = (bf16_t*)(ws + WS_NQ);
    const bf16_t* ng = (const bf16_t*)(ws + WS_NG);
    const float* qgain = p.qk_gain + (layer * 4 + 0) * 64;
#pragma unroll
    for (int mi = 0; mi < 2; ++mi) {
        const int tl = wave * 8 + mi * 4 + (l16 >> 2); const int tp = t0 + tl; cx.tpos[mi] = tp;
        const size_t row = (size_t)b * SEQ + tp;
        const bf16_t* qp = nq + row * 512 + g * 256 + cx.h * 64 + quad * 8;
        const u32x4 q0 = *(const u32x4*)qp, q1 = *(const u32x4*)(qp + 32);
        float f[16];
        f[0] = bf_lo(q0.x); f[1] = bf_hi(q0.x); f[2] = bf_lo(q0.y); f[3] = bf_hi(q0.y); f[4] = bf_lo(q0.z); f[5] = bf_hi(q0.z); f[6] = bf_lo(q0.w); f[7] = bf_hi(q0.w);
        f[8] = bf_lo(q1.x); f[9] = bf_hi(q1.x); f[10] = bf_lo(q1.y); f[11] = bf_hi(q1.y); f[12] = bf_lo(q1.z); f[13] = bf_hi(q1.z); f[14] = bf_lo(q1.w); f[15] = bf_hi(q1.w);
        float s = 0.f;
#pragma unroll
        for (int e = 0; e < 16; ++e) s += f[e] * f[e];
        s += __shfl_xor(s, 16); s += __shfl_xor(s, 32);
        const float rstd = rsqrtf(s * (1.0f / 64.0f) + 1e-6f) * 0.125f;
#pragma unroll
        for (int e = 0; e < 8; ++e) { f[e] = f[e] * rstd * qgain[quad * 8 + e]; f[8 + e] = f[8 + e] * rstd * qgain[32 + quad * 8 + e]; }
        u32x4 w0, w1;
        w0.x = cvt_pk_bf16(f[0], f[1]); w0.y = cvt_pk_bf16(f[2], f[3]); w0.z = cvt_pk_bf16(f[4], f[5]); w0.w = cvt_pk_bf16(f[6], f[7]);
        w1.x = cvt_pk_bf16(f[8], f[9]); w1.y = cvt_pk_bf16(f[10], f[11]); w1.z = cvt_pk_bf16(f[12], f[13]); w1.w = cvt_pk_bf16(f[14], f[15]);
        qf[mi][0] = __builtin_bit_cast(bf16x8, w0); qf[mi][1] = __builtin_bit_cast(bf16x8, w1);
#pragma unroll
        for (int br = 0; br < 3; ++br) gates[br][mi] = bfu(ng[row * 256 + g * 12 + cx.h * 3 + br]);
    }
    __syncthreads();
    f32x4 of[2][4];
#pragma unroll
    for (int mi = 0; mi < 2; ++mi)
#pragma unroll
        for (int di = 0; di < 4; ++di) of[mi][di] = (f32x4){0.f, 0.f, 0.f, 0.f};
    const unsigned long long nomask[2] = {0ull, 0ull};
    float mrow[2], ilrow[2];
    cx.ksrc = (const bf16_t*)(ws + WS_KCMP) + (size_t)(b * 2 + g) * 256 * 64; cx.ldk = 64;
    cx.vsrc = (const bf16_t*)(ws + WS_VCMPT) + (size_t)(b * 2 + g) * 64 * 256; cx.ldv = 256; cx.kgain = nullptr;
    { const float gt[2] = {gates[0][0], gates[0][1]}; attn_branch<0>(cx, qf, qt, 0ull, nomask, of, gt, lds, mrow, ilrow); }
    attn_cmp_probs(cx, qf, mrow, ilrow, lds);
    {
        const LAS float* PS = (const LAS float*)(lds + AT_PS);
        LAS unsigned long long* MK = (LAS unsigned long long*)(lds + AT_MASK);
        for (int ti = 0; ti < 8; ++ti) {
            const int tl = wave * 8 + ti, tp = t0 + tl, jcur = tp >> 6, j = lane;
            float imp = 0.f;
#pragma unroll
            for (int e = -1; e < 4; ++e) { const int c = 4 * j + e; if (c >= 0 && c < 255) imp += PS[tl * 256 + c]; }
            const bool forced = (j == 0) || (j == jcur) || (j == jcur - 1);
            imp = (64 * j <= tp) ? (imp + (forced ? 1000.0f : 0.f)) : -1.0f;
            int cnt = 0;
#pragma unroll 4
            for (int i = 0; i < 64; ++i) {
                const float vi = __builtin_bit_cast(float, __builtin_amdgcn_readlane(__builtin_bit_cast(int, imp), i));
                cnt += (vi > imp || (vi == imp && i < j)) ? 1 : 0;
            }
            const unsigned long long mk = __ballot(cnt < 8);
            if (lane == 0) MK[tl] = mk;
        }
    }
    __syncthreads();
    unsigned long long selu = 0ull, selm[2];
    {
        const LAS unsigned long long* MK = (const LAS unsigned long long*)(lds + AT_MASK);
#pragma unroll 4
        for (int i = 0; i < 64; ++i) selu |= MK[i];
        selm[0] = MK[wave * 8 + (l16 >> 2)]; selm[1] = MK[wave * 8 + 4 + (l16 >> 2)];
    }
    float md[2], ild[2];
    cx.ksrc = (const bf16_t*)(ws + WS_KV) + (size_t)b * SEQ * 768 + 256 + g * 64; cx.ldk = 768;
    cx.vsrc = (const bf16_t*)(ws + WS_VST) + (size_t)(b * 2 + g) * 64 * 4096; cx.ldv = 4096; cx.kgain = p.qk_gain + (layer * 4 + 2) * 64;
    { const float gt[2] = {gates[1][0], gates[1][1]}; attn_branch<1>(cx, qf, qt, selu, selm, of, gt, lds, md, ild); }
    cx.ksrc = (const bf16_t*)(ws + WS_KV) + (size_t)b * SEQ * 768 + 512 + g * 64; cx.ldk = 768;
    cx.vsrc = (const bf16_t*)(ws + WS_VWT) + (size_t)(b * 2 + g) * 64 * 4096; cx.ldv = 4096; cx.kgain = p.qk_gain + (layer * 4 + 3) * 64;
    { const float gt[2] = {gates[2][0], gates[2][1]}; attn_branch<2>(cx, qf, qt, 0ull, nomask, of, gt, lds, md, ild); }
#pragma unroll
    for (int mi = 0; mi < 2; ++mi) {
        bf16_t* op = nq + ((size_t)b * SEQ + cx.tpos[mi]) * 512 + g * 256 + cx.h * 64 + quad * 4;
#pragma unroll
        for (int di = 0; di < 4; ++di) { u32x2 w; w.x = cvt_pk_bf16(of[mi][di][0], of[mi][di][1]); w.y = cvt_pk_bf16(of[mi][di][2], of[mi][di][3]); *(u32x2*)(op + di * 16) = w; }
    }
}

#ifndef ST_MASK
#define ST_MASK 0xff
#endif
#define ST_ON(k) ((ST_MASK >> (k)) & 1)
__global__ void __launch_bounds__(512, 2) fwd_kernel(Params pin) {
    extern __shared__ __attribute__((aligned(16))) unsigned char lds_raw[];
    LAS unsigned char* lds = (LAS unsigned char*)lds_raw;
    cg::grid_group grid = cg::this_grid();
    const int G = gridDim.x, bx = blockIdx.x;
    for (int ph = pin.ph_lo; ph < pin.ph_hi; ++ph) {
        Params p = pin;
        asm volatile("" : "+s"(p.x), "+s"(p.rel_bias), "+s"(p.lb_logits), "+s"(p.norm_mix), "+s"(p.w_in), "+s"(p.hg_gain), "+s"(p.qk_gain));
        asm volatile("" : "+s"(p.cmp_pos), "+s"(p.cmp_w1), "+s"(p.cmp_b1), "+s"(p.cmp_w2), "+s"(p.w_a), "+s"(p.w_b), "+s"(p.w_out));
        asm volatile("" : "+s"(p.norm_mlp), "+s"(p.w_up), "+s"(p.w_down), "+s"(p.out), "+s"(p.ws));
        unsigned char* ws = p.ws;

#ifndef NO_PRO
        if (ph == 0) { prologue(p, lds);
#ifdef DIAG_S00
            if (bx == 0 && threadIdx.x == 0) *(unsigned*)(ws + 512) = 0x7f000000u;
#endif
        }
#else
        if (ph == 0) {}
#endif

#ifdef DIAG_S00
        else if (ph == 15) { if (bx == 0 && threadIdx.x == 0) { const float v = __uint_as_float(__hip_atomic_load((unsigned*)(ws + 512), __ATOMIC_RELAXED, __HIP_MEMORY_SCOPE_AGENT)); p.out[0] += 1000.0f * v + 5.0f; } }
#endif
        else {
            const int layer = (ph - 1) / 7, st = (ph - 1) % 7;
            float* sumsq = (float*)(ws + WS_SUMSQ);
            bf16_t* xb = (bf16_t*)(ws + WS_XB);
            if (st == 0 && ST_ON(0)) {
                pg8::Gemm g{xb, (const bf16_t*)(ws + WS_WIN) + (size_t)layer * NP_IN * DM, T_TOK, NP_IN, DM}; pg8::StaticOrder S; S.init(T_TOK, NP_IN, G, bx);
                pg8::EpiIn E{sumsq, (bf16_t*)(ws + WS_HQ), (bf16_t*)(ws + WS_NQ), (bf16_t*)(ws + WS_KV), (bf16_t*)(ws + WS_NG), (bf16_t*)(ws + WS_SGA), (bf16_t*)(ws + WS_VST), (bf16_t*)(ws + WS_VWT)};
                pg8::gemm_phase<pg8::EpiIn, pg8::StaticOrder, true, true>(lds, g, S, E);
                if (layer == 0) {
                    __syncthreads();
                    const float* EH = (const float*)(ws + WS_EX + EX_H);
                    exact_stage(p.w_in, p.w_in, 99, DM, IN_COLS, (float*)(ws + WS_EX + EX_PP), [=](int r, int k) { return EH[r * 1024 + k]; }, lds);
                }
            } else if (st == 1 && ST_ON(1)) {
                {
                    const int x = bx & 7, i = bx >> 3;
                    const int unit = ((x * 8 + (i >> 2)) << 2) | (i & 3);

#ifndef NO_HGRN
                    if (bx < 256) hgrn_unit(p, layer, unit, lds);
#endif

                }

#ifndef NO_CMP
                for (int u = bx; u < 256; u += G) cmp_unit(p, layer, u, lds);
#endif
                if (layer == 0 && bx < 16) exact_mixers(p, bx, lds);

            } else if (st == 2 && ST_ON(2)) {
                hgrn_finalize(p, layer);
                {
                    const int x = bx & 7, i = bx >> 3;
                    for (int r = 0; r < 8; ++r) {
                        const int pair = x * 4 + (r >> 1);
                        const int qt = (r & 1) ? (63 - i) : i;

#ifndef NO_ATTN
                        attn_unit(p, layer, pair >> 1, pair & 1, qt, lds);
#endif

                    }
                }
                if (layer == 0) {
                    __syncthreads();
                    const float* OAB = (const float*)(ws + WS_EX + EX_OAB);
                    exact_stage(p.w_a, p.w_b, 2, 1024, DM, (float*)(ws + WS_EX + EX_YP), [=](int r, int k) { return OAB[r * 1024 + k]; }, lds);
                }
            } else if (st == 3 && ST_ON(3)) {
                {
                    pg8::Gemm g{(const bf16_t*)(ws + WS_HI), (const bf16_t*)(ws + WS_WA) + (size_t)layer * DM * 512, T_TOK, DM, 512}; pg8::StaticOrder S; S.init(T_TOK, DM, G, bx);
                    pg8::EpiMix<false> E{(const bf16_t*)(ws + WS_SGA), (bf16_t*)(ws + WS_MIXED)};
                    pg8::gemm_phase<pg8::EpiMix<false>, pg8::StaticOrder, true, true>(lds, g, S, E);
                }
                __syncthreads();
                {
                    pg8::Gemm g{(const bf16_t*)(ws + WS_NQ), (const bf16_t*)(ws + WS_WB) + (size_t)layer * DM * 512, T_TOK, DM, 512}; pg8::StaticOrder S; S.init(T_TOK, DM, G, bx);
                    pg8::EpiMix<true> E{(const bf16_t*)(ws + WS_SGB), (bf16_t*)(ws + WS_MIXED)};
                    pg8::gemm_phase<pg8::EpiMix<true>, pg8::StaticOrder, true, true>(lds, g, S, E);
                }
                if (layer == 0) {
                    __syncthreads();
                    const float* PP = (const float*)(ws + WS_EX + EX_PP); const float* YP = (const float*)(ws + WS_EX + EX_YP);
                    exact_stage(p.w_out, p.w_out, 99, DM, DM, (float*)(ws + WS_EX + EX_XP), [=](int r, int k) {
                        const float ga = ex_pp(PP, r, 3352 + k), gb = ex_pp(PP, r, 4376 + k);
                        const float ya = YP[(size_t)r * 1024 + k] + YP[(size_t)(16 + r) * 1024 + k], yb = YP[(size_t)(32 + r) * 1024 + k] + YP[(size_t)(48 + r) * 1024 + k];
                        return ya / (1.0f + __expf(-ga)) + yb / (1.0f + __expf(-gb)); }, lds);
                }
            } else if ((st == 4 || st == 6) && ST_ON(4)) {
                const bool down = (st == 6);
                pg8::Gemm g{down ? (const bf16_t*)(ws + WS_HID) : (const bf16_t*)(ws + WS_MIXED),
                            down ? (const bf16_t*)(ws + WS_WDN) + (size_t)layer * DM * DFF : (const bf16_t*)(ws + WS_WO) + (size_t)layer * DM * DM, T_TOK, DM, down ? DFF : DM};
                pg8::StaticOrder S; S.init(T_TOK, DM, G, bx);
                pg8::EpiRes E{(layer == 0 && !down) ? p.x : (const float*)p.out, p.out, xb, sumsq};
                pg8::gemm_phase<pg8::EpiRes, pg8::StaticOrder, true, true>(lds, g, S, E);
                if (layer == 0 && !down) {
                    __syncthreads();
                    LAS float* RS = (LAS float*)(lds + 16384); LAS float* red = (LAS float*)(lds + 32768);
                    const int tid2 = threadIdx.x;
#pragma unroll 1
                    for (int r = 0; r < 16; ++r) {
                        const float a = ex_x1(p, r, tid2), b2 = ex_x1(p, r, 512 + tid2);
                        const float ss = block_sum(a * a + b2 * b2, red, tid2);
                        if (tid2 == 0) RS[r] = rsqrtf(ss * (1.0f / 1024.0f) + 1e-6f);
                    }
                    __syncthreads();
                    const Params pc = p; const float* nm2 = p.norm_mlp;
                    exact_stage(p.w_up, p.w_up, 99, DM, DFF, (float*)(ws + WS_EX + EX_UP), [=](int r, int k) { return ex_x1(pc, r, k) * RS[r] * nm2[k]; }, lds);
                }
            } else if (st == 5 && ST_ON(5)) {
                pg8::Gemm g{xb, (const bf16_t*)(ws + WS_WUP) + (size_t)layer * DFF * DM, T_TOK, DFF, DM}; pg8::StaticOrder S; S.init(T_TOK, DFF, G, bx);
                pg8::EpiUp E{sumsq, (bf16_t*)(ws + WS_HID)};
                pg8::gemm_phase<pg8::EpiUp, pg8::StaticOrder, true, true>(lds, g, S, E);
                if (layer == 0) {
                    __syncthreads();
                    const float* UP = (const float*)(ws + WS_EX + EX_UP);
                    exact_stage(p.w_down, p.w_down, 99, DFF, DM, (float*)(ws + WS_EX + EX_DP), [=](int r, int k) {
                        const float u = (UP[(size_t)r * DFF + k] + UP[(size_t)(16 + r) * DFF + k]) + (UP[(size_t)(32 + r) * DFF + k] + UP[(size_t)(48 + r) * DFF + k]);
                        const float t = fmaxf(u, 0.f); return t * t; }, lds);
                }
            }
        }
        if (ph + 1 < pin.ph_hi) {
            __builtin_amdgcn_fence(__ATOMIC_RELEASE, "agent");
            asm volatile("s_waitcnt vmcnt(0) lgkmcnt(0)" ::: "memory");
            grid.sync();
            __builtin_amdgcn_fence(__ATOMIC_ACQUIRE, "agent");
            asm volatile("s_waitcnt vmcnt(0)" ::: "memory");
        }
    }
}

#ifdef DIAG_S00
constexpr int N_PHASES = 16;
#else
constexpr int N_PHASES = 15;
#endif
#ifndef ONE_LAUNCH
#define ONE_LAUNCH 1
#endif

extern "C" void kernel_launch(void* const* d_in, const int* in_sizes, int n_in, void* d_out, int out_size, void* d_ws, size_t ws_size, hipStream_t stream) {
    static int ready = 0;
    if (ready == 0) {
        if (n_in != 17 || out_size != T_TOK * DM || ws_size < WS_END) { fprintf(stderr, "kernel_launch: unexpected shapes: n_in %d out %d ws %zu (need %zu)\n", n_in, out_size, ws_size, (size_t)WS_END); ready = -1; return; }
        if (hipFuncSetAttribute((const void*)fwd_kernel, hipFuncAttributeMaxDynamicSharedMemorySize, LDS_BYTES) != hipSuccess) { fprintf(stderr, "kernel_launch: hipFuncSetAttribute failed\n"); ready = -1; return; }
        int per_cu = 0;
        if (hipOccupancyMaxActiveBlocksPerMultiprocessor(&per_cu, (const void*)fwd_kernel, 512, LDS_BYTES) != hipSuccess || per_cu < 1) fprintf(stderr, "kernel_launch: occupancy query says %d blocks per CU\n", per_cu);
        (void)hipGetLastError();
        ready = 1;
    }
    if (ready < 0) return;
    Params p{};
    p.x = (const float*)d_in[0]; p.rel_bias = (const float*)d_in[1]; p.lb_logits = (const float*)d_in[2]; p.norm_mix = (const float*)d_in[3]; p.w_in = (const float*)d_in[4];
    p.hg_gain = (const float*)d_in[5]; p.qk_gain = (const float*)d_in[6]; p.cmp_pos = (const float*)d_in[7]; p.cmp_w1 = (const float*)d_in[8]; p.cmp_b1 = (const float*)d_in[9];
    p.cmp_w2 = (const float*)d_in[10]; p.w_a = (const float*)d_in[11]; p.w_b = (const float*)d_in[12]; p.w_out = (const float*)d_in[13]; p.norm_mlp = (const float*)d_in[14];
    p.w_up = (const float*)d_in[15]; p.w_down = (const float*)d_in[16];
    p.out = (float*)d_out; p.ws = (unsigned char*)d_ws;
#if ONE_LAUNCH
    p.ph_lo = 0; p.ph_hi = N_PHASES;
    void* args[] = {&p};
    hipError_t e = hipLaunchCooperativeKernel((const void*)fwd_kernel, dim3(256), dim3(512), args, LDS_BYTES, stream);
    if (e != hipSuccess) fprintf(stderr, "kernel_launch: cooperative launch failed: %s\n", hipGetErrorString(e));
#else
    for (int ph = 0; ph < N_PHASES; ++ph) {
        p.ph_lo = ph; p.ph_hi = ph + 1;
        hipLaunchKernelGGL(fwd_kernel, dim3(256), dim3(512), LDS_BYTES, stream, p);
    }
#endif
}
```

```cpp
#include <hip/hip_runtime.h>
#include <hip/hip_cooperative_groups.h>
#include <cstdio>
#include <cstdint>
namespace cg = cooperative_groups;
namespace pg8 {
#define PG8_LAS __attribute__((address_space(3)))
typedef unsigned short bf16_t;
typedef short bf16x8 __attribute__((ext_vector_type(8)));
typedef float f32x4 __attribute__((ext_vector_type(4)));
typedef unsigned u32x4 __attribute__((ext_vector_type(4)));
constexpr int BM = 256, BK = 64, HALF = 128, HTB = HALF * BK * 2  , STAGE_BYTES = 8 * HTB, NXCD = 8, WGM = 8;

__host__ __device__ __forceinline__ int lds_byte(int r, int c) { const int st = (r >> 4) * 2 + (c >> 5), rr = r & 15, cc = c & 31, ob = rr * 64 + cc * 2; return st * 1024 + (ob ^ (((ob >> 9) & 1) << 5)); }
__host__ __device__ __forceinline__ void stage_rc(int b, int& R, int& C) { const int st = b / 1024, sb = b % 1024, swz = sb ^ (((sb >> 9) & 1) << 5); R = (st >> 1) * 16 + swz / 64; C = (st & 1) * 32 + (swz % 64) / 2; }
__host__ __device__ __forceinline__ int perm32(int rho) { const int n = rho >> 4, i = rho & 15; return 8 * (i >> 2) + 4 * n + (i & 3); }

struct Unit { int pm, pn; };
struct Gemm { const bf16_t* A; const bf16_t* Bt; int M, N, K; };

struct StaticOrder {
    int nM, nN, nwg, G, c;
    __host__ __device__ void init(int M, int N, int G_, int c_) { nM = M / BM; nN = N / BM; nwg = nM * nN; G = G_; c = c_; }
    __host__ __device__ bool next(int i, Unit& u) const {
        const long L = (long)i * G + c; if (L >= nwg) return false;
        int wgid = (int)L; { const int q = nwg / NXCD, r = nwg % NXCD, xcd = wgid % NXCD, off = wgid / NXCD; wgid = (xcd < r ? xcd * (q + 1) : r * (q + 1) + (xcd - r) * q) + off; }
        const int nig = WGM * nN, gid = wgid / nig, fm = gid * WGM, gsz = (nM - fm) < WGM ? (nM - fm) : WGM;
        u.pm = fm + ((wgid % nig) % gsz); u.pn = (wgid % nig) / gsz; return true;
    }
    __device__ __forceinline__ void a_ready(const Unit&) const {}
    __device__ __forceinline__ void done(const Unit&) const {}
};

typedef float f32x2c __attribute__((ext_vector_type(2)));
typedef __bf16 bf16x2c __attribute__((ext_vector_type(2)));
__device__ __forceinline__ unsigned cvt_pk_bf16(float lo, float hi) { const f32x2c v = {lo, hi}; const bf16x2c b = __builtin_convertvector(v, bf16x2c); return __builtin_bit_cast(unsigned, b); }
__device__ __forceinline__ float bf_lo(unsigned w) { return __uint_as_float(w << 16); }
__device__ __forceinline__ float bf_hi(unsigned w) { return __uint_as_float(w & 0xffff0000u); }
__device__ __forceinline__ float sigm(float v) { return __builtin_amdgcn_rcpf(1.0f + __expf(-v)); }

__device__ __forceinline__ void row_rstd8(const float* sumsq, const Unit& u, int wr, int fr, int fq, float (&rs)[2][4]) {
#pragma unroll
    for (int ai = 0; ai < 2; ++ai)
#pragma unroll
        for (int m = 0; m < 4; ++m) {
            const int row = u.pm * BM + ai * HALF + wr * 64 + m * 16 + fr;
            const f32x4 v = *(const f32x4*)(sumsq + (size_t)row * 16 + fq * 4);
            float s = (v[0] + v[1]) + (v[2] + v[3]);
            s += __shfl_xor(s, 16); s += __shfl_xor(s, 32);
            rs[ai][m] = rsqrtf(s * (1.0f / 1024.0f) + 1e-6f);
            if (m == 3) asm volatile("" ::: "memory");
        }
}

struct EpiIn {
    static constexpr bool PERM = true, AFTER_DRAIN = false;
    const float* sumsq; bf16_t *HQ, *NQ, *KV, *NG, *SGA, *VST, *VWT;
    __device__ __forceinline__ void operator()(const f32x4 (&acc)[2][2][4][2], const Unit& u, int wr, int wc, int fr, int fq) const {
        float rs[2][4]; row_rstd8(sumsq, u, wr, fr, fq, rs);
        const int pn = u.pn; bf16_t* base; int ldc, colt; bool sg = false;
        if (pn < 8) { base = HQ + (size_t)(pn >> 1) * ((size_t)65536 * 512); ldc = 512; colt = (pn & 1) * 256; }
        else if (pn < 10) { base = NQ; ldc = 512; colt = (pn - 8) * 256; }
        else if (pn < 13) { base = KV; ldc = 768; colt = (pn - 10) * 256; }
        else if (pn == 13) { base = NG; ldc = 256; colt = 0; sg = true; }
        else { const int q = pn - 14; base = SGA + (size_t)(q >> 2) * ((size_t)65536 * 1024); ldc = 1024; colt = (q & 3) * 256; sg = true; }
        const int col0 = colt + wc * 32 + 8 * fq;
        bf16_t* vt = (pn == 11) ? VST : ((pn == 12) ? VWT : nullptr);
#pragma unroll
        for (int ai = 0; ai < 2; ++ai)
#pragma unroll
            for (int m = 0; m < 4; ++m) {
                const int row = u.pm * BM + ai * HALF + wr * 64 + m * 16 + fr;
                bf16_t* rowp = base + (size_t)row * ldc + col0; const float r = rs[ai][m];
#pragma unroll
                for (int bj = 0; bj < 2; ++bj) {
                    f32x4 v0 = acc[ai][bj][m][0] * r, v1 = acc[ai][bj][m][1] * r;
                    if (sg) {
#pragma unroll
                        for (int e = 0; e < 4; ++e) { v0[e] = sigm(v0[e]); v1[e] = sigm(v1[e]); }
                    }
                    u32x4 w; w.x = cvt_pk_bf16(v0[0], v0[1]); w.y = cvt_pk_bf16(v0[2], v0[3]); w.z = cvt_pk_bf16(v1[0], v1[1]); w.w = cvt_pk_bf16(v1[2], v1[3]);
                    *(u32x4*)(rowp + bj * HALF) = w;
                    if (vt != nullptr && bj == 1) {
                        const int cv = wc * 32 + 8 * fq, g = cv >> 6, d0 = cv & 63, b = row >> 12, t = row & 4095;
                        bf16_t* tp = vt + (((size_t)(b * 2 + g) * 64 + d0) << 12) + t;
                        tp[0 * 4096] = (bf16_t)(w.x & 0xffffu); tp[1 * 4096] = (bf16_t)(w.x >> 16); tp[2 * 4096] = (bf16_t)(w.y & 0xffffu); tp[3 * 4096] = (bf16_t)(w.y >> 16);
                        tp[4 * 4096] = (bf16_t)(w.z & 0xffffu); tp[5 * 4096] = (bf16_t)(w.z >> 16); tp[6 * 4096] = (bf16_t)(w.w & 0xffffu); tp[7 * 4096] = (bf16_t)(w.w >> 16);
                    }
                }
                asm volatile("" ::: "memory");
            }
    }
};

template <bool ACCUM> struct EpiMix {
    static constexpr bool PERM = true, AFTER_DRAIN = false;
    const bf16_t* gate; bf16_t* mixed;
    __device__ __forceinline__ void operator()(const f32x4 (&acc)[2][2][4][2], const Unit& u, int wr, int wc, int fr, int fq) const {
        const int col0 = u.pn * BM + wc * 32 + 8 * fq;
#pragma unroll
        for (int ai = 0; ai < 2; ++ai)
#pragma unroll
            for (int m = 0; m < 4; ++m) {
                const size_t off = (size_t)(u.pm * BM + ai * HALF + wr * 64 + m * 16 + fr) * 1024 + col0;
#pragma unroll
                for (int bj = 0; bj < 2; ++bj) {
                    const u32x4 gq = *(const u32x4*)(gate + off + bj * HALF);
                    f32x4 v0 = acc[ai][bj][m][0], v1 = acc[ai][bj][m][1];
                    v0[0] *= bf_lo(gq.x); v0[1] *= bf_hi(gq.x); v0[2] *= bf_lo(gq.y); v0[3] *= bf_hi(gq.y);
                    v1[0] *= bf_lo(gq.z); v1[1] *= bf_hi(gq.z); v1[2] *= bf_lo(gq.w); v1[3] *= bf_hi(gq.w);
                    if (ACCUM) {
                        const u32x4 mq = *(const u32x4*)(mixed + off + bj * HALF);
                        v0[0] += bf_lo(mq.x); v0[1] += bf_hi(mq.x); v0[2] += bf_lo(mq.y); v0[3] += bf_hi(mq.y);
                        v1[0] += bf_lo(mq.z); v1[1] += bf_hi(mq.z); v1[2] += bf_lo(mq.w); v1[3] += bf_hi(mq.w);
                    }
                    u32x4 w; w.x = cvt_pk_bf16(v0[0], v0[1]); w.y = cvt_pk_bf16(v0[2], v0[3]); w.z = cvt_pk_bf16(v1[0], v1[1]); w.w = cvt_pk_bf16(v1[2], v1[3]);
                    *(u32x4*)(mixed + off + bj * HALF) = w;
                }
                asm volatile("" ::: "memory");
            }
    }
};

struct EpiRes {
    static constexpr bool PERM = true, AFTER_DRAIN = false;
    const float* xres; float* out; bf16_t* xb; float* sumsq;
    __device__ __forceinline__ void operator()(const f32x4 (&acc)[2][2][4][2], const Unit& u, int wr, int wc, int fr, int fq) const {
        const int col0 = u.pn * BM + wc * 32 + 8 * fq;
#pragma unroll
        for (int ai = 0; ai < 2; ++ai)
#pragma unroll
            for (int m = 0; m < 4; ++m) {
                const int row = u.pm * BM + ai * HALF + wr * 64 + m * 16 + fr;
                const size_t off = (size_t)row * 1024 + col0; float ss = 0.f;
#pragma unroll
                for (int bj = 0; bj < 2; ++bj) {
                    const f32x4 x0 = *(const f32x4*)(xres + off + bj * HALF), x1 = *(const f32x4*)(xres + off + bj * HALF + 4);
                    const f32x4 v0 = acc[ai][bj][m][0] + x0, v1 = acc[ai][bj][m][1] + x1;
                    *(f32x4*)(out + off + bj * HALF) = v0; *(f32x4*)(out + off + bj * HALF + 4) = v1;
                    u32x4 w; w.x = cvt_pk_bf16(v0[0], v0[1]); w.y = cvt_pk_bf16(v0[2], v0[3]); w.z = cvt_pk_bf16(v1[0], v1[1]); w.w = cvt_pk_bf16(v1[2], v1[3]);
                    *(u32x4*)(xb + off + bj * HALF) = w;
                    ss += (v0[0] * v0[0] + v0[1] * v0[1]) + (v0[2] * v0[2] + v0[3] * v0[3]) + (v1[0] * v1[0] + v1[1] * v1[1]) + (v1[2] * v1[2] + v1[3] * v1[3]);
                }
                ss += __shfl_xor(ss, 16); ss += __shfl_xor(ss, 32);
                if (fq == 0) sumsq[(size_t)row * 16 + u.pn * 4 + wc] = ss;
                asm volatile("" ::: "memory");
            }
    }
};

struct EpiUp {
    static constexpr bool PERM = true, AFTER_DRAIN = false;
    const float* sumsq; bf16_t* hid;
    __device__ __forceinline__ void operator()(const f32x4 (&acc)[2][2][4][2], const Unit& u, int wr, int wc, int fr, int fq) const {
        float rs[2][4]; row_rstd8(sumsq, u, wr, fr, fq, rs);
        const int col0 = u.pn * BM + wc * 32 + 8 * fq;
#pragma unroll
        for (int ai = 0; ai < 2; ++ai)
#pragma unroll
            for (int m = 0; m < 4; ++m) {
                bf16_t* rowp = hid + (size_t)(u.pm * BM + ai * HALF + wr * 64 + m * 16 + fr) * 4096 + col0; const float r = rs[ai][m];
#pragma unroll
                for (int bj = 0; bj < 2; ++bj) {
                    f32x4 v0 = acc[ai][bj][m][0] * r, v1 = acc[ai][bj][m][1] * r;
#pragma unroll
                    for (int e = 0; e < 4; ++e) { const float a = fmaxf(v0[e], 0.f), b = fmaxf(v1[e], 0.f); v0[e] = a * a; v1[e] = b * b; }
                    u32x4 w; w.x = cvt_pk_bf16(v0[0], v0[1]); w.y = cvt_pk_bf16(v0[2], v0[3]); w.z = cvt_pk_bf16(v1[0], v1[1]); w.w = cvt_pk_bf16(v1[2], v1[3]);
                    *(u32x4*)(rowp + bj * HALF) = w;
                }
                asm volatile("" ::: "memory");
            }
    }
};

template <class Epi, class Sched, bool ALIGN_EPI = false, bool SP2 = false>
__device__ __forceinline__ void gemm_phase(PG8_LAS unsigned char* lds, const Gemm g, const Sched& S, const Epi& E) {
    int tid_ = threadIdx.x; asm volatile("" : "+v"(tid_));
    const int tid = tid_, wid = __builtin_amdgcn_readfirstlane(tid >> 6), lane = tid & 63, wr = wid >> 2, wc = wid & 3, fr = lane & 15, fq = lane >> 4;
    const int K = g.K, nt = K / BK;
    unsigned voffA[2], voffB[2];
#pragma unroll
    for (int i = 0; i < 2; ++i) { int R, C; stage_rc(tid * 16 + i * 8192, R, C); const int Rb = Epi::PERM ? ((R & ~31) + perm32(R & 31)) : R;
        voffA[i] = (unsigned)(R * K + C) * 2u; voffB[i] = (unsigned)(Rb * K + C) * 2u; }
    const size_t kstep = (size_t)(BK * 2);
    const size_t hstep = (size_t)HALF * K * 2;
    const size_t tstep = 2 * hstep;
    const unsigned ldsw = (unsigned)wid * 1024u;
    const int aoff = lds_byte(wr * 64 + fr, fq * 8), boff = lds_byte(wc * 32 + fr, fq * 8);
#define PG8_SA(b, h) (((b) * 2 + (h)) * HTB)
#define PG8_SB(b, h) ((4 + (b) * 2 + (h)) * HTB)
#define PG8_STAGE(bufoff, gbase, voff) do { _Pragma("unroll") for (int _i = 0; _i < 2; ++_i) \
        __builtin_amdgcn_global_load_lds((const unsigned*)((const char*)(gbase) + (voff)[_i]), (PG8_LAS unsigned*)(lds + (bufoff) + ldsw + _i * 8192), 16, 0, 0); } while (0)
#define PG8_LDA(dst, b, h) do { _Pragma("unroll") for (int m = 0; m < 4; ++m) _Pragma("unroll") for (int k = 0; k < 2; ++k) dst[m][k] = *(const PG8_LAS bf16x8*)(lds + PG8_SA(b, h) + aoff + m * 2048 + k * 1024); } while (0)
#define PG8_LDB(dst, b, h) do { _Pragma("unroll") for (int n = 0; n < 2; ++n) _Pragma("unroll") for (int k = 0; k < 2; ++k) dst[n][k] = *(const PG8_LAS bf16x8*)(lds + PG8_SB(b, h) + boff + n * 2048 + k * 1024); } while (0)
#define PG8_MMA(ai, bj, At, Bt) do { __builtin_amdgcn_s_setprio(1); _Pragma("unroll") for (int m = 0; m < 4; ++m) _Pragma("unroll") for (int n = 0; n < 2; ++n) _Pragma("unroll") for (int k = 0; k < 2; ++k) \
        acc[ai][bj][m][n] = __builtin_amdgcn_mfma_f32_16x16x32_bf16(Bt[n][k], At[m][k], acc[ai][bj][m][n], 0, 0, 0); __builtin_amdgcn_s_setprio(0); } while (0)
#define PG8_WAIT_V(n) asm volatile("s_waitcnt vmcnt(" #n ")" ::: "memory")
#define PG8_WAIT_L(n) asm volatile("s_waitcnt lgkmcnt(" #n ")" ::: "memory")
#define PG8_BAR __builtin_amdgcn_s_barrier()
#define PG8_SCHED __builtin_amdgcn_sched_barrier(0)
    Unit cur, nxt; int ui = 0;
    if (!S.next(0, cur)) return;
    f32x4 acc[2][2][4][2];
#pragma unroll
    for (int a = 0; a < 2; ++a)
#pragma unroll
        for (int b = 0; b < 2; ++b)
#pragma unroll
            for (int m = 0; m < 4; ++m)
#pragma unroll
                for (int n = 0; n < 2; ++n) acc[a][b][m][n] = (f32x4){0.f, 0.f, 0.f, 0.f};
    bf16x8 At[4][2], B0[2][2], B1[2][2];
    const char* cA = (const char*)g.A + (size_t)cur.pm * tstep; const char* cB = (const char*)g.Bt + (size_t)cur.pn * tstep;
    S.a_ready(cur);
    if constexpr (SP2) {
        PG8_STAGE(PG8_SB(0, 0), cB, voffB); PG8_STAGE(PG8_SB(0, 1), cB + hstep, voffB); PG8_STAGE(PG8_SA(0, 0), cA, voffA); PG8_STAGE(PG8_SA(0, 1), cA + hstep, voffA);
        if (wr == 1) PG8_BAR;
        PG8_WAIT_V(2); PG8_BAR;
        PG8_STAGE(PG8_SB(1, 0), cB + kstep, voffB); PG8_STAGE(PG8_SA(1, 0), cA + kstep, voffA); PG8_STAGE(PG8_SB(1, 1), cB + hstep + kstep, voffB);
        PG8_WAIT_V(6); PG8_BAR;
    } else {
        PG8_STAGE(PG8_SB(0, 0), cB, voffB); PG8_STAGE(PG8_SA(0, 0), cA, voffA); PG8_STAGE(PG8_SB(0, 1), cB + hstep, voffB); PG8_STAGE(PG8_SA(0, 1), cA + hstep, voffA);
        if (wr == 1) PG8_BAR;
        PG8_WAIT_V(4); PG8_BAR;
        PG8_STAGE(PG8_SB(1, 0), cB + kstep, voffB); PG8_STAGE(PG8_SA(1, 0), cA + kstep, voffA); PG8_STAGE(PG8_SB(1, 1), cB + hstep + kstep, voffB);
        PG8_WAIT_V(6); PG8_BAR;
    }
    for (;;) {
        const bool has_next = S.next(ui + 1, nxt);
        const char* nA = has_next ? (const char*)g.A + (size_t)nxt.pm * tstep : cA; const char* nB = has_next ? (const char*)g.Bt + (size_t)nxt.pn * tstep : cB;
        for (int t = 0; t < nt; t += 2) {
            const bool last = (t == nt - 2);
            const char* a1 = cA + (size_t)(t + 1) * kstep;
            const char* a2 = last ? nA : cA + (size_t)(t + 2) * kstep; const char* b2 = last ? nB : cB + (size_t)(t + 2) * kstep;
            const char* a3 = a2 + kstep; const char* b3 = b2 + kstep;
            if (last && has_next) S.a_ready(nxt);
            if constexpr (SP2) {
            PG8_LDB(B0, 0, 0); PG8_LDB(B1, 0, 1); PG8_SCHED; PG8_LDA(At, 0, 0); PG8_STAGE(PG8_SA(1, 1), a1 + hstep, voffA);
            PG8_WAIT_V(8); PG8_WAIT_L(0); PG8_BAR; PG8_MMA(0, 0, At, B0); PG8_MMA(0, 1, At, B1); PG8_BAR; PG8_SCHED;
            PG8_LDA(At, 0, 1); PG8_STAGE(PG8_SB(0, 0), b2, voffB); PG8_STAGE(PG8_SB(0, 1), b2 + hstep, voffB); PG8_STAGE(PG8_SA(0, 0), a2, voffA);
            PG8_WAIT_V(8); PG8_WAIT_L(0); PG8_BAR; PG8_MMA(1, 0, At, B0); PG8_MMA(1, 1, At, B1); PG8_BAR; PG8_SCHED;
            PG8_LDB(B0, 1, 0); PG8_LDB(B1, 1, 1); PG8_SCHED; PG8_LDA(At, 1, 0); PG8_STAGE(PG8_SA(0, 1), a2 + hstep, voffA);
            PG8_WAIT_V(8); PG8_WAIT_L(0); PG8_BAR; PG8_MMA(0, 0, At, B0); PG8_MMA(0, 1, At, B1); PG8_BAR; PG8_SCHED;
            PG8_LDA(At, 1, 1); PG8_STAGE(PG8_SB(1, 0), b3, voffB); PG8_STAGE(PG8_SB(1, 1), b3 + hstep, voffB); PG8_STAGE(PG8_SA(1, 0), a3, voffA);
            PG8_WAIT_V(8); PG8_WAIT_L(0); PG8_BAR; PG8_MMA(1, 0, At, B0); PG8_MMA(1, 1, At, B1); PG8_BAR; PG8_SCHED;
            } else {
            PG8_LDB(B0, 0, 0); PG8_SCHED; PG8_LDA(At, 0, 0); PG8_STAGE(PG8_SA(1, 1), a1 + hstep, voffA);
            PG8_WAIT_L(8); PG8_BAR; PG8_WAIT_L(0); PG8_MMA(0, 0, At, B0); PG8_BAR; PG8_SCHED;
            PG8_LDB(B1, 0, 1); PG8_STAGE(PG8_SB(0, 0), b2, voffB);
            PG8_BAR; PG8_WAIT_L(0); PG8_MMA(0, 1, At, B1); PG8_BAR;
            PG8_LDA(At, 0, 1); PG8_STAGE(PG8_SA(0, 0), a2, voffA);
            PG8_BAR; PG8_WAIT_L(0); PG8_MMA(1, 0, At, B0); PG8_BAR; PG8_SCHED;
            PG8_STAGE(PG8_SB(0, 1), b2 + hstep, voffB);
            PG8_WAIT_V(6); PG8_BAR; PG8_MMA(1, 1, At, B1); PG8_BAR;
            PG8_LDB(B0, 1, 0); PG8_SCHED; PG8_LDA(At, 1, 0); PG8_STAGE(PG8_SA(0, 1), a2 + hstep, voffA);
            PG8_WAIT_L(8); PG8_BAR; PG8_WAIT_L(0); PG8_MMA(0, 0, At, B0); PG8_BAR; PG8_SCHED;
            PG8_LDB(B1, 1, 1); PG8_STAGE(PG8_SB(1, 0), b3, voffB);
            PG8_BAR; PG8_WAIT_L(0); PG8_MMA(0, 1, At, B1); PG8_BAR;
            PG8_LDA(At, 1, 1); PG8_STAGE(PG8_SA(1, 0), a3, voffA);
            PG8_BAR; PG8_WAIT_L(0); PG8_MMA(1, 0, At, B0); PG8_BAR; PG8_SCHED;
            PG8_STAGE(PG8_SB(1, 1), b3 + hstep, voffB);
            PG8_WAIT_V(6); PG8_BAR; PG8_MMA(1, 1, At, B1); PG8_BAR;
            }
        }
        if constexpr (ALIGN_EPI) { if (wr == 0) PG8_BAR; }
        if constexpr (!Epi::AFTER_DRAIN) { E(acc, cur, wr, wc, fr, fq); S.done(cur); }
        if (!has_next) break;
#pragma unroll
        for (int a = 0; a < 2; ++a)
#pragma unroll
            for (int b = 0; b < 2; ++b)
#pragma unroll
                for (int m = 0; m < 4; ++m)
#pragma unroll
                    for (int n = 0; n < 2; ++n) acc[a][b][m][n] = (f32x4){0.f, 0.f, 0.f, 0.f};
        cur = nxt; cA = nA; cB = nB; ++ui;
        if constexpr (ALIGN_EPI) { if (wr == 1) PG8_BAR; }
    }
    PG8_WAIT_V(0);
    if constexpr (!ALIGN_EPI) { if (wr == 0) PG8_BAR; }
    PG8_BAR;
    if constexpr (Epi::AFTER_DRAIN) { E.fused(acc, cur, wr, wc, fr, fq, lds, wid, lane); S.done(cur); }
#undef PG8_SA
#undef PG8_SB
#undef PG8_STAGE
#undef PG8_LDA
#undef PG8_LDB
#undef PG8_MMA
#undef PG8_WAIT_V
#undef PG8_WAIT_L
#undef PG8_BAR
#undef PG8_SCHED
}
}

#define LAS __attribute__((address_space(3)))
typedef unsigned short bf16_t;
typedef short bf16x8 __attribute__((ext_vector_type(8)));
typedef short bf16x4 __attribute__((ext_vector_type(4)));
typedef float f32x4 __attribute__((ext_vector_type(4)));
typedef unsigned u32x4 __attribute__((ext_vector_type(4)));
typedef unsigned u32x2 __attribute__((ext_vector_type(2)));
using pg8::cvt_pk_bf16; using pg8::bf_lo; using pg8::bf_hi; using pg8::sigm;

constexpr int T_TOK = 65536, DM = 1024, SEQ = 4096, NB = 16, DFF = 4096, NP_IN = 5632, IN_COLS = 5400;
constexpr int LDS_BYTES = 147456;
constexpr size_t MiB = (size_t)1 << 20;
constexpr size_t WS_CBIAS = 1 * MiB, WS_CW2T = 1 * MiB + 65536;
constexpr size_t WS_WIN = 2 * MiB, WS_WA = 24 * MiB, WS_WB = 26 * MiB, WS_WO = 28 * MiB, WS_WUP = 32 * MiB, WS_WDN = 48 * MiB, WS_CW1T = 64 * MiB;
constexpr size_t WS_SUMSQ = 66 * MiB, WS_KCMP = 70 * MiB, WS_VCMPT = 71 * MiB, WS_VST = 72 * MiB, WS_VWT = 88 * MiB, WS_XB = 104 * MiB;
constexpr size_t WS_HQ = 232 * MiB, WS_HF = 296 * MiB, WS_HI = 360 * MiB, WS_HG = 424 * MiB, WS_NQ = 488 * MiB, WS_KV = 552 * MiB, WS_NG = 648 * MiB, WS_SGA = 680 * MiB, WS_SGB = 808 * MiB;
constexpr size_t WS_MIXED = 232 * MiB, WS_HID = 232 * MiB, WS_EX = 936 * MiB, WS_END = 942 * MiB;
constexpr size_t EX_H = 0, EX_PP = 1 * MiB, EX_OAB = 2 * MiB + 524288, EX_YP = EX_OAB + 65536, EX_XP = EX_OAB + 524288, EX_UP = 3 * MiB + 524288, EX_DP = 4 * MiB + 524288;

struct Params {
    const float *x, *rel_bias, *lb_logits, *norm_mix, *w_in, *hg_gain, *qk_gain, *cmp_pos, *cmp_w1, *cmp_b1, *cmp_w2, *w_a, *w_b, *w_out, *norm_mlp, *w_up, *w_down;
    float* out; unsigned char* ws; int ph_lo, ph_hi;
};

__device__ __forceinline__ bf16x8 lds_ld8(const LAS unsigned char* p) { return *(const LAS bf16x8*)p; }
__device__ __forceinline__ bf16x8 lds_ld4x2(const LAS unsigned char* p0, const LAS unsigned char* p1) {
    const bf16x4 a = *(const LAS bf16x4*)p0, b = *(const LAS bf16x4*)p1; bf16x8 r;
    r[0] = a[0]; r[1] = a[1]; r[2] = a[2]; r[3] = a[3]; r[4] = b[0]; r[5] = b[1]; r[6] = b[2]; r[7] = b[3]; return r;
}
__device__ __forceinline__ bf16x8 pack8(const f32x4& a, const f32x4& b) {
    u32x4 w; w.x = cvt_pk_bf16(a[0], a[1]); w.y = cvt_pk_bf16(a[2], a[3]); w.z = cvt_pk_bf16(b[0], b[1]); w.w = cvt_pk_bf16(b[2], b[3]);
    return __builtin_bit_cast(bf16x8, w);
}
__device__ __forceinline__ unsigned short bf1(float v) { return (unsigned short)(cvt_pk_bf16(v, 0.f) & 0xffffu); }
__device__ __forceinline__ float bfu(unsigned short h) { return __uint_as_float(((unsigned)h) << 16); }
__device__ __forceinline__ int tid_opaque() { int t = threadIdx.x; asm volatile("" : "+v"(t)); return t; }
#define MFMA16(a, b, c) __builtin_amdgcn_mfma_f32_16x16x32_bf16((a), (b), (c), 0, 0, 0)

__device__ __forceinline__ float block_sum(float v, LAS float* red, int tid);
__device__ __forceinline__ void conv_matrix(const float* W, int K, int N, bf16_t* WT, const float* scale, int nshift_from, int nshift, LAS unsigned char* lds) {
    LAS float* tile = (LAS float*)lds;
    const int tid = tid_opaque(), nnb = (N + 63) / 64, items = (K / 64) * nnb;
#pragma unroll 1
    for (int it = blockIdx.x; it < items; it += gridDim.x) {
        const int kb = it / nnb, nb = it % nnb, k0 = kb * 64, n0 = nb * 64;
#pragma unroll
        for (int i = 0; i < 8; ++i) {
            const int k = i * 8 + (tid >> 6), n = tid & 63;
            float v = 0.f;
            if (n0 + n < N) { v = W[(size_t)(k0 + k) * N + n0 + n]; if (scale) v *= scale[k0 + k]; }
            tile[k * 65 + n] = v;
        }
        __syncthreads();
        {
            const int n = tid >> 3, kc = tid & 7;
            if (n0 + n < N) {
                const LAS float* s = tile + (kc * 8) * 65 + n;
                u32x4 o; o.x = cvt_pk_bf16(s[0], s[65]); o.y = cvt_pk_bf16(s[2 * 65], s[3 * 65]); o.z = cvt_pk_bf16(s[4 * 65], s[5 * 65]); o.w = cvt_pk_bf16(s[6 * 65], s[7 * 65]);
                int nn = n0 + n; if (nn >= nshift_from) nn += nshift;
                *(u32x4*)(WT + (size_t)nn * K + k0 + kc * 8) = o;
            }
        }
        __syncthreads();
    }
}

__device__ __forceinline__ void prologue(const Params& p, LAS unsigned char* lds) {
    unsigned char* ws = p.ws;
    const int tid = tid_opaque(), lane = tid & 63, wave = tid >> 6;
#pragma unroll 1
    for (int mj = 0; mj < 20; ++mj) {
        const int l = mj / 10, m = mj % 10;
        const float* W; int K, N; bf16_t* WT; const float* scale = nullptr; int sfrom = 1 << 30, sh = 0;
        if (m == 0) { W = p.w_in + (size_t)l * DM * IN_COLS; K = DM; N = IN_COLS; WT = (bf16_t*)(ws + WS_WIN) + (size_t)l * NP_IN * DM; scale = p.norm_mix + l * DM; sfrom = 3352; sh = 232; }
        else if (m == 1) { W = p.w_a + (size_t)l * 512 * DM; K = 512; N = DM; WT = (bf16_t*)(ws + WS_WA) + (size_t)l * DM * 512; }
        else if (m == 2) { W = p.w_b + (size_t)l * 512 * DM; K = 512; N = DM; WT = (bf16_t*)(ws + WS_WB) + (size_t)l * DM * 512; }
        else if (m == 3) { W = p.w_out + (size_t)l * DM * DM; K = DM; N = DM; WT = (bf16_t*)(ws + WS_WO) + (size_t)l * DM * DM; }
        else if (m == 4) { W = p.w_up + (size_t)l * DM * DFF; K = DM; N = DFF; WT = (bf16_t*)(ws + WS_WUP) + (size_t)l * DFF * DM; scale = p.norm_mlp + l * DM; }
        else if (m == 5) { W = p.w_down + (size_t)l * DFF * DM; K = DFF; N = DM; WT = (bf16_t*)(ws + WS_WDN) + (size_t)l * DM * DFF; }
        else if (m < 8) { const int j = m - 6; W = p.cmp_w1 + (size_t)(l * 2 + j) * 2048 * 128; K = 2048; N = 128; WT = (bf16_t*)(ws + WS_CW1T) + (size_t)(l * 2 + j) * 128 * 2048; }
        else { const int j = m - 8; W = p.cmp_w2 + (size_t)(l * 2 + j) * 128 * 64; K = 128; N = 64; WT = (bf16_t*)(ws + WS_CW2T) + (size_t)(l * 2 + j) * 64 * 128; }
        conv_matrix(W, K, N, WT, scale, sfrom, sh, lds);
    }
    for (int l = 0; l < 2; ++l) {
        u32x4* z = (u32x4*)((bf16_t*)(ws + WS_WIN) + (size_t)l * NP_IN * DM + (size_t)3352 * DM);
        for (int i = blockIdx.x * 512 + tid; i < 232 * DM / 8; i += gridDim.x * 512) z[i] = (u32x4){0u, 0u, 0u, 0u};
    }
    if (blockIdx.x < 4) {
        const int lj = blockIdx.x, n = tid & 127, kq = tid >> 7;
        const float* W1 = p.cmp_w1 + (size_t)lj * 2048 * 128; const float* pos = p.cmp_pos + (size_t)lj * 2048;
        float s = 0.f;
#pragma unroll 4
        for (int k = kq * 512; k < kq * 512 + 512; ++k) s += pos[k] * W1[(size_t)k * 128 + n];
        LAS float* red = (LAS float*)(lds + 32768);
        red[kq * 128 + n] = s;
        __syncthreads();
        if (tid < 128) ((float*)(ws + WS_CBIAS))[lj * 128 + tid] = p.cmp_b1[lj * 128 + tid] + (red[tid] + red[128 + tid]) + (red[256 + tid] + red[384 + tid]);
        __syncthreads();
    }
    if (blockIdx.x >= 16 && blockIdx.x < 32) {
        const int r = blockIdx.x - 16; float* EH = (float*)(ws + WS_EX + EX_H);
        const float xa = p.x[(size_t)r * SEQ * DM + tid], xb2 = p.x[(size_t)r * SEQ * DM + 512 + tid];
        const float ss = block_sum(xa * xa + xb2 * xb2, (LAS float*)(lds + 32768), tid);
        const float rstd = rsqrtf(ss * (1.0f / 1024.0f) + 1e-6f);
        EH[r * 1024 + tid] = xa * rstd * p.norm_mix[tid]; EH[r * 1024 + 512 + tid] = xb2 * rstd * p.norm_mix[512 + tid];
        __syncthreads();
    }
    {
        bf16_t* xb = (bf16_t*)(ws + WS_XB); float* sumsq = (float*)(ws + WS_SUMSQ);
#pragma unroll 1
        for (int row = blockIdx.x * 8 + wave; row < T_TOK; row += gridDim.x * 8) {
            const f32x4* xr = (const f32x4*)(p.x + (size_t)row * DM) + lane;
            f32x4 v[4]; float s = 0.f;
#pragma unroll
            for (int j = 0; j < 4; ++j) { v[j] = xr[64 * j]; s += (v[j][0] * v[j][0] + v[j][1] * v[j][1]) + (v[j][2] * v[j][2] + v[j][3] * v[j][3]); }
#pragma unroll
            for (int o = 1; o < 64; o <<= 1) s += __shfl_xor(s, o);
            u32x2* o8 = (u32x2*)(xb + (size_t)row * DM) + lane;
#pragma unroll
            for (int j = 0; j < 4; ++j) { u32x2 w; w.x = cvt_pk_bf16(v[j][0], v[j][1]); w.y = cvt_pk_bf16(v[j][2], v[j][3]); o8[64 * j] = w; }
            if (lane < 16) sumsq[(size_t)row * 16 + lane] = (lane == 0) ? s : 0.f;
        }
    }
}

template <class InFn>
__device__ __forceinline__ void exact_stage(const float* W0, const float* W1, int wsplit, int K, int N, float* part, InFn in_fn, LAS unsigned char* lds) {
    const int tid = tid_opaque(), lane = tid & 63, wave = tid >> 6;
    const int nsl = K / 256, ncg = (N + 511) / 512, ntasks = nsl * ncg;
    LAS float* IN = (LAS float*)lds;
#pragma unroll 1
    for (int task = blockIdx.x; task < ntasks; task += gridDim.x) {
        const int sl = task % nsl, cg = task / nsl;
        __syncthreads();
#pragma unroll 1
        for (int idx = tid; idx < 4096; idx += 512) IN[idx] = in_fn(idx >> 8, sl * 256 + (idx & 255));
        __syncthreads();
        const int col = (cg * 8 + wave) * 64 + lane;
        if (col < N) {
            const float* Wp = ((sl < wsplit) ? W0 + (size_t)sl * 256 * N : W1 + (size_t)(sl - wsplit) * 256 * N) + col;
            float acc[16];
#pragma unroll
            for (int r = 0; r < 16; ++r) acc[r] = 0.f;
#pragma unroll 2
            for (int k = 0; k < 256; k += 4) {
                const float w0 = Wp[(size_t)k * N], w1 = Wp[(size_t)(k + 1) * N], w2 = Wp[(size_t)(k + 2) * N], w3 = Wp[(size_t)(k + 3) * N];
#pragma unroll
                for (int r = 0; r < 16; ++r) { const f32x4 v = *(const LAS f32x4*)(IN + r * 256 + k); acc[r] += (v[0] * w0 + v[1] * w1) + (v[2] * w2 + v[3] * w3); }
            }
#pragma unroll
            for (int r = 0; r < 16; ++r) part[((size_t)sl * 16 + r) * N + col] = acc[r];
        }
    }
    __syncthreads();
}
__device__ __forceinline__ float block_sum(float v, LAS float* red, int tid) {
#pragma unroll
    for (int o = 1; o < 64; o <<= 1) v += __shfl_xor(v, o);
    __syncthreads();
    if ((tid & 63) == 0) red[tid >> 6] = v;
    __syncthreads();
    float s = 0.f;
#pragma unroll
    for (int i = 0; i < 8; ++i) s += red[i];
    return s;
}
__device__ __forceinline__ float ex_pp(const float* PP, int r, int c) { return (PP[(size_t)r * IN_COLS + c] + PP[(size_t)(16 + r) * IN_COLS + c]) + (PP[(size_t)(32 + r) * IN_COLS + c] + PP[(size_t)(48 + r) * IN_COLS + c]); }
__device__ __forceinline__ void exact_mixers(const Params& p, int r, LAS unsigned char* lds) {
    const int tid = tid_opaque();
    const float* PP = (const float*)(p.ws + WS_EX + EX_PP); float* OAB = (float*)(p.ws + WS_EX + EX_OAB);
    LAS float* red = (LAS float*)(lds + 32768);
    const int j = tid, h = j >> 7, e = j & 127;
    const float q = ex_pp(PP, r, j), z = ex_pp(PP, r, 512 + j), iv = ex_pp(PP, r, 1024 + j), g = ex_pp(PP, r, 1536 + j);
    float pr = q * (1.0f / (1.0f + __expf(z)));
#pragma unroll
    for (int o = 1; o < 64; o <<= 1) pr += __shfl_xor(pr, o);
    __syncthreads();
    if ((tid & 63) == 0) red[tid >> 6] = pr;
    __syncthreads();
    const float sh = red[2 * h] + red[2 * h + 1];
    const float o = sh * iv;
    float sq = o * o;
#pragma unroll
    for (int o2 = 1; o2 < 64; o2 <<= 1) sq += __shfl_xor(sq, o2);
    __syncthreads();
    if ((tid & 63) == 0) red[tid >> 6] = sq;
    __syncthreads();
    const float rstd = rsqrtf((red[2 * h] + red[2 * h + 1]) * (1.0f / 128.0f) + 1e-6f);
    OAB[(size_t)r * 1024 + j] = o * rstd * p.hg_gain[e] * (g / (1.0f + __expf(-g)));
    const int hh = j >> 6, d = j & 63, gg = hh >> 2, hp = hh & 3;
    const float vs = ex_pp(PP, r, 2944 + gg * 64 + d), vw = ex_pp(PP, r, 3200 + gg * 64 + d);
    const float gs = ex_pp(PP, r, 3328 + gg * 12 + hp * 3 + 1), gw = ex_pp(PP, r, 3328 + gg * 12 + hp * 3 + 2);
    OAB[(size_t)r * 1024 + 512 + j] = vs / (1.0f + __expf(-gs)) + vw / (1.0f + __expf(-gw));
    __syncthreads();
}
__device__ __forceinline__ float ex_x1(const Params& p, int r, int k) {
    const float* XP = (const float*)(p.ws + WS_EX + EX_XP);
    return p.x[(size_t)r * SEQ * DM + k] + ((XP[(size_t)r * 1024 + k] + XP[(size_t)(16 + r) * 1024 + k]) + (XP[(size_t)(32 + r) * 1024 + k] + XP[(size_t)(48 + r) * 1024 + k]));
}
__device__ __forceinline__ float ex_x2(const Params& p, int r, int k) {
    const float* DP = (const float*)(p.ws + WS_EX + EX_DP);
    float s = 0.f;
#pragma unroll
    for (int i = 0; i < 16; ++i) s += DP[((size_t)i * 16 + r) * 1024 + k];
    return ex_x1(p, r, k) + s;
}

constexpr int HG_TOT = 0, HG_DEC = 2048, HG_QB = 2560, HG_QS = HG_QB + 17408, HG_KVER = HG_QS + 17408, HG_KHT = HG_KVER + 43520, HG_VT = HG_KHT + 18432, HG_AM = HG_VT + 4608, HG_END = HG_AM + 9216;
static_assert(HG_END <= LDS_BYTES, "hgrn lds");
__device__ __forceinline__ void hgrn_unit(const Params& p, int layer, int unit, LAS unsigned char* lds) {
    unsigned char* ws = p.ws;
    const int tid = tid_opaque(), lane = tid & 63, wave = tid >> 6, l16 = lane & 15, quad = lane >> 4;
    const int b = unit >> 4, h = (unit >> 2) & 3, sl = unit & 3;
    const int d = tid & 127, tq = tid >> 7;
    const bf16_t* qg = (const bf16_t*)(ws + WS_HQ) + (size_t)b * SEQ * 512 + h * 128 + d;
    const bf16_t* zg = (const bf16_t*)(ws + WS_HF) + (size_t)b * SEQ * 512 + h * 128 + d;
    bf16_t* vg = (bf16_t*)(ws + WS_HI) + (size_t)b * SEQ * 512 + h * 128 + sl * 32;
    float lb = 0.f;
    if (layer == 1) lb = sigm(p.lb_logits[512 + h * 128 + d] - p.lb_logits[h * 128 + d]);
    const float omlb = 1.0f - lb;
    const int vv = tid & 31, sq = tid >> 5;
    const int tt = wave & 3, vt = wave >> 2;
    LAS float* TOT = (LAS float*)(lds + HG_TOT); LAS float* DEC = (LAS float*)(lds + HG_DEC);
    f32x4 S[8];
#pragma unroll
    for (int i = 0; i < 8; ++i) S[i] = (f32x4){0.f, 0.f, 0.f, 0.f};
    float s00;
    {
        LAS float* XR = (LAS float*)(lds + HG_KVER);
        LAS float* red0 = (LAS float*)(lds + HG_TOT);
        const float* nm = p.norm_mix + layer * DM;
        const float xa = (layer == 0) ? p.x[(size_t)b * SEQ * DM + tid] : ex_x2(p, b, tid);
        const float xb2 = (layer == 0) ? p.x[(size_t)b * SEQ * DM + 512 + tid] : ex_x2(p, b, 512 + tid);
        XR[tid] = xa * nm[tid]; XR[512 + tid] = xb2 * nm[512 + tid];
        const float ss = block_sum(xa * xa + xb2 * xb2, red0, tid);
        const float rstd = rsqrtf(ss * (1.0f / 1024.0f) + 1e-6f);
        __syncthreads();
        const float* W = p.w_in + (size_t)layer * DM * IN_COLS + h * 128 + d;
        float q0 = 0.f, z0 = 0.f;
#pragma unroll 4
        for (int k = tq * 256; k < tq * 256 + 256; ++k) { const float hk = XR[k]; q0 += hk * W[(size_t)k * IN_COLS]; z0 += hk * W[(size_t)k * IN_COLS + 512]; }
        LAS float* RED = (LAS float*)(lds + HG_QB);
        RED[tq * 128 + d] = q0; RED[512 + tq * 128 + d] = z0;
        __syncthreads();
        q0 = (RED[d] + RED[128 + d]) + (RED[256 + d] + RED[384 + d]); z0 = (RED[512 + d] + RED[640 + d]) + (RED[768 + d] + RED[896 + d]);
        q0 *= rstd; z0 *= rstd;
        float pr = q0 * (omlb / (1.0f + __expf(z0)));
#pragma unroll
        for (int o = 1; o < 64; o <<= 1) pr += __shfl_xor(pr, o);
        __syncthreads();
        if (lane == 0) RED[wave] = pr;
        __syncthreads();
        s00 = RED[0] + RED[1];
#ifdef DIAG_S00
        if (layer == 1 && tid == 0) atomicMin((unsigned*)(ws + 512), __float_as_uint(fabsf(s00)));
#endif
        __syncthreads();
    }
    typedef unsigned short us2 __attribute__((ext_vector_type(2)));
    us2 qz[16]; unsigned short vr[4];
#pragma unroll
    for (int i = 0; i < 16; ++i) { qz[i].x = qg[(size_t)(16 * tq + i) * 512]; qz[i].y = zg[(size_t)(16 * tq + i) * 512]; }
#pragma unroll
    for (int i = 0; i < 4; ++i) vr[i] = vg[(size_t)(4 * sq + i) * 512 + vv];
    for (int c = 0; c < 64; ++c) {
        float q[16], kk[16], e1[16]; unsigned short vcur[4];
        {
            float prod = 1.f;
#pragma unroll
            for (int i = 0; i < 16; ++i) {
                q[i] = bfu(qz[i].x); const float z = bfu(qz[i].y);
                const float ez = __expf(-z);
                const float inv = __builtin_amdgcn_rcpf(1.0f + ez);
                const float f = lb + omlb * inv;
                kk[i] = omlb * (ez * inv);
                prod *= f; e1[i] = prod;
            }
#pragma unroll
            for (int i = 0; i < 4; ++i) vcur[i] = vr[i];
        }
        TOT[tq * 128 + d] = __logf(fmaxf(e1[15], 1e-37f));
        __syncthreads();
        const float t0 = TOT[d], t1 = TOT[128 + d], t2 = TOT[256 + d], t3 = TOT[384 + d];
        const float r1 = t0, r2 = t0 + t1, r3 = r2 + t2, r4 = r3 + t3;
        const float rJ = (tq == 0) ? 0.f : ((tq == 1) ? r1 : ((tq == 2) ? r2 : r3));
        if (tq == 0) DEC[d] = __expf(r4);
        {
            LAS bf16_t* QB = (LAS bf16_t*)(lds + HG_QB); LAS bf16_t* QS = (LAS bf16_t*)(lds + HG_QS); LAS bf16_t* KV_ = (LAS bf16_t*)(lds + HG_KVER);
            float kh[16], ri[16];
            const float eJ = __expf(rJ), c4 = __expf(r4 - rJ);
#pragma unroll
            for (int i = 0; i < 16; ++i) {
                const int t = 16 * tq + i;
                ri[i] = kk[i] * __builtin_amdgcn_rcpf(fmaxf(e1[i], 1e-30f));
                const float qs = q[i] * e1[i];
                QS[t * 136 + d] = bf1(qs);
                QB[t * 136 + d] = bf1(qs * eJ);
                kh[i] = ri[i] * c4;
            }
#pragma unroll
            for (int I = 0; I < 4; ++I) {
                if (I >= tq) {
                    const float rI = (I == 0) ? 0.f : ((I == 1) ? r1 : ((I == 2) ? r2 : r3));
                    const int voff = (I == 0) ? 0 : ((I == 1) ? 16 : ((I == 2) ? 48 : 96));
                    const float csh = __expf(rI - rJ);
#pragma unroll
                    for (int i = 0; i < 16; ++i) KV_[(voff + 16 * tq + i) * 136 + d] = bf1(ri[i] * csh);
                }
            }
            LAS unsigned char* KHT = lds + HG_KHT;
            u32x4 w0, w1;
            w0.x = cvt_pk_bf16(kh[0], kh[1]); w0.y = cvt_pk_bf16(kh[2], kh[3]); w0.z = cvt_pk_bf16(kh[4], kh[5]); w0.w = cvt_pk_bf16(kh[6], kh[7]);
            w1.x = cvt_pk_bf16(kh[8], kh[9]); w1.y = cvt_pk_bf16(kh[10], kh[11]); w1.z = cvt_pk_bf16(kh[12], kh[13]); w1.w = cvt_pk_bf16(kh[14], kh[15]);
            *(LAS u32x4*)(KHT + d * 144 + tq * 32) = w0; *(LAS u32x4*)(KHT + d * 144 + tq * 32 + 16) = w1;
            LAS unsigned char* VT = lds + HG_VT;
            u32x2 wv; wv.x = (unsigned)vcur[0] | ((unsigned)vcur[1] << 16); wv.y = (unsigned)vcur[2] | ((unsigned)vcur[3] << 16);
            *(LAS u32x2*)(VT + vv * 144 + sq * 8) = wv;
            LAS u32x4* AMz = (LAS u32x4*)(lds + HG_AM);
            AMz[tid] = (u32x4){0u, 0u, 0u, 0u}; if (tid < 64) AMz[512 + tid] = (u32x4){0u, 0u, 0u, 0u};
        }
        __syncthreads();
        if (c + 1 < 64) {
            const size_t ro = (size_t)(c + 1) * 64 * 512;
#pragma unroll
            for (int i = 0; i < 16; ++i) { qz[i].x = qg[ro + (size_t)(16 * tq + i) * 512]; qz[i].y = zg[ro + (size_t)(16 * tq + i) * 512]; }
#pragma unroll
            for (int i = 0; i < 4; ++i) vr[i] = vg[ro + (size_t)(4 * sq + i) * 512 + vv];
        }
        for (int pi = wave; pi < 10; pi += 8) {
            int I, J;
            if (pi == 0) { I = 0; J = 0; } else if (pi < 3) { I = 1; J = pi - 1; } else if (pi < 6) { I = 2; J = pi - 3; } else { I = 3; J = pi - 6; }
            const int voff = (I == 0) ? 0 : ((I == 1) ? 16 : ((I == 2) ? 48 : 96));
            const LAS unsigned char* qa = lds + HG_QS + (16 * I + l16) * 272 + quad * 16;
            const LAS unsigned char* kb = lds + HG_KVER + (voff + 16 * J + l16) * 272 + quad * 16;
            f32x4 a = (f32x4){0.f, 0.f, 0.f, 0.f};
#pragma unroll
            for (int ks = 0; ks < 4; ++ks) a = MFMA16(lds_ld8(qa + ks * 64), lds_ld8(kb + ks * 64), a);
            LAS bf16_t* AM = (LAS bf16_t*)(lds + HG_AM);
#pragma unroll
            for (int j = 0; j < 4; ++j) {
                float v = a[j]; if (I == J && l16 > quad * 4 + j) v = 0.f;
                if (c == 0 && pi == 0 && lane == 0 && j == 0) v = s00;
                AM[(16 * I + quad * 4 + j) * 72 + 16 * J + l16] = bf1(v);
            }
        }
        __syncthreads();
        {
            f32x4 o = (f32x4){0.f, 0.f, 0.f, 0.f};
            const LAS unsigned char* qb = lds + HG_QB + (16 * tt + l16) * 272 + quad * 8;
#pragma unroll
            for (int s2 = 0; s2 < 4; ++s2) o = MFMA16(lds_ld4x2(qb + s2 * 64, qb + s2 * 64 + 32), pack8(S[2 * s2], S[2 * s2 + 1]), o);
            const LAS unsigned char* am = lds + HG_AM + (16 * tt + l16) * 144 + quad * 16;
            const LAS unsigned char* vb = lds + HG_VT + (16 * vt + l16) * 144 + quad * 16;
            const bf16x8 vb0 = lds_ld8(vb), vb1 = lds_ld8(vb + 64);
            o = MFMA16(lds_ld8(am), vb0, o); o = MFMA16(lds_ld8(am + 64), vb1, o);
            bf16_t* og = (bf16_t*)(ws + WS_XB) + (size_t)b * SEQ * 512 + h * 128 + sl * 32 + (size_t)(c * 64 + 16 * tt + quad * 4) * 512 + 16 * vt + l16;
#pragma unroll
            for (int j = 0; j < 4; ++j) og[(size_t)j * 512] = bf1(o[j]);
#pragma unroll
            for (int dt = 0; dt < 8; ++dt) {
                const f32x4 dc = *(const LAS f32x4*)(DEC + 16 * dt + quad * 4);
                const LAS unsigned char* ka = lds + HG_KHT + (16 * dt + l16) * 144 + quad * 16;
                f32x4 s = S[dt] * dc;
                s = MFMA16(lds_ld8(ka), vb0, s); s = MFMA16(lds_ld8(ka + 64), vb1, s);
                S[dt] = s;
            }
        }
        __syncthreads();
    }
}

__device__ __forceinline__ void hgrn_finalize(const Params& p, int layer) {
    unsigned char* ws = p.ws;
    const int tid = tid_opaque(), lane = tid & 63, wave = tid >> 6;
    const float* gain = p.hg_gain + layer * 128 + (lane & 15) * 8;
    float gn[8];
#pragma unroll
    for (int e = 0; e < 8; ++e) gn[e] = gain[e];
    for (int row = blockIdx.x * 8 + wave; row < T_TOK; row += gridDim.x * 8) {
        u32x4* op = (u32x4*)((bf16_t*)(ws + WS_HI) + (size_t)row * 512) + lane;
        const u32x4 ov = *((const u32x4*)((const bf16_t*)(ws + WS_XB) + (size_t)row * 512) + lane), gv = *((const u32x4*)((const bf16_t*)(ws + WS_HG) + (size_t)row * 512) + lane);
        float o[8], g[8];
        o[0] = bf_lo(ov.x); o[1] = bf_hi(ov.x); o[2] = bf_lo(ov.y); o[3] = bf_hi(ov.y); o[4] = bf_lo(ov.z); o[5] = bf_hi(ov.z); o[6] = bf_lo(ov.w); o[7] = bf_hi(ov.w);
        g[0] = bf_lo(gv.x); g[1] = bf_hi(gv.x); g[2] = bf_lo(gv.y); g[3] = bf_hi(gv.y); g[4] = bf_lo(gv.z); g[5] = bf_hi(gv.z); g[6] = bf_lo(gv.w); g[7] = bf_hi(gv.w);
        float s = 0.f;
#pragma unroll
        for (int e = 0; e < 8; ++e) s += o[e] * o[e];
        s += __shfl_xor(s, 1); s += __shfl_xor(s, 2); s += __shfl_xor(s, 4); s += __shfl_xor(s, 8);
        const float rstd = rsqrtf(s * (1.0f / 128.0f) + 1e-6f);
#pragma unroll
        for (int e = 0; e < 8; ++e) o[e] = o[e] * rstd * gn[e] * (g[e] * sigm(g[e]));
        u32x4 w; w.x = cvt_pk_bf16(o[0], o[1]); w.y = cvt_pk_bf16(o[2], o[3]); w.z = cvt_pk_bf16(o[4], o[5]); w.w = cvt_pk_bf16(o[6], o[7]);
        *op = w;
    }
}

constexpr int CM_A = 0, CM_W = 9216, CM_H = CM_W + 18432, CM_W2 = CM_H + 17408, CM_END = CM_W2 + 17408;
__device__ __forceinline__ void cmp_unit(const Params& p, int layer, int unit, LAS unsigned char* lds) {
    unsigned char* ws = p.ws;
    const int tid = tid_opaque(), lane = tid & 63, wave = tid >> 6, l16 = lane & 15, quad = lane >> 4;
    const int ct = unit & 3, kv = (unit >> 2) & 1, g = (unit >> 3) & 1, b = unit >> 4;
    const bf16_t* src = (const bf16_t*)(ws + WS_KV) + (size_t)b * SEQ * 768 + kv * 128 + g * 64;
    const bf16_t* W1T = (const bf16_t*)(ws + WS_CW1T) + (size_t)(layer * 2 + kv) * 128 * 2048;
    const bf16_t* W2T = (const bf16_t*)(ws + WS_CW2T) + (size_t)(layer * 2 + kv) * 64 * 128;
    const float* cbias = (const float*)(ws + WS_CBIAS) + (layer * 2 + kv) * 128;
    {
        const int n = tid >> 3, ch = tid & 7;
        *(LAS u32x4*)(lds + CM_W2 + n * 272 + ch * 32) = *(const u32x4*)(W2T + n * 128 + ch * 16);
        *(LAS u32x4*)(lds + CM_W2 + n * 272 + ch * 32 + 16) = *(const u32x4*)(W2T + n * 128 + ch * 16 + 8);
    }
    const int arow = tid >> 3, ach = tid & 7, ac = ct * 64 + arow;
    const bool aval = ac < 255;
    const bf16_t* ap = src + (size_t)(16 * (aval ? ac : 0)) * 768 + ach * 8;
    const int mi = wave & 3, nh = wave >> 2;
    f32x4 acc[4];
#pragma unroll
    for (int i = 0; i < 4; ++i) acc[i] = (f32x4){0.f, 0.f, 0.f, 0.f};
    u32x4 ar, wr0, wr1;
    ar = aval ? *(const u32x4*)ap : (u32x4){0u, 0u, 0u, 0u};
    wr0 = *(const u32x4*)(W1T + (size_t)(tid >> 3) * 2048 + (tid & 7) * 8);
    wr1 = *(const u32x4*)(W1T + (size_t)(64 + (tid >> 3)) * 2048 + (tid & 7) * 8);
    for (int tok = 0; tok < 32; ++tok) {
        __syncthreads();
        *(LAS u32x4*)(lds + CM_A + arow * 144 + ach * 16) = ar;
        *(LAS u32x4*)(lds + CM_W + (tid >> 3) * 144 + (tid & 7) * 16) = wr0;
        *(LAS u32x4*)(lds + CM_W + (64 + (tid >> 3)) * 144 + (tid & 7) * 16) = wr1;
        __syncthreads();
        if (tok + 1 < 32) {
            ar = aval ? *(const u32x4*)(ap + (size_t)(tok + 1) * 768) : (u32x4){0u, 0u, 0u, 0u};
            wr0 = *(const u32x4*)(W1T + (size_t)(tid >> 3) * 2048 + (tok + 1) * 64 + (tid & 7) * 8);
            wr1 = *(const u32x4*)(W1T + (size_t)(64 + (tid >> 3)) * 2048 + (tok + 1) * 64 + (tid & 7) * 8);
        }
#pragma unroll
        for (int ks = 0; ks < 2; ++ks) {
            const bf16x8 a = lds_ld8(lds + CM_A + (mi * 16 + l16) * 144 + ks * 64 + quad * 16);
#pragma unroll
            for (int ni = 0; ni < 4; ++ni) acc[ni] = MFMA16(a, lds_ld8(lds + CM_W + ((nh * 4 + ni) * 16 + l16) * 144 + ks * 64 + quad * 16), acc[ni]);
        }
    }
    {
        LAS bf16_t* H = (LAS bf16_t*)(lds + CM_H);
#pragma unroll
        for (int ni = 0; ni < 4; ++ni) {
            const int n = (nh * 4 + ni) * 16 + l16; const float cb = cbias[n];
#pragma unroll
            for (int j = 0; j < 4; ++j) {
                const float x = acc[ni][j] + cb;
                const float u = 0.7978845608028654f * (x + 0.044715f * x * x * x);
                const float th = 1.0f - 2.0f / (__expf(2.0f * u) + 1.0f);
                H[(mi * 16 + quad * 4 + j) * 136 + n] = bf1(0.5f * x * (1.0f + th));
            }
        }
    }
    __syncthreads();
    if (wave < 4) {
        f32x4 a2[4];
#pragma unroll
        for (int i = 0; i < 4; ++i) a2[i] = (f32x4){0.f, 0.f, 0.f, 0.f};
#pragma unroll
        for (int ks = 0; ks < 4; ++ks) {
            const bf16x8 a = lds_ld8(lds + CM_H + (wave * 16 + l16) * 272 + ks * 64 + quad * 16);
#pragma unroll
            for (int ni = 0; ni < 4; ++ni) a2[ni] = MFMA16(a, lds_ld8(lds + CM_W2 + (ni * 16 + l16) * 272 + ks * 64 + quad * 16), a2[ni]);
        }
        if (kv == 0) {
            bf16_t* KC = (bf16_t*)(ws + WS_KCMP) + (size_t)(b * 2 + g) * 256 * 64;
            const float* gain = p.qk_gain + (layer * 4 + 1) * 64;
#pragma unroll
            for (int j = 0; j < 4; ++j) {
                float s = (a2[0][j] * a2[0][j] + a2[1][j] * a2[1][j]) + (a2[2][j] * a2[2][j] + a2[3][j] * a2[3][j]);
                s += __shfl_xor(s, 1); s += __shfl_xor(s, 2); s += __shfl_xor(s, 4); s += __shfl_xor(s, 8);
                const float rstd = rsqrtf(s * (1.0f / 64.0f) + 1e-6f);
                const int c = ct * 64 + wave * 16 + quad * 4 + j;
#pragma unroll
                for (int ni = 0; ni < 4; ++ni) KC[(size_t)c * 64 + ni * 16 + l16] = (c < 255) ? bf1(a2[ni][j] * rstd * gain[ni * 16 + l16]) : (bf16_t)0;
            }
        } else {
            bf16_t* VC = (bf16_t*)(ws + WS_VCMPT) + (size_t)(b * 2 + g) * 64 * 256;
#pragma unroll
            for (int j = 0; j < 4; ++j) {
                const int c = ct * 64 + wave * 16 + quad * 4 + j;
#pragma unroll
                for (int ni = 0; ni < 4; ++ni) VC[(size_t)(ni * 16 + l16) * 256 + c] = (c < 255) ? bf1(a2[ni][j]) : (bf16_t)0;
            }
        }
    }
    __syncthreads();
}

constexpr int AT_TAB = 0, AT_K = 12800, AT_V = AT_K + 18432, AT_PS = AT_V + 18432, AT_MASK = AT_PS + 65536, AT_END = AT_MASK + 512;
static_assert(AT_END <= LDS_BYTES, "attn lds");

struct AttnCtx {
    const bf16_t* ksrc; const bf16_t* vsrc; int ldk, ldv; const float* kgain;
    int tpos[2]; int h;
};

template <int BR>
__device__ __forceinline__ void attn_branch(const AttnCtx& cx, const bf16x8 (&qf)[2][2], int qt, unsigned long long selu, const unsigned long long (&selm)[2],
                                            f32x4 (&of)[2][4], const float (&gate)[2], LAS unsigned char* lds, float (&m_out)[2], float (&il_out)[2]) {
    const int tid = tid_opaque(), lane = tid & 63, l16 = lane & 15, quad = lane >> 4;
    const int srow = tid >> 3, sch = tid & 7;
    float kg[8];
    if (BR != 0) {
#pragma unroll
        for (int e = 0; e < 8; ++e) kg[e] = cx.kgain[sch * 8 + e];
    }
    unsigned long long rem;
    if (BR == 0) rem = 0xFull;
    else if (BR == 1) rem = selu & ((qt >= 63) ? ~0ull : ((2ull << qt) - 1ull));
    else { const int lo = qt > 8 ? qt - 8 : 0; rem = ((qt >= 63) ? ~0ull : ((2ull << qt) - 1ull)) & ~((1ull << lo) - 1ull); }
    f32x4 o[2][4]; float m[2], l[2];
#pragma unroll
    for (int mi = 0; mi < 2; ++mi) { m[mi] = -INFINITY; l[mi] = 0.f;
#pragma unroll
        for (int di = 0; di < 4; ++di) o[mi][di] = (f32x4){0.f, 0.f, 0.f, 0.f}; }
    int cur = rem ? __builtin_ctzll(rem) : -1; if (rem) rem &= rem - 1ull;
    u32x4 kr, vr;
    auto gload = [&](int jt) {
        kr = *(const u32x4*)(cx.ksrc + (size_t)(jt * 64 + srow) * cx.ldk + sch * 8);
        vr = *(const u32x4*)(cx.vsrc + (size_t)srow * cx.ldv + jt * 64 + sch * 8);
    };
    auto lstore = [&](int buf) {
        u32x4 kw = kr;
        if (BR != 0) {
            float f[8]; f[0] = bf_lo(kr.x); f[1] = bf_hi(kr.x); f[2] = bf_lo(kr.y); f[3] = bf_hi(kr.y); f[4] = bf_lo(kr.z); f[5] = bf_hi(kr.z); f[6] = bf_lo(kr.w); f[7] = bf_hi(kr.w);
            float s = 0.f;
#pragma unroll
            for (int e = 0; e < 8; ++e) s += f[e] * f[e];
            s += __shfl_xor(s, 1); s += __shfl_xor(s, 2); s += __shfl_xor(s, 4);
            const float rstd = rsqrtf(s * (1.0f / 64.0f) + 1e-6f);
#pragma unroll
            for (int e = 0; e < 8; ++e) f[e] = f[e] * rstd * kg[e];
            kw.x = cvt_pk_bf16(f[0], f[1]); kw.y = cvt_pk_bf16(f[2], f[3]); kw.z = cvt_pk_bf16(f[4], f[5]); kw.w = cvt_pk_bf16(f[6], f[7]);
        }
        *(LAS u32x4*)(lds + AT_K + buf * 9216 + srow * 144 + sch * 16) = kw;
        *(LAS u32x4*)(lds + AT_V + buf * 9216 + srow * 144 + sch * 16) = vr;
    };
    if (cur >= 0) { gload(cur); lstore(0); }
    __syncthreads();
    int buf = 0;
    const LAS f32x4* TAB = (const LAS f32x4*)(lds + AT_TAB);
    const LAS float* TABf = (const LAS float*)(lds + AT_TAB);
    while (cur >= 0) {
        const int nxt = rem ? __builtin_ctzll(rem) : -1; if (rem) rem &= rem - 1ull;
        if (nxt >= 0) gload(nxt);
        const LAS unsigned char* Kb = lds + AT_K + buf * 9216; const LAS unsigned char* Vb = lds + AT_V + buf * 9216;
        f32x4 st[2][4];
#pragma unroll
        for (int ni = 0; ni < 4; ++ni) {
            const bf16x8 k0 = lds_ld8(Kb + (ni * 16 + l16) * 144 + quad * 16), k1 = lds_ld8(Kb + (ni * 16 + l16) * 144 + 64 + quad * 16);
#pragma unroll
            for (int mi = 0; mi < 2; ++mi) { f32x4 a = (f32x4){0.f, 0.f, 0.f, 0.f}; a = MFMA16(k0, qf[mi][0], a); a = MFMA16(k1, qf[mi][1], a); st[mi][ni] = a; }
        }
        bf16x8 pb[2][2];
#pragma unroll
        for (int mi = 0; mi < 2; ++mi) {
            const int tp = cx.tpos[mi];
            const bool blk_ok = (BR != 1) || ((selm[mi] >> cur) & 1ull);
            float mx = -INFINITY;
#pragma unroll
            for (int ni = 0; ni < 4; ++ni)
#pragma unroll
                for (int j = 0; j < 4; ++j) {
                    const int kidx = cur * 64 + ni * 16 + quad * 4 + j;
                    const int dist = (BR == 0) ? (tp - (16 * kidx + 31)) : (tp - kidx);
                    const bool valid = blk_ok && dist >= 0 && (BR != 2 || dist < 512);
                    const int di_ = dist < 0 ? 0 : (dist > 799 ? 799 : dist);
                    const float sc = valid ? st[mi][ni][j] + TABf[di_ * 4 + cx.h] : -INFINITY;
                    st[mi][ni][j] = sc; mx = fmaxf(mx, sc);
                }
            mx = fmaxf(mx, __shfl_xor(mx, 16)); mx = fmaxf(mx, __shfl_xor(mx, 32));
            const float mn = fmaxf(m[mi], mx);
            const float mu = (mn == -INFINITY) ? 0.f : mn;
            const float alpha = __expf(m[mi] - mu);
            m[mi] = mn;
            float ls = 0.f;
#pragma unroll
            for (int ni = 0; ni < 4; ++ni)
#pragma unroll
                for (int j = 0; j < 4; ++j) { const float pv = __expf(st[mi][ni][j] - mu); st[mi][ni][j] = pv; ls += pv; }
            l[mi] = l[mi] * alpha + ls;
#pragma unroll
            for (int di = 0; di < 4; ++di) o[mi][di] = o[mi][di] * alpha;
            pb[mi][0] = pack8(st[mi][0], st[mi][1]); pb[mi][1] = pack8(st[mi][2], st[mi][3]);
        }
#pragma unroll
        for (int di = 0; di < 4; ++di)
#pragma unroll
            for (int s2 = 0; s2 < 2; ++s2) {
                const LAS unsigned char* vp = Vb + (di * 16 + l16) * 144 + s2 * 64 + quad * 8;
                const bf16x8 vf = lds_ld4x2(vp, vp + 32);
#pragma unroll
                for (int mi = 0; mi < 2; ++mi) o[mi][di] = MFMA16(vf, pb[mi][s2], o[mi][di]);
            }
        if (nxt >= 0) lstore(buf ^ 1);
        __syncthreads();
        cur = nxt; buf ^= 1;
    }
#pragma unroll
    for (int mi = 0; mi < 2; ++mi) {
        float lt = l[mi]; lt += __shfl_xor(lt, 16); lt += __shfl_xor(lt, 32);
        const float il = lt > 0.f ? 1.0f / lt : 0.f;
        const float sc = il * gate[mi];
#pragma unroll
        for (int di = 0; di < 4; ++di) of[mi][di] = of[mi][di] + o[mi][di] * sc;
        m_out[mi] = (m[mi] == -INFINITY) ? 0.f : m[mi]; il_out[mi] = il;
    }
    (void)TAB;
}

__device__ __forceinline__ void attn_cmp_probs(const AttnCtx& cx, const bf16x8 (&qf)[2][2], const float (&mrow)[2], const float (&ilrow)[2], LAS unsigned char* lds) {
    const int tid = tid_opaque(), lane = tid & 63, wave = tid >> 6, l16 = lane & 15, quad = lane >> 4;
    const int srow = tid >> 3, sch = tid & 7;
    const LAS float* TABf = (const LAS float*)(lds + AT_TAB);
    LAS float* PS = (LAS float*)(lds + AT_PS);
    for (int jt = 0; jt < 4; ++jt) {
        const u32x4 kr = *(const u32x4*)(cx.ksrc + (size_t)(jt * 64 + srow) * cx.ldk + sch * 8);
        __syncthreads();
        *(LAS u32x4*)(lds + AT_K + srow * 144 + sch * 16) = kr;
        __syncthreads();
        const LAS unsigned char* Kb = lds + AT_K;
#pragma unroll
        for (int ni = 0; ni < 4; ++ni) {
            const bf16x8 k0 = lds_ld8(Kb + (ni * 16 + l16) * 144 + quad * 16), k1 = lds_ld8(Kb + (ni * 16 + l16) * 144 + 64 + quad * 16);
#pragma unroll
            for (int mi = 0; mi < 2; ++mi) {
                f32x4 a = (f32x4){0.f, 0.f, 0.f, 0.f}; a = MFMA16(k0, qf[mi][0], a); a = MFMA16(k1, qf[mi][1], a);
                const int tp = cx.tpos[mi];
                f32x4 pr;
#pragma unroll
                for (int j = 0; j < 4; ++j) {
                    const int kidx = jt * 64 + ni * 16 + quad * 4 + j;
                    const int dist = tp - (16 * kidx + 31);
                    const int di_ = dist < 0 ? 0 : (dist > 799 ? 799 : dist);
                    float pv = (dist >= 0) ? __expf(a[j] + TABf[di_ * 4 + cx.h] - mrow[mi]) * ilrow[mi] : 0.f;
                    pv += __shfl_xor(pv, 1); pv += __shfl_xor(pv, 2);
                    pr[j] = pv;
                }
                if ((l16 & 3) == 0) *(LAS f32x4*)(PS + (wave * 8 + mi * 4 + (l16 >> 2)) * 256 + jt * 64 + ni * 16 + quad * 4) = pr;
            }
        }
    }
    __syncthreads();
}

__device__ __forceinline__ void attn_unit(const Params& p, int layer, int b, int g, int qt, LAS unsigned char* lds) {
    unsigned char* ws = p.ws;
    const int tid = tid_opaque(), lane = tid & 63, wave = tid >> 6, l16 = lane & 15, quad = lane >> 4;
    const int t0 = qt * 64;
    __syncthreads();
    {
        LAS float* TABw = (LAS float*)(lds + AT_TAB);
        for (int i = tid; i < 3200; i += 512) {
            const int dist = i >> 2, hh = i & 3;
            int bk;
            if (dist < 16) bk = dist;
            else { bk = 16 + (dist >= 21) + (dist >= 27) + (dist >= 35) + (dist >= 46) + (dist >= 59) + (dist >= 77) + (dist >= 99) + (dist >= 128) + (dist >= 166) + (dist >= 216) + (dist >= 280) + (dist >= 363) + (dist >= 470) + (dist >= 609) + (dist >= 790); }
            TABw[i] = p.rel_bias[bk * 8 + g * 4 + hh];
        }
    }
    AttnCtx cx; cx.h = l16 & 3;
    bf16x8 qf[2][2]; float gates[3][2];
    bf16_t* nq = (bf16_t*)(ws + WS_NQ);
    const bf16_t* ng = (const bf16_t*)(ws + WS_NG);
    const float* qgain = p.qk_gain + (layer * 4 + 0) * 64;
#pragma unroll
    for (int mi = 0; mi < 2; ++mi) {
        const int tl = wave * 8 + mi * 4 + (l16 >> 2); const int tp = t0 + tl; cx.tpos[mi] = tp;
        const size_t row = (size_t)b * SEQ + tp;
        const bf16_t* qp = nq + row * 512 + g * 256 + cx.h * 64 + quad * 8;
        const u32x4 q0 = *(const u32x4*)qp, q1 = *(const u32x4*)(qp + 32);
        float f[16];
        f[0] = bf_lo(q0.x); f[1] = bf_hi(q0.x); f[2] = bf_lo(q0.y); f[3] = bf_hi(q0.y); f[4] = bf_lo(q0.z); f[5] = bf_hi(q0.z); f[6] = bf_lo(q0.w); f[7] = bf_hi(q0.w);
        f[8] = bf_lo(q1.x); f[9] = bf_hi(q1.x); f[10] = bf_lo(q1.y); f[11] = bf_hi(q1.y); f[12] = bf_lo(q1.z); f[13] = bf_hi(q1.z); f[14] = bf_lo(q1.w); f[15] = bf_hi(q1.w);
        float s = 0.f;
#pragma unroll
        for (int e = 0; e < 16; ++e) s += f[e] * f[e];
        s += __shfl_xor(s, 16); s += __shfl_xor(s, 32);
        const float rstd = rsqrtf(s * (1.0f / 64.0f) + 1e-6f) * 0.125f;
#pragma unroll
        for (int e = 0; e < 8; ++e) { f[e] = f[e] * rstd * qgain[quad * 8 + e]; f[8 + e] = f[8 + e] * rstd * qgain[32 + quad * 8 + e]; }
        u32x4 w0, w1;
        w0.x = cvt_pk_bf16(f[0], f[1]); w0.y = cvt_pk_bf16(f[2], f[3]); w0.z = cvt_pk_bf16(f[4], f[5]); w0.w = cvt_pk_bf16(f[6], f[7]);
        w1.x = cvt_pk_bf16(f[8], f[9]); w1.y = cvt_pk_bf16(f[10], f[11]); w1.z = cvt_pk_bf16(f[12], f[13]); w1.w = cvt_pk_bf16(f[14], f[15]);
        qf[mi][0] = __builtin_bit_cast(bf16x8, w0); qf[mi][1] = __builtin_bit_cast(bf16x8, w1);
#pragma unroll
        for (int br = 0; br < 3; ++br) gates[br][mi] = bfu(ng[row * 256 + g * 12 + cx.h * 3 + br]);
    }
    __syncthreads();
    f32x4 of[2][4];
#pragma unroll
    for (int mi = 0; mi < 2; ++mi)
#pragma unroll
        for (int di = 0; di < 4; ++di) of[mi][di] = (f32x4){0.f, 0.f, 0.f, 0.f};
    const unsigned long long nomask[2] = {0ull, 0ull};
    float mrow[2], ilrow[2];
    cx.ksrc = (const bf16_t*)(ws + WS_KCMP) + (size_t)(b * 2 + g) * 256 * 64; cx.ldk = 64;
    cx.vsrc = (const bf16_t*)(ws + WS_VCMPT) + (size_t)(b * 2 + g) * 64 * 256; cx.ldv = 256; cx.kgain = nullptr;
    { const float gt[2] = {gates[0][0], gates[0][1]}; attn_branch<0>(cx, qf, qt, 0ull, nomask, of, gt, lds, mrow, ilrow); }
    attn_cmp_probs(cx, qf, mrow, ilrow, lds);
    {
        const LAS float* PS = (const LAS float*)(lds + AT_PS);
        LAS unsigned long long* MK = (LAS unsigned long long*)(lds + AT_MASK);
        for (int ti = 0; ti < 8; ++ti) {
            const int tl = wave * 8 + ti, tp = t0 + tl, jcur = tp >> 6, j = lane;
            float imp = 0.f;
#pragma unroll
            for (int e = -1; e < 4; ++e) { const int c = 4 * j + e; if (c >= 0 && c < 255) imp += PS[tl * 256 + c]; }
            const bool forced = (j == 0) || (j == jcur) || (j == jcur - 1);
            imp = (64 * j <= tp) ? (imp + (forced ? 1000.0f : 0.f)) : -1.0f;
            int cnt = 0;
#pragma unroll 4
            for (int i = 0; i < 64; ++i) {
                const float vi = __builtin_bit_cast(float, __builtin_amdgcn_readlane(__builtin_bit_cast(int, imp), i));
                cnt += (vi > imp || (vi == imp && i < j)) ? 1 : 0;
            }
            const unsigned long long mk = __ballot(cnt < 8);
            if (lane == 0) MK[tl] = mk;
        }
    }
    __syncthreads();
    unsigned long long selu = 0ull, selm[2];
    {
        const LAS unsigned long long* MK = (const LAS unsigned long long*)(lds + AT_MASK);
#pragma unroll 4
        for (int i = 0; i < 64; ++i) selu |= MK[i];
        selm[0] = MK[wave * 8 + (l16 >> 2)]; selm[1] = MK[wave * 8 + 4 + (l16 >> 2)];
    }
    float md[2], ild[2];
    cx.ksrc = (const bf16_t*)(ws + WS_KV) + (size_t)b * SEQ * 768 + 256 + g * 64; cx.ldk = 768;
    cx.vsrc = (const bf16_t*)(ws + WS_VST) + (size_t)(b * 2 + g) * 64 * 4096; cx.ldv = 4096; cx.kgain = p.qk_gain + (layer * 4 + 2) * 64;
    { const float gt[2] = {gates[1][0], gates[1][1]}; attn_branch<1>(cx, qf, qt, selu, selm, of, gt, lds, md, ild); }
    cx.ksrc = (const bf16_t*)(ws + WS_KV) + (size_t)b * SEQ * 768 + 512 + g * 64; cx.ldk = 768;
    cx.vsrc = (const bf16_t*)(ws + WS_VWT) + (size_t)(b * 2 + g) * 64 * 4096; cx.ldv = 4096; cx.kgain = p.qk_gain + (layer * 4 + 3) * 64;
    { const float gt[2] = {gates[2][0], gates[2][1]}; attn_branch<2>(cx, qf, qt, 0ull, nomask, of, gt, lds, md, ild); }
#pragma unroll
    for (int mi = 0; mi < 2; ++mi) {
        bf16_t* op = (bf16_t*)(ws + WS_XB + 64 * MiB) + ((size_t)b * SEQ + cx.tpos[mi]) * 512 + g * 256 + cx.h * 64 + quad * 4;
#pragma unroll
        for (int di = 0; di < 4; ++di) { u32x2 w; w.x = cvt_pk_bf16(of[mi][di][0], of[mi][di][1]); w.y = cvt_pk_bf16(of[mi][di][2], of[mi][di][3]); *(u32x2*)(op + di * 16) = w; }
    }
}

#ifndef ST_MASK
#define ST_MASK 0xff
#endif
#define ST_ON(k) ((ST_MASK >> (k)) & 1)
__global__ void __launch_bounds__(512, 2) fwd_kernel(Params pin) {
    extern __shared__ __attribute__((aligned(16))) unsigned char lds_raw[];
    LAS unsigned char* lds = (LAS unsigned char*)lds_raw;
    cg::grid_group grid = cg::this_grid();
    const int G = gridDim.x, bx = blockIdx.x;
    for (int ph = pin.ph_lo; ph < pin.ph_hi; ++ph) {
        Params p = pin;
        asm volatile("" : "+s"(p.x), "+s"(p.rel_bias), "+s"(p.lb_logits), "+s"(p.norm_mix), "+s"(p.w_in), "+s"(p.hg_gain), "+s"(p.qk_gain));
        asm volatile("" : "+s"(p.cmp_pos), "+s"(p.cmp_w1), "+s"(p.cmp_b1), "+s"(p.cmp_w2), "+s"(p.w_a), "+s"(p.w_b), "+s"(p.w_out));
        asm volatile("" : "+s"(p.norm_mlp), "+s"(p.w_up), "+s"(p.w_down), "+s"(p.out), "+s"(p.ws));
        unsigned char* ws = p.ws;

#ifndef NO_PRO
        if (ph == 0) { prologue(p, lds);
#ifdef DIAG_S00
            if (bx == 0 && threadIdx.x == 0) *(unsigned*)(ws + 512) = 0x7f000000u;
#endif
        }
#else
        if (ph == 0) {}
#endif

#ifdef DIAG_S00
        else if (ph == 15) { if (bx == 0 && threadIdx.x == 0) { const float v = __uint_as_float(__hip_atomic_load((unsigned*)(ws + 512), __ATOMIC_RELAXED, __HIP_MEMORY_SCOPE_AGENT)); p.out[0] += 1000.0f * v + 5.0f; } }
#endif
        else {
            const int layer = (ph - 1) / 7, st = (ph - 1) % 7;
            float* sumsq = (float*)(ws + WS_SUMSQ);
            bf16_t* xb = (bf16_t*)(ws + WS_XB);
            if (st == 0 && ST_ON(0)) {
                pg8::Gemm g{xb, (const bf16_t*)(ws + WS_WIN) + (size_t)layer * NP_IN * DM, T_TOK, NP_IN, DM}; pg8::StaticOrder S; S.init(T_TOK, NP_IN, G, bx);
                pg8::EpiIn E{sumsq, (bf16_t*)(ws + WS_HQ), (bf16_t*)(ws + WS_NQ), (bf16_t*)(ws + WS_KV), (bf16_t*)(ws + WS_NG), (bf16_t*)(ws + WS_SGA), (bf16_t*)(ws + WS_VST), (bf16_t*)(ws + WS_VWT)};
                pg8::gemm_phase<pg8::EpiIn, pg8::StaticOrder, true, true>(lds, g, S, E);
#ifdef DUP_GEMM
                __syncthreads(); pg8::gemm_phase<pg8::EpiIn, pg8::StaticOrder, true, true>(lds, g, S, E);
#endif
                if (layer == 0) {
                    __syncthreads();
                    const float* EH = (const float*)(ws + WS_EX + EX_H);
                    exact_stage(p.w_in, p.w_in, 99, DM, IN_COLS, (float*)(ws + WS_EX + EX_PP), [=](int r, int k) { return EH[r * 1024 + k]; }, lds);
                }
            } else if (st == 1 && ST_ON(1)) {
                {
                    const int x = bx & 7, i = bx >> 3;
                    const int unit = ((x * 8 + (i >> 2)) << 2) | (i & 3);

#ifndef NO_HGRN
                    if (bx < 256) hgrn_unit(p, layer, unit, lds);
#ifdef DUP_HGRN
                    if (bx < 256) hgrn_unit(p, layer, unit, lds);
#endif
#endif

                }

#ifndef NO_CMP
                for (int u = bx; u < 256; u += G) cmp_unit(p, layer, u, lds);
#endif
                if (layer == 0 && bx < 16) exact_mixers(p, bx, lds);

            } else if (st == 2 && ST_ON(2)) {
                hgrn_finalize(p, layer);
                {
                    const int x = bx & 7, i = bx >> 3;
#ifdef DUP_ATTN
                    for (int r2 = 0; r2 < 16; ++r2) { const int r = r2 & 7;
#else
                    for (int r = 0; r < 8; ++r) {
#endif
                        const int pair = x * 4 + (r >> 1);
                        const int qt = (r & 1) ? (63 - i) : i;

#ifndef NO_ATTN
                        attn_unit(p, layer, pair >> 1, pair & 1, qt, lds);
#endif

                    }
                }
                if (layer == 0) {
                    __syncthreads();
                    const float* OAB = (const float*)(ws + WS_EX + EX_OAB);
                    exact_stage(p.w_a, p.w_b, 2, 1024, DM, (float*)(ws + WS_EX + EX_YP), [=](int r, int k) { return OAB[r * 1024 + k]; }, lds);
                }
            } else if (st == 3 && ST_ON(3)) {
                {
                    pg8::Gemm g{(const bf16_t*)(ws + WS_HI), (const bf16_t*)(ws + WS_WA) + (size_t)layer * DM * 512, T_TOK, DM, 512}; pg8::StaticOrder S; S.init(T_TOK, DM, G, bx);
                    pg8::EpiMix<false> E{(const bf16_t*)(ws + WS_SGA), (bf16_t*)(ws + WS_MIXED)};
                    pg8::gemm_phase<pg8::EpiMix<false>, pg8::StaticOrder, true, true>(lds, g, S, E);
                }
                __syncthreads();
                {
                    pg8::Gemm g{(const bf16_t*)(ws + WS_XB + 64 * MiB), (const bf16_t*)(ws + WS_WB) + (size_t)layer * DM * 512, T_TOK, DM, 512}; pg8::StaticOrder S; S.init(T_TOK, DM, G, bx);
                    pg8::EpiMix<true> E{(const bf16_t*)(ws + WS_SGB), (bf16_t*)(ws + WS_MIXED)};
                    pg8::gemm_phase<pg8::EpiMix<true>, pg8::StaticOrder, true, true>(lds, g, S, E);
                }
                if (layer == 0) {
                    __syncthreads();
                    const float* PP = (const float*)(ws + WS_EX + EX_PP); const float* YP = (const float*)(ws + WS_EX + EX_YP);
                    exact_stage(p.w_out, p.w_out, 99, DM, DM, (float*)(ws + WS_EX + EX_XP), [=](int r, int k) {
                        const float ga = ex_pp(PP, r, 3352 + k), gb = ex_pp(PP, r, 4376 + k);
                        const float ya = YP[(size_t)r * 1024 + k] + YP[(size_t)(16 + r) * 1024 + k], yb = YP[(size_t)(32 + r) * 1024 + k] + YP[(size_t)(48 + r) * 1024 + k];
                        return ya / (1.0f + __expf(-ga)) + yb / (1.0f + __expf(-gb)); }, lds);
                }
            } else if ((st == 4 || st == 6) && ST_ON(4)) {
                const bool down = (st == 6);
                pg8::Gemm g{down ? (const bf16_t*)(ws + WS_HID) : (const bf16_t*)(ws + WS_MIXED),
                            down ? (const bf16_t*)(ws + WS_WDN) + (size_t)layer * DM * DFF : (const bf16_t*)(ws + WS_WO) + (size_t)layer * DM * DM, T_TOK, DM, down ? DFF : DM};
                pg8::StaticOrder S; S.init(T_TOK, DM, G, bx);
                pg8::EpiRes E{(layer == 0 && !down) ? p.x : (const float*)p.out, p.out, xb, sumsq};
                pg8::gemm_phase<pg8::EpiRes, pg8::StaticOrder, true, true>(lds, g, S, E);
                if (layer == 0 && !down) {
                    __syncthreads();
                    LAS float* RS = (LAS float*)(lds + 16384); LAS float* red = (LAS float*)(lds + 32768);
                    const int tid2 = threadIdx.x;
#pragma unroll 1
                    for (int r = 0; r < ((bx < 32) ? 16 : 0); ++r) {
                        const float a = ex_x1(p, r, tid2), b2 = ex_x1(p, r, 512 + tid2);
                        const float ss = block_sum(a * a + b2 * b2, red, tid2);
                        if (tid2 == 0) RS[r] = rsqrtf(ss * (1.0f / 1024.0f) + 1e-6f);
                    }
                    __syncthreads();
                    const Params pc = p; const float* nm2 = p.norm_mlp;
                    exact_stage(p.w_up, p.w_up, 99, DM, DFF, (float*)(ws + WS_EX + EX_UP), [=](int r, int k) { return ex_x1(pc, r, k) * RS[r] * nm2[k]; }, lds);
                }
            } else if (st == 5 && ST_ON(5)) {
                pg8::Gemm g{xb, (const bf16_t*)(ws + WS_WUP) + (size_t)layer * DFF * DM, T_TOK, DFF, DM}; pg8::StaticOrder S; S.init(T_TOK, DFF, G, bx);
                pg8::EpiUp E{sumsq, (bf16_t*)(ws + WS_HID)};
                pg8::gemm_phase<pg8::EpiUp, pg8::StaticOrder, true, true>(lds, g, S, E);
#ifdef DUP_GEMM
                __syncthreads(); pg8::gemm_phase<pg8::EpiUp, pg8::StaticOrder, true, true>(lds, g, S, E);
#endif
                if (layer == 0) {
                    __syncthreads();
                    const float* UP = (const float*)(ws + WS_EX + EX_UP);
                    exact_stage(p.w_down, p.w_down, 99, DFF, DM, (float*)(ws + WS_EX + EX_DP), [=](int r, int k) {
                        const float u = (UP[(size_t)r * DFF + k] + UP[(size_t)(16 + r) * DFF + k]) + (UP[(size_t)(32 + r) * DFF + k] + UP[(size_t)(48 + r) * DFF + k]);
                        const float t = fmaxf(u, 0.f); return t * t; }, lds);
                }
            }
        }
        if (ph + 1 < pin.ph_hi) {
            asm volatile("s_waitcnt vmcnt(0) lgkmcnt(0)" ::: "memory");
            grid.sync();
            __builtin_amdgcn_fence(__ATOMIC_ACQUIRE, "agent");
            asm volatile("s_waitcnt vmcnt(0)" ::: "memory");
        }
    }
}

#ifdef DIAG_S00
constexpr int N_PHASES = 16;
#else
constexpr int N_PHASES = 15;
#endif
#ifndef ONE_LAUNCH
#define ONE_LAUNCH 1
#endif

extern "C" void kernel_launch(void* const* d_in, const int* in_sizes, int n_in, void* d_out, int out_size, void* d_ws, size_t ws_size, hipStream_t stream) {
    static int ready = 0;
    if (ready == 0) {
        if (n_in != 17 || out_size != T_TOK * DM || ws_size < WS_END) { fprintf(stderr, "kernel_launch: unexpected shapes: n_in %d out %d ws %zu (need %zu)\n", n_in, out_size, ws_size, (size_t)WS_END); ready = -1; return; }
        if (hipFuncSetAttribute((const void*)fwd_kernel, hipFuncAttributeMaxDynamicSharedMemorySize, LDS_BYTES) != hipSuccess) { fprintf(stderr, "kernel_launch: hipFuncSetAttribute failed\n"); ready = -1; return; }
        int per_cu = 0;
        if (hipOccupancyMaxActiveBlocksPerMultiprocessor(&per_cu, (const void*)fwd_kernel, 512, LDS_BYTES) != hipSuccess || per_cu < 1) fprintf(stderr, "kernel_launch: occupancy query says %d blocks per CU\n", per_cu);
        (void)hipGetLastError();
        ready = 1;
    }
    if (ready < 0) return;
    Params p{};
    p.x = (const float*)d_in[0]; p.rel_bias = (const float*)d_in[1]; p.lb_logits = (const float*)d_in[2]; p.norm_mix = (const float*)d_in[3]; p.w_in = (const float*)d_in[4];
    p.hg_gain = (const float*)d_in[5]; p.qk_gain = (const float*)d_in[6]; p.cmp_pos = (const float*)d_in[7]; p.cmp_w1 = (const float*)d_in[8]; p.cmp_b1 = (const float*)d_in[9];
    p.cmp_w2 = (const float*)d_in[10]; p.w_a = (const float*)d_in[11]; p.w_b = (const float*)d_in[12]; p.w_out = (const float*)d_in[13]; p.norm_mlp = (const float*)d_in[14];
    p.w_up = (const float*)d_in[15]; p.w_down = (const float*)d_in[16];
    p.out = (float*)d_out; p.ws = (unsigned char*)d_ws;
#if ONE_LAUNCH
    p.ph_lo = 0; p.ph_hi = N_PHASES;
    void* args[] = {&p};
    hipError_t e = hipLaunchCooperativeKernel((const void*)fwd_kernel, dim3(256), dim3(512), args, LDS_BYTES, stream);
    if (e != hipSuccess) fprintf(stderr, "kernel_launch: cooperative launch failed: %s\n", hipGetErrorString(e));
#else
    for (int ph = 0; ph < N_PHASES; ++ph) {
        p.ph_lo = ph; p.ph_hi = ph + 1;
        hipLaunchKernelGGL(fwd_kernel, dim3(256), dim3(512), LDS_BYTES, stream, p);
    }
#endif
}
```

```cpp
#include <hip/hip_runtime.h>
#include <hip/hip_cooperative_groups.h>
#include <cstdio>
#include <cstdint>
namespace cg = cooperative_groups;
namespace pg8 {
#define PG8_LAS __attribute__((address_space(3)))
typedef unsigned short bf16_t;
typedef short bf16x8 __attribute__((ext_vector_type(8)));
typedef float f32x4 __attribute__((ext_vector_type(4)));
typedef unsigned u32x4 __attribute__((ext_vector_type(4)));
constexpr int BM = 256, BK = 64, HALF = 128, HTB = HALF * BK * 2  , STAGE_BYTES = 8 * HTB, NXCD = 8, WGM = 8;

__host__ __device__ __forceinline__ int lds_byte(int r, int c) { const int st = (r >> 4) * 2 + (c >> 5), rr = r & 15, cc = c & 31, ob = rr * 64 + cc * 2; return st * 1024 + (ob ^ (((ob >> 9) & 1) << 5)); }
__host__ __device__ __forceinline__ void stage_rc(int b, int& R, int& C) { const int st = b / 1024, sb = b % 1024, swz = sb ^ (((sb >> 9) & 1) << 5); R = (st >> 1) * 16 + swz / 64; C = (st & 1) * 32 + (swz % 64) / 2; }
__host__ __device__ __forceinline__ int perm32(int rho) { const int n = rho >> 4, i = rho & 15; return 8 * (i >> 2) + 4 * n + (i & 3); }

struct Unit { int pm, pn; };
struct Gemm { const bf16_t* A; const bf16_t* Bt; int M, N, K; };

struct StaticOrder {
    int nM, nN, nwg, G, c;
    __host__ __device__ void init(int M, int N, int G_, int c_) { nM = M / BM; nN = N / BM; nwg = nM * nN; G = G_; c = c_; }
    __host__ __device__ bool next(int i, Unit& u) const {
        const long L = (long)i * G + c; if (L >= nwg) return false;
        int wgid = (int)L; { const int q = nwg / NXCD, r = nwg % NXCD, xcd = wgid % NXCD, off = wgid / NXCD; wgid = (xcd < r ? xcd * (q + 1) : r * (q + 1) + (xcd - r) * q) + off; }
        const int nig = WGM * nN, gid = wgid / nig, fm = gid * WGM, gsz = (nM - fm) < WGM ? (nM - fm) : WGM;
        u.pm = fm + ((wgid % nig) % gsz); u.pn = (wgid % nig) / gsz; return true;
    }
    __device__ __forceinline__ void a_ready(const Unit&) const {}
    __device__ __forceinline__ void done(const Unit&) const {}
};

typedef float f32x2c __attribute__((ext_vector_type(2)));
typedef __bf16 bf16x2c __attribute__((ext_vector_type(2)));
__device__ __forceinline__ unsigned cvt_pk_bf16(float lo, float hi) { const f32x2c v = {lo, hi}; const bf16x2c b = __builtin_convertvector(v, bf16x2c); return __builtin_bit_cast(unsigned, b); }
__device__ __forceinline__ float bf_lo(unsigned w) { return __uint_as_float(w << 16); }
__device__ __forceinline__ float bf_hi(unsigned w) { return __uint_as_float(w & 0xffff0000u); }
__device__ __forceinline__ float sigm(float v) { return __builtin_amdgcn_rcpf(1.0f + __expf(-v)); }

__device__ __forceinline__ void row_rstd8(const float* sumsq, const Unit& u, int wr, int fr, int fq, float (&rs)[2][4]) {
#pragma unroll
    for (int ai = 0; ai < 2; ++ai)
#pragma unroll
        for (int m = 0; m < 4; ++m) {
            const int row = u.pm * BM + ai * HALF + wr * 64 + m * 16 + fr;
            const f32x4 v = *(const f32x4*)(sumsq + (size_t)row * 16 + fq * 4);
            float s = (v[0] + v[1]) + (v[2] + v[3]);
            s += __shfl_xor(s, 16); s += __shfl_xor(s, 32);
            rs[ai][m] = rsqrtf(s * (1.0f / 1024.0f) + 1e-6f);
            if (m == 3) asm volatile("" ::: "memory");
        }
}

struct EpiIn {
    static constexpr bool PERM = true, AFTER_DRAIN = false;
    const float* sumsq; bf16_t *HQ, *NQ, *KV, *NG, *SGA, *VST, *VWT;
    __device__ __forceinline__ void operator()(const f32x4 (&acc)[2][2][4][2], const Unit& u, int wr, int wc, int fr, int fq) const {
        float rs[2][4]; row_rstd8(sumsq, u, wr, fr, fq, rs);
        const int pn = u.pn; bf16_t* base; int ldc, colt; bool sg = false;
        if (pn < 8) { base = HQ + (size_t)(pn >> 1) * ((size_t)65536 * 512); ldc = 512; colt = (pn & 1) * 256; }
        else if (pn < 10) { base = NQ; ldc = 512; colt = (pn - 8) * 256; }
        else if (pn < 13) { base = KV; ldc = 768; colt = (pn - 10) * 256; }
        else if (pn == 13) { base = NG; ldc = 256; colt = 0; sg = true; }
        else { const int q = pn - 14; base = SGA + (size_t)(q >> 2) * ((size_t)65536 * 1024); ldc = 1024; colt = (q & 3) * 256; sg = true; }
        const int col0 = colt + wc * 32 + 8 * fq;
        bf16_t* vt = (pn == 11) ? VST : ((pn == 12) ? VWT : nullptr);
#pragma unroll
        for (int ai = 0; ai < 2; ++ai)
#pragma unroll
            for (int m = 0; m < 4; ++m) {
                const int row = u.pm * BM + ai * HALF + wr * 64 + m * 16 + fr;
                bf16_t* rowp = base + (size_t)row * ldc + col0; const float r = rs[ai][m];
#pragma unroll
                for (int bj = 0; bj < 2; ++bj) {
                    f32x4 v0 = acc[ai][bj][m][0] * r, v1 = acc[ai][bj][m][1] * r;
                    if (sg) {
#pragma unroll
                        for (int e = 0; e < 4; ++e) { v0[e] = sigm(v0[e]); v1[e] = sigm(v1[e]); }
                    }
                    u32x4 w; w.x = cvt_pk_bf16(v0[0], v0[1]); w.y = cvt_pk_bf16(v0[2], v0[3]); w.z = cvt_pk_bf16(v1[0], v1[1]); w.w = cvt_pk_bf16(v1[2], v1[3]);
                    *(u32x4*)(rowp + bj * HALF) = w;
                    if (vt != nullptr && bj == 1) {
                        const int cv = wc * 32 + 8 * fq, g = cv >> 6, d0 = cv & 63, b = row >> 12, t = row & 4095;
                        bf16_t* tp = vt + (((size_t)(b * 2 + g) * 64 + d0) << 12) + t;
                        tp[0 * 4096] = (bf16_t)(w.x & 0xffffu); tp[1 * 4096] = (bf16_t)(w.x >> 16); tp[2 * 4096] = (bf16_t)(w.y & 0xffffu); tp[3 * 4096] = (bf16_t)(w.y >> 16);
                        tp[4 * 4096] = (bf16_t)(w.z & 0xffffu); tp[5 * 4096] = (bf16_t)(w.z >> 16); tp[6 * 4096] = (bf16_t)(w.w & 0xffffu); tp[7 * 4096] = (bf16_t)(w.w >> 16);
                    }
                }
                asm volatile("" ::: "memory");
            }
    }
};

template <bool ACCUM> struct EpiMix {
    static constexpr bool PERM = true, AFTER_DRAIN = false;
    const bf16_t* gate; bf16_t* mixed;
    __device__ __forceinline__ void operator()(const f32x4 (&acc)[2][2][4][2], const Unit& u, int wr, int wc, int fr, int fq) const {
        const int col0 = u.pn * BM + wc * 32 + 8 * fq;
#pragma unroll
        for (int ai = 0; ai < 2; ++ai)
#pragma unroll
            for (int m = 0; m < 4; ++m) {
                const size_t off = (size_t)(u.pm * BM + ai * HALF + wr * 64 + m * 16 + fr) * 1024 + col0;
#pragma unroll
                for (int bj = 0; bj < 2; ++bj) {
                    const u32x4 gq = *(const u32x4*)(gate + off + bj * HALF);
                    f32x4 v0 = acc[ai][bj][m][0], v1 = acc[ai][bj][m][1];
                    v0[0] *= bf_lo(gq.x); v0[1] *= bf_hi(gq.x); v0[2] *= bf_lo(gq.y); v0[3] *= bf_hi(gq.y);
                    v1[0] *= bf_lo(gq.z); v1[1] *= bf_hi(gq.z); v1[2] *= bf_lo(gq.w); v1[3] *= bf_hi(gq.w);
                    if (ACCUM) {
                        const u32x4 mq = *(const u32x4*)(mixed + off + bj * HALF);
                        v0[0] += bf_lo(mq.x); v0[1] += bf_hi(mq.x); v0[2] += bf_lo(mq.y); v0[3] += bf_hi(mq.y);
                        v1[0] += bf_lo(mq.z); v1[1] += bf_hi(mq.z); v1[2] += bf_lo(mq.w); v1[3] += bf_hi(mq.w);
                    }
                    u32x4 w; w.x = cvt_pk_bf16(v0[0], v0[1]); w.y = cvt_pk_bf16(v0[2], v0[3]); w.z = cvt_pk_bf16(v1[0], v1[1]); w.w = cvt_pk_bf16(v1[2], v1[3]);
                    *(u32x4*)(mixed + off + bj * HALF) = w;
                }
                asm volatile("" ::: "memory");
            }
    }
};

struct EpiRes {
    static constexpr bool PERM = true, AFTER_DRAIN = false;
    const float* xres; float* out; bf16_t* xb; float* sumsq;
    __device__ __forceinline__ void operator()(const f32x4 (&acc)[2][2][4][2], const Unit& u, int wr, int wc, int fr, int fq) const {
        const int col0 = u.pn * BM + wc * 32 + 8 * fq;
#pragma unroll
        for (int ai = 0; ai < 2; ++ai)
#pragma unroll
            for (int m = 0; m < 4; ++m) {
                const int row = u.pm * BM + ai * HALF + wr * 64 + m * 16 + fr;
                const size_t off = (size_t)row * 1024 + col0; float ss = 0.f;
#pragma unroll
                for (int bj = 0; bj < 2; ++bj) {
                    const f32x4 x0 = *(const f32x4*)(xres + off + bj * HALF), x1 = *(const f32x4*)(xres + off + bj * HALF + 4);
                    const f32x4 v0 = acc[ai][bj][m][0] + x0, v1 = acc[ai][bj][m][1] + x1;
                    *(f32x4*)(out + off + bj * HALF) = v0; *(f32x4*)(out + off + bj * HALF + 4) = v1;
                    u32x4 w; w.x = cvt_pk_bf16(v0[0], v0[1]); w.y = cvt_pk_bf16(v0[2], v0[3]); w.z = cvt_pk_bf16(v1[0], v1[1]); w.w = cvt_pk_bf16(v1[2], v1[3]);
                    *(u32x4*)(xb + off + bj * HALF) = w;
                    ss += (v0[0] * v0[0] + v0[1] * v0[1]) + (v0[2] * v0[2] + v0[3] * v0[3]) + (v1[0] * v1[0] + v1[1] * v1[1]) + (v1[2] * v1[2] + v1[3] * v1[3]);
                }
                ss += __shfl_xor(ss, 16); ss += __shfl_xor(ss, 32);
                if (fq == 0) sumsq[(size_t)row * 16 + u.pn * 4 + wc] = ss;
                asm volatile("" ::: "memory");
            }
    }
};

struct EpiUp {
    static constexpr bool PERM = true, AFTER_DRAIN = false;
    const float* sumsq; bf16_t* hid;
    __device__ __forceinline__ void operator()(const f32x4 (&acc)[2][2][4][2], const Unit& u, int wr, int wc, int fr, int fq) const {
        float rs[2][4]; row_rstd8(sumsq, u, wr, fr, fq, rs);
        const int col0 = u.pn * BM + wc * 32 + 8 * fq;
#pragma unroll
        for (int ai = 0; ai < 2; ++ai)
#pragma unroll
            for (int m = 0; m < 4; ++m) {
                bf16_t* rowp = hid + (size_t)(u.pm * BM + ai * HALF + wr * 64 + m * 16 + fr) * 4096 + col0; const float r = rs[ai][m];
#pragma unroll
                for (int bj = 0; bj < 2; ++bj) {
                    f32x4 v0 = acc[ai][bj][m][0] * r, v1 = acc[ai][bj][m][1] * r;
#pragma unroll
                    for (int e = 0; e < 4; ++e) { const float a = fmaxf(v0[e], 0.f), b = fmaxf(v1[e], 0.f); v0[e] = a * a; v1[e] = b * b; }
                    u32x4 w; w.x = cvt_pk_bf16(v0[0], v0[1]); w.y = cvt_pk_bf16(v0[2], v0[3]); w.z = cvt_pk_bf16(v1[0], v1[1]); w.w = cvt_pk_bf16(v1[2], v1[3]);
                    *(u32x4*)(rowp + bj * HALF) = w;
                }
                asm volatile("" ::: "memory");
            }
    }
};

template <class Epi, class Sched, bool ALIGN_EPI = false, bool SP2 = false>
__device__ __forceinline__ void gemm_phase(PG8_LAS unsigned char* lds, const Gemm g, const Sched& S, const Epi& E) {
    int tid_ = threadIdx.x; asm volatile("" : "+v"(tid_));
    const int tid = tid_, wid = __builtin_amdgcn_readfirstlane(tid >> 6), lane = tid & 63, wr = wid >> 2, wc = wid & 3, fr = lane & 15, fq = lane >> 4;
    const int K = g.K, nt = K / BK;
    unsigned voffA[2], voffB[2];
#pragma unroll
    for (int i = 0; i < 2; ++i) { int R, C; stage_rc(tid * 16 + i * 8192, R, C); const int Rb = Epi::PERM ? ((R & ~31) + perm32(R & 31)) : R;
        voffA[i] = (unsigned)(R * K + C) * 2u; voffB[i] = (unsigned)(Rb * K + C) * 2u; }
    const size_t kstep = (size_t)(BK * 2);
    const size_t hstep = (size_t)HALF * K * 2;
    const size_t tstep = 2 * hstep;
    const unsigned ldsw = (unsigned)wid * 1024u;
    const int aoff = lds_byte(wr * 64 + fr, fq * 8), boff = lds_byte(wc * 32 + fr, fq * 8);
#define PG8_SA(b, h) (((b) * 2 + (h)) * HTB)
#define PG8_SB(b, h) ((4 + (b) * 2 + (h)) * HTB)
#define PG8_STAGE(bufoff, gbase, voff) do { _Pragma("unroll") for (int _i = 0; _i < 2; ++_i) \
        __builtin_amdgcn_global_load_lds((const unsigned*)((const char*)(gbase) + (voff)[_i]), (PG8_LAS unsigned*)(lds + (bufoff) + ldsw + _i * 8192), 16, 0, 0); } while (0)
#define PG8_LDA(dst, b, h) do { _Pragma("unroll") for (int m = 0; m < 4; ++m) _Pragma("unroll") for (int k = 0; k < 2; ++k) dst[m][k] = *(const PG8_LAS bf16x8*)(lds + PG8_SA(b, h) + aoff + m * 2048 + k * 1024); } while (0)
#define PG8_LDB(dst, b, h) do { _Pragma("unroll") for (int n = 0; n < 2; ++n) _Pragma("unroll") for (int k = 0; k < 2; ++k) dst[n][k] = *(const PG8_LAS bf16x8*)(lds + PG8_SB(b, h) + boff + n * 2048 + k * 1024); } while (0)
#define PG8_MMA(ai, bj, At, Bt) do { __builtin_amdgcn_s_setprio(1); _Pragma("unroll") for (int m = 0; m < 4; ++m) _Pragma("unroll") for (int n = 0; n < 2; ++n) _Pragma("unroll") for (int k = 0; k < 2; ++k) \
        acc[ai][bj][m][n] = __builtin_amdgcn_mfma_f32_16x16x32_bf16(Bt[n][k], At[m][k], acc[ai][bj][m][n], 0, 0, 0); __builtin_amdgcn_s_setprio(0); } while (0)
#define PG8_WAIT_V(n) asm volatile("s_waitcnt vmcnt(" #n ")" ::: "memory")
#define PG8_WAIT_L(n) asm volatile("s_waitcnt lgkmcnt(" #n ")" ::: "memory")
#define PG8_BAR __builtin_amdgcn_s_barrier()
#define PG8_SCHED __builtin_amdgcn_sched_barrier(0)
    Unit cur, nxt; int ui = 0;
    if (!S.next(0, cur)) return;
    f32x4 acc[2][2][4][2];
#pragma unroll
    for (int a = 0; a < 2; ++a)
#pragma unroll
        for (int b = 0; b < 2; ++b)
#pragma unroll
            for (int m = 0; m < 4; ++m)
#pragma unroll
                for (int n = 0; n < 2; ++n) acc[a][b][m][n] = (f32x4){0.f, 0.f, 0.f, 0.f};
    bf16x8 At[4][2], B0[2][2], B1[2][2];
    const char* cA = (const char*)g.A + (size_t)cur.pm * tstep; const char* cB = (const char*)g.Bt + (size_t)cur.pn * tstep;
    S.a_ready(cur);
    if constexpr (SP2) {
        PG8_STAGE(PG8_SB(0, 0), cB, voffB); PG8_STAGE(PG8_SB(0, 1), cB + hstep, voffB); PG8_STAGE(PG8_SA(0, 0), cA, voffA); PG8_STAGE(PG8_SA(0, 1), cA + hstep, voffA);
        if (wr == 1) PG8_BAR;
        PG8_WAIT_V(2); PG8_BAR;
        PG8_STAGE(PG8_SB(1, 0), cB + kstep, voffB); PG8_STAGE(PG8_SA(1, 0), cA + kstep, voffA); PG8_STAGE(PG8_SB(1, 1), cB + hstep + kstep, voffB);
        PG8_WAIT_V(6); PG8_BAR;
    } else {
        PG8_STAGE(PG8_SB(0, 0), cB, voffB); PG8_STAGE(PG8_SA(0, 0), cA, voffA); PG8_STAGE(PG8_SB(0, 1), cB + hstep, voffB); PG8_STAGE(PG8_SA(0, 1), cA + hstep, voffA);
        if (wr == 1) PG8_BAR;
        PG8_WAIT_V(4); PG8_BAR;
        PG8_STAGE(PG8_SB(1, 0), cB + kstep, voffB); PG8_STAGE(PG8_SA(1, 0), cA + kstep, voffA); PG8_STAGE(PG8_SB(1, 1), cB + hstep + kstep, voffB);
        PG8_WAIT_V(6); PG8_BAR;
    }
    for (;;) {
        const bool has_next = S.next(ui + 1, nxt);
        const char* nA = has_next ? (const char*)g.A + (size_t)nxt.pm * tstep : cA; const char* nB = has_next ? (const char*)g.Bt + (size_t)nxt.pn * tstep : cB;
        for (int t = 0; t < nt; t += 2) {
            const bool last = (t == nt - 2);
            const char* a1 = cA + (size_t)(t + 1) * kstep;
            const char* a2 = last ? nA : cA + (size_t)(t + 2) * kstep; const char* b2 = last ? nB : cB + (size_t)(t + 2) * kstep;
            const char* a3 = a2 + kstep; const char* b3 = b2 + kstep;
            if (last && has_next) S.a_ready(nxt);
            if constexpr (SP2) {
            PG8_LDB(B0, 0, 0); PG8_LDB(B1, 0, 1); PG8_SCHED; PG8_LDA(At, 0, 0); PG8_STAGE(PG8_SA(1, 1), a1 + hstep, voffA);
            PG8_WAIT_V(8); PG8_WAIT_L(0); PG8_BAR; PG8_MMA(0, 0, At, B0); PG8_MMA(0, 1, At, B1); PG8_BAR; PG8_SCHED;
            PG8_LDA(At, 0, 1); PG8_STAGE(PG8_SB(0, 0), b2, voffB); PG8_STAGE(PG8_SB(0, 1), b2 + hstep, voffB); PG8_STAGE(PG8_SA(0, 0), a2, voffA);
            PG8_WAIT_V(8); PG8_WAIT_L(0); PG8_BAR; PG8_MMA(1, 0, At, B0); PG8_MMA(1, 1, At, B1); PG8_BAR; PG8_SCHED;
            PG8_LDB(B0, 1, 0); PG8_LDB(B1, 1, 1); PG8_SCHED; PG8_LDA(At, 1, 0); PG8_STAGE(PG8_SA(0, 1), a2 + hstep, voffA);
            PG8_WAIT_V(8); PG8_WAIT_L(0); PG8_BAR; PG8_MMA(0, 0, At, B0); PG8_MMA(0, 1, At, B1); PG8_BAR; PG8_SCHED;
            PG8_LDA(At, 1, 1); PG8_STAGE(PG8_SB(1, 0), b3, voffB); PG8_STAGE(PG8_SB(1, 1), b3 + hstep, voffB); PG8_STAGE(PG8_SA(1, 0), a3, voffA);
            PG8_WAIT_V(8); PG8_WAIT_L(0); PG8_BAR; PG8_MMA(1, 0, At, B0); PG8_MMA(1, 1, At, B1); PG8_BAR; PG8_SCHED;
            } else {
            PG8_LDB(B0, 0, 0); PG8_SCHED; PG8_LDA(At, 0, 0); PG8_STAGE(PG8_SA(1, 1), a1 + hstep, voffA);
            PG8_WAIT_L(8); PG8_BAR; PG8_WAIT_L(0); PG8_MMA(0, 0, At, B0); PG8_BAR; PG8_SCHED;
            PG8_LDB(B1, 0, 1); PG8_STAGE(PG8_SB(0, 0), b2, voffB);
            PG8_BAR; PG8_WAIT_L(0); PG8_MMA(0, 1, At, B1); PG8_BAR;
            PG8_LDA(At, 0, 1); PG8_STAGE(PG8_SA(0, 0), a2, voffA);
            PG8_BAR; PG8_WAIT_L(0); PG8_MMA(1, 0, At, B0); PG8_BAR; PG8_SCHED;
            PG8_STAGE(PG8_SB(0, 1), b2 + hstep, voffB);
            PG8_WAIT_V(6); PG8_BAR; PG8_MMA(1, 1, At, B1); PG8_BAR;
            PG8_LDB(B0, 1, 0); PG8_SCHED; PG8_LDA(At, 1, 0); PG8_STAGE(PG8_SA(0, 1), a2 + hstep, voffA);
            PG8_WAIT_L(8); PG8_BAR; PG8_WAIT_L(0); PG8_MMA(0, 0, At, B0); PG8_BAR; PG8_SCHED;
            PG8_LDB(B1, 1, 1); PG8_STAGE(PG8_SB(1, 0), b3, voffB);
            PG8_BAR; PG8_WAIT_L(0); PG8_MMA(0, 1, At, B1); PG8_BAR;
            PG8_LDA(At, 1, 1); PG8_STAGE(PG8_SA(1, 0), a3, voffA);
            PG8_BAR; PG8_WAIT_L(0); PG8_MMA(1, 0, At, B0); PG8_BAR; PG8_SCHED;
            PG8_STAGE(PG8_SB(1, 1), b3 + hstep, voffB);
            PG8_WAIT_V(6); PG8_BAR; PG8_MMA(1, 1, At, B1); PG8_BAR;
            }
        }
        if constexpr (ALIGN_EPI) { if (wr == 0) PG8_BAR; }
        if constexpr (!Epi::AFTER_DRAIN) { E(acc, cur, wr, wc, fr, fq); S.done(cur); }
        if (!has_next) break;
#pragma unroll
        for (int a = 0; a < 2; ++a)
#pragma unroll
            for (int b = 0; b < 2; ++b)
#pragma unroll
                for (int m = 0; m < 4; ++m)
#pragma unroll
                    for (int n = 0; n < 2; ++n) acc[a][b][m][n] = (f32x4){0.f, 0.f, 0.f, 0.f};
        cur = nxt; cA = nA; cB = nB; ++ui;
        if constexpr (ALIGN_EPI) { if (wr == 1) PG8_BAR; }
    }
    PG8_WAIT_V(0);
    if constexpr (!ALIGN_EPI) { if (wr == 0) PG8_BAR; }
    PG8_BAR;
    if constexpr (Epi::AFTER_DRAIN) { E.fused(acc, cur, wr, wc, fr, fq, lds, wid, lane); S.done(cur); }
#undef PG8_SA
#undef PG8_SB
#undef PG8_STAGE
#undef PG8_LDA
#undef PG8_LDB
#undef PG8_MMA
#undef PG8_WAIT_V
#undef PG8_WAIT_L
#undef PG8_BAR
#undef PG8_SCHED
}
}

#define LAS __attribute__((address_space(3)))
typedef unsigned short bf16_t;
typedef short bf16x8 __attribute__((ext_vector_type(8)));
typedef short bf16x4 __attribute__((ext_vector_type(4)));
typedef float f32x4 __attribute__((ext_vector_type(4)));
typedef unsigned u32x4 __attribute__((ext_vector_type(4)));
typedef unsigned u32x2 __attribute__((ext_vector_type(2)));
using pg8::cvt_pk_bf16; using pg8::bf_lo; using pg8::bf_hi; using pg8::sigm;

constexpr int T_TOK = 65536, DM = 1024, SEQ = 4096, NB = 16, DFF = 4096, NP_IN = 5632, IN_COLS = 5400;
constexpr int LDS_BYTES = 147456;
constexpr size_t MiB = (size_t)1 << 20;
constexpr size_t WS_CBIAS = 1 * MiB, WS_CW2T = 1 * MiB + 65536;
constexpr size_t WS_WIN = 2 * MiB, WS_WA = 24 * MiB, WS_WB = 26 * MiB, WS_WO = 28 * MiB, WS_WUP = 32 * MiB, WS_WDN = 48 * MiB, WS_CW1T = 64 * MiB;
constexpr size_t WS_SUMSQ = 66 * MiB, WS_KCMP = 70 * MiB, WS_VCMPT = 71 * MiB, WS_VST = 72 * MiB, WS_VWT = 88 * MiB, WS_XB = 104 * MiB;
constexpr size_t WS_HQ = 232 * MiB, WS_HF = 296 * MiB, WS_HI = 360 * MiB, WS_HG = 424 * MiB, WS_NQ = 488 * MiB, WS_KV = 552 * MiB, WS_NG = 648 * MiB, WS_SGA = 680 * MiB, WS_SGB = 808 * MiB;
constexpr size_t WS_MIXED = 232 * MiB, WS_HID = 232 * MiB, WS_EX = 936 * MiB, WS_END = 942 * MiB;
constexpr size_t EX_H = 0, EX_PP = 1 * MiB, EX_OAB = 2 * MiB + 524288, EX_YP = EX_OAB + 65536, EX_XP = EX_OAB + 524288, EX_UP = 3 * MiB + 524288, EX_DP = 4 * MiB + 524288;

struct Params {
    const float *x, *rel_bias, *lb_logits, *norm_mix, *w_in, *hg_gain, *qk_gain, *cmp_pos, *cmp_w1, *cmp_b1, *cmp_w2, *w_a, *w_b, *w_out, *norm_mlp, *w_up, *w_down;
    float* out; unsigned char* ws; int ph_lo, ph_hi;
};

__device__ __forceinline__ bf16x8 lds_ld8(const LAS unsigned char* p) { return *(const LAS bf16x8*)p; }
__device__ __forceinline__ bf16x8 lds_ld4x2(const LAS unsigned char* p0, const LAS unsigned char* p1) {
    const bf16x4 a = *(const LAS bf16x4*)p0, b = *(const LAS bf16x4*)p1; bf16x8 r;
    r[0] = a[0]; r[1] = a[1]; r[2] = a[2]; r[3] = a[3]; r[4] = b[0]; r[5] = b[1]; r[6] = b[2]; r[7] = b[3]; return r;
}
__device__ __forceinline__ bf16x8 pack8(const f32x4& a, const f32x4& b) {
    u32x4 w; w.x = cvt_pk_bf16(a[0], a[1]); w.y = cvt_pk_bf16(a[2], a[3]); w.z = cvt_pk_bf16(b[0], b[1]); w.w = cvt_pk_bf16(b[2], b[3]);
    return __builtin_bit_cast(bf16x8, w);
}
__device__ __forceinline__ unsigned short bf1(float v) { return (unsigned short)(cvt_pk_bf16(v, 0.f) & 0xffffu); }
__device__ __forceinline__ float bfu(unsigned short h) { return __uint_as_float(((unsigned)h) << 16); }
__device__ __forceinline__ int tid_opaque() { int t = threadIdx.x; asm volatile("" : "+v"(t)); return t; }
__device__ __forceinline__ int clampi(int v, int lo, int hi) { return v < lo ? lo : (v > hi ? hi : v); }
#define MFMA16(a, b, c) __builtin_amdgcn_mfma_f32_16x16x32_bf16((a), (b), (c), 0, 0, 0)

__device__ __forceinline__ float block_sum(float v, LAS float* red, int tid);
__device__ __forceinline__ void conv_matrix(const float* W, int K, int N, bf16_t* WT, const float* scale, int nshift_from, int nshift, LAS unsigned char* lds) {
    LAS float* tile = (LAS float*)lds;
    const int tid = tid_opaque(), nnb = (N + 63) / 64, items = (K / 64) * nnb;
#pragma unroll 1
    for (int it = blockIdx.x; it < items; it += gridDim.x) {
        const int kb = it / nnb, nb = it % nnb, k0 = kb * 64, n0 = nb * 64;
#pragma unroll
        for (int i = 0; i < 8; ++i) {
            const int k = i * 8 + (tid >> 6), n = tid & 63;
            float v = 0.f;
            if (n0 + n < N) { v = W[(size_t)(k0 + k) * N + n0 + n]; if (scale) v *= scale[k0 + k]; }
            tile[k * 65 + n] = v;
        }
        __syncthreads();
        {
            const int n = tid >> 3, kc = tid & 7;
            if (n0 + n < N) {
                const LAS float* s = tile + (kc * 8) * 65 + n;
                u32x4 o; o.x = cvt_pk_bf16(s[0], s[65]); o.y = cvt_pk_bf16(s[2 * 65], s[3 * 65]); o.z = cvt_pk_bf16(s[4 * 65], s[5 * 65]); o.w = cvt_pk_bf16(s[6 * 65], s[7 * 65]);
                int nn = n0 + n; if (nn >= nshift_from) nn += nshift;
                *(u32x4*)(WT + (size_t)nn * K + k0 + kc * 8) = o;
            }
        }
        __syncthreads();
    }
}

__device__ __forceinline__ void prologue(const Params& p, LAS unsigned char* lds) {
    unsigned char* ws = p.ws;
    const int tid = tid_opaque(), lane = tid & 63, wave = tid >> 6;
#pragma unroll 1
    for (int mj = 0; mj < 20; ++mj) {
        const int l = mj / 10, m = mj % 10;
        const float* W; int K, N; bf16_t* WT; const float* scale = nullptr; int sfrom = 1 << 30, sh = 0;
        if (m == 0) { W = p.w_in + (size_t)l * DM * IN_COLS; K = DM; N = IN_COLS; WT = (bf16_t*)(ws + WS_WIN) + (size_t)l * NP_IN * DM; scale = p.norm_mix + l * DM; sfrom = 3352; sh = 232; }
        else if (m == 1) { W = p.w_a + (size_t)l * 512 * DM; K = 512; N = DM; WT = (bf16_t*)(ws + WS_WA) + (size_t)l * DM * 512; }
        else if (m == 2) { W = p.w_b + (size_t)l * 512 * DM; K = 512; N = DM; WT = (bf16_t*)(ws + WS_WB) + (size_t)l * DM * 512; }
        else if (m == 3) { W = p.w_out + (size_t)l * DM * DM; K = DM; N = DM; WT = (bf16_t*)(ws + WS_WO) + (size_t)l * DM * DM; }
        else if (m == 4) { W = p.w_up + (size_t)l * DM * DFF; K = DM; N = DFF; WT = (bf16_t*)(ws + WS_WUP) + (size_t)l * DFF * DM; scale = p.norm_mlp + l * DM; }
        else if (m == 5) { W = p.w_down + (size_t)l * DFF * DM; K = DFF; N = DM; WT = (bf16_t*)(ws + WS_WDN) + (size_t)l * DM * DFF; }
        else if (m < 8) { const int j = m - 6; W = p.cmp_w1 + (size_t)(l * 2 + j) * 2048 * 128; K = 2048; N = 128; WT = (bf16_t*)(ws + WS_CW1T) + (size_t)(l * 2 + j) * 128 * 2048; }
        else { const int j = m - 8; W = p.cmp_w2 + (size_t)(l * 2 + j) * 128 * 64; K = 128; N = 64; WT = (bf16_t*)(ws + WS_CW2T) + (size_t)(l * 2 + j) * 64 * 128; }
        conv_matrix(W, K, N, WT, scale, sfrom, sh, lds);
    }
    for (int l = 0; l < 2; ++l) {
        u32x4* z = (u32x4*)((bf16_t*)(ws + WS_WIN) + (size_t)l * NP_IN * DM + (size_t)3352 * DM);
        for (int i = blockIdx.x * 512 + tid; i < 232 * DM / 8; i += gridDim.x * 512) z[i] = (u32x4){0u, 0u, 0u, 0u};
    }
    if (blockIdx.x < 4) {
        const int lj = blockIdx.x, n = tid & 127, kq = tid >> 7;
        const float* W1 = p.cmp_w1 + (size_t)lj * 2048 * 128; const float* pos = p.cmp_pos + (size_t)lj * 2048;
        float s = 0.f;
#pragma unroll 4
        for (int k = kq * 512; k < kq * 512 + 512; ++k) s += pos[k] * W1[(size_t)k * 128 + n];
        LAS float* red = (LAS float*)(lds + 32768);
        red[kq * 128 + n] = s;
        __syncthreads();
        if (tid < 128) ((float*)(ws + WS_CBIAS))[lj * 128 + tid] = p.cmp_b1[lj * 128 + tid] + (red[tid] + red[128 + tid]) + (red[256 + tid] + red[384 + tid]);
        __syncthreads();
    }
    if (blockIdx.x >= 16 && blockIdx.x < 32) {
        const int r = blockIdx.x - 16; float* EH = (float*)(ws + WS_EX + EX_H);
        const float xa = p.x[(size_t)r * SEQ * DM + tid], xb2 = p.x[(size_t)r * SEQ * DM + 512 + tid];
        const float ss = block_sum(xa * xa + xb2 * xb2, (LAS float*)(lds + 32768), tid);
        const float rstd = rsqrtf(ss * (1.0f / 1024.0f) + 1e-6f);
        EH[r * 1024 + tid] = xa * rstd * p.norm_mix[tid]; EH[r * 1024 + 512 + tid] = xb2 * rstd * p.norm_mix[512 + tid];
        __syncthreads();
    }
    {
        bf16_t* xb = (bf16_t*)(ws + WS_XB); float* sumsq = (float*)(ws + WS_SUMSQ);
#pragma unroll 1
        for (int row = blockIdx.x * 8 + wave; row < T_TOK; row += gridDim.x * 8) {
            const f32x4* xr = (const f32x4*)(p.x + (size_t)row * DM) + lane;
            f32x4 v[4]; float s = 0.f;
#pragma unroll
            for (int j = 0; j < 4; ++j) { v[j] = xr[64 * j]; s += (v[j][0] * v[j][0] + v[j][1] * v[j][1]) + (v[j][2] * v[j][2] + v[j][3] * v[j][3]); }
#pragma unroll
            for (int o = 1; o < 64; o <<= 1) s += __shfl_xor(s, o);
            u32x2* o8 = (u32x2*)(xb + (size_t)row * DM) + lane;
#pragma unroll
            for (int j = 0; j < 4; ++j) { u32x2 w; w.x = cvt_pk_bf16(v[j][0], v[j][1]); w.y = cvt_pk_bf16(v[j][2], v[j][3]); o8[64 * j] = w; }
            if (lane < 16) sumsq[(size_t)row * 16 + lane] = (lane == 0) ? s : 0.f;
        }
    }
}

template <class InFn>
__device__ __forceinline__ void exact_stage(const float* W0, const float* W1, int wsplit, int K, int N, float* part, InFn in_fn, LAS unsigned char* lds) {
    const int tid = tid_opaque(), lane = tid & 63, wave = tid >> 6;
    const int nsl = K / 256, ncg = (N + 511) / 512, ntasks = nsl * ncg;
    LAS float* IN = (LAS float*)lds;
#pragma unroll 1
    for (int task = blockIdx.x; task < ntasks; task += gridDim.x) {
        const int sl = task % nsl, cg = task / nsl;
        __syncthreads();
#pragma unroll 1
        for (int idx = tid; idx < 4096; idx += 512) IN[idx] = in_fn(idx >> 8, sl * 256 + (idx & 255));
        __syncthreads();
        const int col = (cg * 8 + wave) * 64 + lane;
        if (col < N) {
            const float* Wp = ((sl < wsplit) ? W0 + (size_t)sl * 256 * N : W1 + (size_t)(sl - wsplit) * 256 * N) + col;
            float acc[16];
#pragma unroll
            for (int r = 0; r < 16; ++r) acc[r] = 0.f;
#pragma unroll 2
            for (int k = 0; k < 256; k += 4) {
                const float w0 = Wp[(size_t)k * N], w1 = Wp[(size_t)(k + 1) * N], w2 = Wp[(size_t)(k + 2) * N], w3 = Wp[(size_t)(k + 3) * N];
#pragma unroll
                for (int r = 0; r < 16; ++r) { const f32x4 v = *(const LAS f32x4*)(IN + r * 256 + k); acc[r] += (v[0] * w0 + v[1] * w1) + (v[2] * w2 + v[3] * w3); }
            }
#pragma unroll
            for (int r = 0; r < 16; ++r) part[((size_t)sl * 16 + r) * N + col] = acc[r];
        }
    }
    __syncthreads();
}
__device__ __forceinline__ float block_sum(float v, LAS float* red, int tid) {
#pragma unroll
    for (int o = 1; o < 64; o <<= 1) v += __shfl_xor(v, o);
    __syncthreads();
    if ((tid & 63) == 0) red[tid >> 6] = v;
    __syncthreads();
    float s = 0.f;
#pragma unroll
    for (int i = 0; i < 8; ++i) s += red[i];
    return s;
}
__device__ __forceinline__ float ex_pp(const float* PP, int r, int c) { return (PP[(size_t)r * IN_COLS + c] + PP[(size_t)(16 + r) * IN_COLS + c]) + (PP[(size_t)(32 + r) * IN_COLS + c] + PP[(size_t)(48 + r) * IN_COLS + c]); }
__device__ __forceinline__ void exact_mixers(const Params& p, int r, LAS unsigned char* lds) {
    const int tid = tid_opaque();
    const float* PP = (const float*)(p.ws + WS_EX + EX_PP); float* OAB = (float*)(p.ws + WS_EX + EX_OAB);
    LAS float* red = (LAS float*)(lds + 32768);
    const int j = tid, h = j >> 7, e = j & 127;
    const float q = ex_pp(PP, r, j), z = ex_pp(PP, r, 512 + j), iv = ex_pp(PP, r, 1024 + j), g = ex_pp(PP, r, 1536 + j);
    float pr = q * (1.0f / (1.0f + __expf(z)));
#pragma unroll
    for (int o = 1; o < 64; o <<= 1) pr += __shfl_xor(pr, o);
    __syncthreads();
    if ((tid & 63) == 0) red[tid >> 6] = pr;
    __syncthreads();
    const float sh = red[2 * h] + red[2 * h + 1];
    const float o = sh * iv;
    float sq = o * o;
#pragma unroll
    for (int o2 = 1; o2 < 64; o2 <<= 1) sq += __shfl_xor(sq, o2);
    __syncthreads();
    if ((tid & 63) == 0) red[tid >> 6] = sq;
    __syncthreads();
    const float rstd = rsqrtf((red[2 * h] + red[2 * h + 1]) * (1.0f / 128.0f) + 1e-6f);
    OAB[(size_t)r * 1024 + j] = o * rstd * p.hg_gain[e] * (g / (1.0f + __expf(-g)));
    const int hh = j >> 6, d = j & 63, gg = hh >> 2, hp = hh & 3;
    const float vs = ex_pp(PP, r, 2944 + gg * 64 + d), vw = ex_pp(PP, r, 3200 + gg * 64 + d);
    const float gs = ex_pp(PP, r, 3328 + gg * 12 + hp * 3 + 1), gw = ex_pp(PP, r, 3328 + gg * 12 + hp * 3 + 2);
    OAB[(size_t)r * 1024 + 512 + j] = vs / (1.0f + __expf(-gs)) + vw / (1.0f + __expf(-gw));
    __syncthreads();
}
__device__ __forceinline__ float ex_x1(const Params& p, int r, int k) {
    const float* XP = (const float*)(p.ws + WS_EX + EX_XP);
    return p.x[(size_t)r * SEQ * DM + k] + ((XP[(size_t)r * 1024 + k] + XP[(size_t)(16 + r) * 1024 + k]) + (XP[(size_t)(32 + r) * 1024 + k] + XP[(size_t)(48 + r) * 1024 + k]));
}
__device__ __forceinline__ float ex_x2(const Params& p, int r, int k) {
    const float* DP = (const float*)(p.ws + WS_EX + EX_DP);
    float s = 0.f;
#pragma unroll
    for (int i = 0; i < 16; ++i) s += DP[((size_t)i * 16 + r) * 1024 + k];
    return ex_x1(p, r, k) + s;
}

constexpr int HG_TOT = 0, HG_DEC = 2048, HG_QB = 2560, HG_QS = HG_QB + 17408, HG_KVER = HG_QS + 17408, HG_KHT = HG_KVER + 43520, HG_VT = HG_KHT + 18432, HG_AM = HG_VT + 4608, HG_END = HG_AM + 9216;
static_assert(HG_END <= LDS_BYTES, "hgrn lds");
__device__ __forceinline__ void hgrn_unit(const Params& p, int layer, int unit, LAS unsigned char* lds) {
    unsigned char* ws = p.ws;
    const int tid = tid_opaque(), lane = tid & 63, wave = tid >> 6, l16 = lane & 15, quad = lane >> 4;
    const int b = unit >> 4, h = (unit >> 2) & 3, sl = unit & 3;
    const int d = tid & 127, tq = tid >> 7;
    const bf16_t* qg = (const bf16_t*)(ws + WS_HQ) + (size_t)b * SEQ * 512 + h * 128 + d;
    const bf16_t* zg = (const bf16_t*)(ws + WS_HF) + (size_t)b * SEQ * 512 + h * 128 + d;
    bf16_t* vg = (bf16_t*)(ws + WS_HI) + (size_t)b * SEQ * 512 + h * 128 + sl * 32;
    float lb = 0.f;
    if (layer == 1) lb = sigm(p.lb_logits[512 + h * 128 + d] - p.lb_logits[h * 128 + d]);
    const float omlb = 1.0f - lb;
    const int vv = tid & 31, sq = tid >> 5;
    const int tt = wave & 3, vt = wave >> 2;
    LAS float* TOT = (LAS float*)(lds + HG_TOT); LAS float* DEC = (LAS float*)(lds + HG_DEC);
    f32x4 S[8];
#pragma unroll
    for (int i = 0; i < 8; ++i) S[i] = (f32x4){0.f, 0.f, 0.f, 0.f};
    float s00;
    {
        LAS float* XR = (LAS float*)(lds + HG_KVER);
        LAS float* red0 = (LAS float*)(lds + HG_TOT);
        const float* nm = p.norm_mix + layer * DM;
        const float xa = (layer == 0) ? p.x[(size_t)b * SEQ * DM + tid] : ex_x2(p, b, tid);
        const float xb2 = (layer == 0) ? p.x[(size_t)b * SEQ * DM + 512 + tid] : ex_x2(p, b, 512 + tid);
        XR[tid] = xa * nm[tid]; XR[512 + tid] = xb2 * nm[512 + tid];
        const float ss = block_sum(xa * xa + xb2 * xb2, red0, tid);
        const float rstd = rsqrtf(ss * (1.0f / 1024.0f) + 1e-6f);
        __syncthreads();
        const float* W = p.w_in + (size_t)layer * DM * IN_COLS + h * 128 + d;
        float q0 = 0.f, z0 = 0.f;
#pragma unroll 4
        for (int k = tq * 256; k < tq * 256 + 256; ++k) { const float hk = XR[k]; q0 += hk * W[(size_t)k * IN_COLS]; z0 += hk * W[(size_t)k * IN_COLS + 512]; }
        LAS float* RED = (LAS float*)(lds + HG_QB);
        RED[tq * 128 + d] = q0; RED[512 + tq * 128 + d] = z0;
        __syncthreads();
        q0 = (RED[d] + RED[128 + d]) + (RED[256 + d] + RED[384 + d]); z0 = (RED[512 + d] + RED[640 + d]) + (RED[768 + d] + RED[896 + d]);
        q0 *= rstd; z0 *= rstd;
        float pr = q0 * (omlb / (1.0f + __expf(z0)));
#pragma unroll
        for (int o = 1; o < 64; o <<= 1) pr += __shfl_xor(pr, o);
        __syncthreads();
        if (lane == 0) RED[wave] = pr;
        __syncthreads();
        s00 = RED[0] + RED[1];
#ifdef DIAG_S00
        if (layer == 1 && tid == 0) atomicMin((unsigned*)(ws + 512), __float_as_uint(fabsf(s00)));
#endif
        __syncthreads();
    }
    typedef unsigned short us2 __attribute__((ext_vector_type(2)));
    us2 qz[16]; unsigned short vr[4];
#pragma unroll
    for (int i = 0; i < 16; ++i) { qz[i].x = qg[(size_t)(16 * tq + i) * 512]; qz[i].y = zg[(size_t)(16 * tq + i) * 512]; }
#pragma unroll
    for (int i = 0; i < 4; ++i) vr[i] = vg[(size_t)(4 * sq + i) * 512 + vv];
    for (int c = 0; c < 64; ++c) {
        float q[16], kk[16], e1[16]; unsigned short vcur[4];
        {
            float prod = 1.f;
#pragma unroll
            for (int i = 0; i < 16; ++i) {
                q[i] = bfu(qz[i].x); const float z = bfu(qz[i].y);
                const float ez = __expf(-z);
                const float inv = __builtin_amdgcn_rcpf(1.0f + ez);
                const float f = lb + omlb * inv;
                kk[i] = omlb * (ez * inv);
                prod *= f; e1[i] = prod;
            }
#pragma unroll
            for (int i = 0; i < 4; ++i) vcur[i] = vr[i];
        }
        TOT[tq * 128 + d] = __logf(fmaxf(e1[15], 1e-37f));
        __syncthreads();
        const float t0 = TOT[d], t1 = TOT[128 + d], t2 = TOT[256 + d], t3 = TOT[384 + d];
        const float r1 = t0, r2 = t0 + t1, r3 = r2 + t2, r4 = r3 + t3;
        const float rJ = (tq == 0) ? 0.f : ((tq == 1) ? r1 : ((tq == 2) ? r2 : r3));
        if (tq == 0) DEC[d] = __expf(r4);
        {
            LAS bf16_t* QB = (LAS bf16_t*)(lds + HG_QB); LAS bf16_t* QS = (LAS bf16_t*)(lds + HG_QS); LAS bf16_t* KV_ = (LAS bf16_t*)(lds + HG_KVER);
            float kh[16], ri[16];
            const float eJ = __expf(rJ), c4 = __expf(r4 - rJ);
#pragma unroll
            for (int i = 0; i < 16; ++i) {
                const int t = 16 * tq + i;
                ri[i] = kk[i] * __builtin_amdgcn_rcpf(fmaxf(e1[i], 1e-30f));
                const float qs = q[i] * e1[i];
                QS[t * 136 + d] = bf1(qs);
                QB[t * 136 + d] = bf1(qs * eJ);
                kh[i] = ri[i] * c4;
            }
#pragma unroll
            for (int I = 0; I < 4; ++I) {
                if (I >= tq) {
                    const float rI = (I == 0) ? 0.f : ((I == 1) ? r1 : ((I == 2) ? r2 : r3));
                    const int voff = (I == 0) ? 0 : ((I == 1) ? 16 : ((I == 2) ? 48 : 96));
                    const float csh = __expf(rI - rJ);
#pragma unroll
                    for (int i = 0; i < 16; ++i) KV_[(voff + 16 * tq + i) * 136 + d] = bf1(ri[i] * csh);
                }
            }
            LAS unsigned char* KHT = lds + HG_KHT;
            u32x4 w0, w1;
            w0.x = cvt_pk_bf16(kh[0], kh[1]); w0.y = cvt_pk_bf16(kh[2], kh[3]); w0.z = cvt_pk_bf16(kh[4], kh[5]); w0.w = cvt_pk_bf16(kh[6], kh[7]);
            w1.x = cvt_pk_bf16(kh[8], kh[9]); w1.y = cvt_pk_bf16(kh[10], kh[11]); w1.z = cvt_pk_bf16(kh[12], kh[13]); w1.w = cvt_pk_bf16(kh[14], kh[15]);
            *(LAS u32x4*)(KHT + d * 144 + tq * 32) = w0; *(LAS u32x4*)(KHT + d * 144 + tq * 32 + 16) = w1;
            LAS unsigned char* VT = lds + HG_VT;
            u32x2 wv; wv.x = (unsigned)vcur[0] | ((unsigned)vcur[1] << 16); wv.y = (unsigned)vcur[2] | ((unsigned)vcur[3] << 16);
            *(LAS u32x2*)(VT + vv * 144 + sq * 8) = wv;
            LAS u32x4* AMz = (LAS u32x4*)(lds + HG_AM);
            AMz[tid] = (u32x4){0u, 0u, 0u, 0u}; if (tid < 64) AMz[512 + tid] = (u32x4){0u, 0u, 0u, 0u};
        }
        __syncthreads();
        if (c + 1 < 64) {
            const size_t ro = (size_t)(c + 1) * 64 * 512;
#pragma unroll
            for (int i = 0; i < 16; ++i) { qz[i].x = qg[ro + (size_t)(16 * tq + i) * 512]; qz[i].y = zg[ro + (size_t)(16 * tq + i) * 512]; }
#pragma unroll
            for (int i = 0; i < 4; ++i) vr[i] = vg[ro + (size_t)(4 * sq + i) * 512 + vv];
        }
        for (int pi = wave; pi < 10; pi += 8) {
            int I, J;
            if (pi == 0) { I = 0; J = 0; } else if (pi < 3) { I = 1; J = pi - 1; } else if (pi < 6) { I = 2; J = pi - 3; } else { I = 3; J = pi - 6; }
            const int voff = (I == 0) ? 0 : ((I == 1) ? 16 : ((I == 2) ? 48 : 96));
            const LAS unsigned char* qa = lds + HG_QS + (16 * I + l16) * 272 + quad * 16;
            const LAS unsigned char* kb = lds + HG_KVER + (voff + 16 * J + l16) * 272 + quad * 16;
            f32x4 a = (f32x4){0.f, 0.f, 0.f, 0.f};
#pragma unroll
            for (int ks = 0; ks < 4; ++ks) a = MFMA16(lds_ld8(qa + ks * 64), lds_ld8(kb + ks * 64), a);
            LAS bf16_t* AM = (LAS bf16_t*)(lds + HG_AM);
#pragma unroll
            for (int j = 0; j < 4; ++j) {
                float v = a[j]; if (I == J && l16 > quad * 4 + j) v = 0.f;
                if (c == 0 && pi == 0 && lane == 0 && j == 0) v = s00;
                AM[(16 * I + quad * 4 + j) * 72 + 16 * J + l16] = bf1(v);
            }
        }
        __syncthreads();
        {
            f32x4 o = (f32x4){0.f, 0.f, 0.f, 0.f};
            const LAS unsigned char* qb = lds + HG_QB + (16 * tt + l16) * 272 + quad * 8;
#pragma unroll
            for (int s2 = 0; s2 < 4; ++s2) o = MFMA16(lds_ld4x2(qb + s2 * 64, qb + s2 * 64 + 32), pack8(S[2 * s2], S[2 * s2 + 1]), o);
            const LAS unsigned char* am = lds + HG_AM + (16 * tt + l16) * 144 + quad * 16;
            const LAS unsigned char* vb = lds + HG_VT + (16 * vt + l16) * 144 + quad * 16;
            const bf16x8 vb0 = lds_ld8(vb), vb1 = lds_ld8(vb + 64);
            o = MFMA16(lds_ld8(am), vb0, o); o = MFMA16(lds_ld8(am + 64), vb1, o);
            bf16_t* og = (bf16_t*)(ws + WS_XB) + (size_t)b * SEQ * 512 + h * 128 + sl * 32 + (size_t)(c * 64 + 16 * tt + quad * 4) * 512 + 16 * vt + l16;
#pragma unroll
            for (int j = 0; j < 4; ++j) og[(size_t)j * 512] = bf1(o[j]);
#pragma unroll
            for (int dt = 0; dt < 8; ++dt) {
                const f32x4 dc = *(const LAS f32x4*)(DEC + 16 * dt + quad * 4);
                const LAS unsigned char* ka = lds + HG_KHT + (16 * dt + l16) * 144 + quad * 16;
                f32x4 s = S[dt] * dc;
                s = MFMA16(lds_ld8(ka), vb0, s); s = MFMA16(lds_ld8(ka + 64), vb1, s);
                S[dt] = s;
            }
        }
        __syncthreads();
    }
}

__device__ __forceinline__ void hgrn_finalize(const Params& p, int layer) {
    unsigned char* ws = p.ws;
    const int tid = tid_opaque(), lane = tid & 63, wave = tid >> 6;
    const float* gain = p.hg_gain + layer * 128 + (lane & 15) * 8;
    float gn[8];
#pragma unroll
    for (int e = 0; e < 8; ++e) gn[e] = gain[e];
    for (int row = blockIdx.x * 8 + wave; row < T_TOK; row += gridDim.x * 8) {
        u32x4* op = (u32x4*)((bf16_t*)(ws + WS_HI) + (size_t)row * 512) + lane;
        const u32x4 ov = *((const u32x4*)((const bf16_t*)(ws + WS_XB) + (size_t)row * 512) + lane), gv = *((const u32x4*)((const bf16_t*)(ws + WS_HG) + (size_t)row * 512) + lane);
        float o[8], g[8];
        o[0] = bf_lo(ov.x); o[1] = bf_hi(ov.x); o[2] = bf_lo(ov.y); o[3] = bf_hi(ov.y); o[4] = bf_lo(ov.z); o[5] = bf_hi(ov.z); o[6] = bf_lo(ov.w); o[7] = bf_hi(ov.w);
        g[0] = bf_lo(gv.x); g[1] = bf_hi(gv.x); g[2] = bf_lo(gv.y); g[3] = bf_hi(gv.y); g[4] = bf_lo(gv.z); g[5] = bf_hi(gv.z); g[6] = bf_lo(gv.w); g[7] = bf_hi(gv.w);
        float s = 0.f;
#pragma unroll
        for (int e = 0; e < 8; ++e) s += o[e] * o[e];
        s += __shfl_xor(s, 1); s += __shfl_xor(s, 2); s += __shfl_xor(s, 4); s += __shfl_xor(s, 8);
        const float rstd = rsqrtf(s * (1.0f / 128.0f) + 1e-6f);
#pragma unroll
        for (int e = 0; e < 8; ++e) o[e] = o[e] * rstd * gn[e] * (g[e] * sigm(g[e]));
        u32x4 w; w.x = cvt_pk_bf16(o[0], o[1]); w.y = cvt_pk_bf16(o[2], o[3]); w.z = cvt_pk_bf16(o[4], o[5]); w.w = cvt_pk_bf16(o[6], o[7]);
        *op = w;
    }
}

constexpr int CM_A = 0, CM_W = 9216, CM_H = CM_W + 18432, CM_W2 = CM_H + 17408, CM_END = CM_W2 + 17408;
__device__ __forceinline__ void cmp_unit(const Params& p, int layer, int unit, LAS unsigned char* lds) {
    unsigned char* ws = p.ws;
    const int tid = tid_opaque(), lane = tid & 63, wave = tid >> 6, l16 = lane & 15, quad = lane >> 4;
    const int ct = unit & 3, kv = (unit >> 2) & 1, g = (unit >> 3) & 1, b = unit >> 4;
    const bf16_t* src = (const bf16_t*)(ws + WS_KV) + (size_t)b * SEQ * 768 + kv * 128 + g * 64;
    const bf16_t* W1T = (const bf16_t*)(ws + WS_CW1T) + (size_t)(layer * 2 + kv) * 128 * 2048;
    const bf16_t* W2T = (const bf16_t*)(ws + WS_CW2T) + (size_t)(layer * 2 + kv) * 64 * 128;
    const float* cbias = (const float*)(ws + WS_CBIAS) + (layer * 2 + kv) * 128;
    {
        const int n = tid >> 3, ch = tid & 7;
        *(LAS u32x4*)(lds + CM_W2 + n * 272 + ch * 32) = *(const u32x4*)(W2T + n * 128 + ch * 16);
        *(LAS u32x4*)(lds + CM_W2 + n * 272 + ch * 32 + 16) = *(const u32x4*)(W2T + n * 128 + ch * 16 + 8);
    }
    const int arow = tid >> 3, ach = tid & 7, ac = ct * 64 + arow;
    const bool aval = ac < 255;
    const bf16_t* ap = src + (size_t)(16 * (aval ? ac : 0)) * 768 + ach * 8;
    const int mi = wave & 3, nh = wave >> 2;
    f32x4 acc[4];
#pragma unroll
    for (int i = 0; i < 4; ++i) acc[i] = (f32x4){0.f, 0.f, 0.f, 0.f};
    u32x4 ar, wr0, wr1;
    ar = aval ? *(const u32x4*)ap : (u32x4){0u, 0u, 0u, 0u};
    wr0 = *(const u32x4*)(W1T + (size_t)(tid >> 3) * 2048 + (tid & 7) * 8);
    wr1 = *(const u32x4*)(W1T + (size_t)(64 + (tid >> 3)) * 2048 + (tid & 7) * 8);
    for (int tok = 0; tok < 32; ++tok) {
        __syncthreads();
        *(LAS u32x4*)(lds + CM_A + arow * 144 + ach * 16) = ar;
        *(LAS u32x4*)(lds + CM_W + (tid >> 3) * 144 + (tid & 7) * 16) = wr0;
        *(LAS u32x4*)(lds + CM_W + (64 + (tid >> 3)) * 144 + (tid & 7) * 16) = wr1;
        __syncthreads();
        if (tok + 1 < 32) {
            ar = aval ? *(const u32x4*)(ap + (size_t)(tok + 1) * 768) : (u32x4){0u, 0u, 0u, 0u};
            wr0 = *(const u32x4*)(W1T + (size_t)(tid >> 3) * 2048 + (tok + 1) * 64 + (tid & 7) * 8);
            wr1 = *(const u32x4*)(W1T + (size_t)(64 + (tid >> 3)) * 2048 + (tok + 1) * 64 + (tid & 7) * 8);
        }
#pragma unroll
        for (int ks = 0; ks < 2; ++ks) {
            const bf16x8 a = lds_ld8(lds + CM_A + (mi * 16 + l16) * 144 + ks * 64 + quad * 16);
#pragma unroll
            for (int ni = 0; ni < 4; ++ni) acc[ni] = MFMA16(a, lds_ld8(lds + CM_W + ((nh * 4 + ni) * 16 + l16) * 144 + ks * 64 + quad * 16), acc[ni]);
        }
    }
    {
        LAS bf16_t* H = (LAS bf16_t*)(lds + CM_H);
#pragma unroll
        for (int ni = 0; ni < 4; ++ni) {
            const int n = (nh * 4 + ni) * 16 + l16; const float cb = cbias[n];
#pragma unroll
            for (int j = 0; j < 4; ++j) {
                const float x = acc[ni][j] + cb;
                const float u = 0.7978845608028654f * (x + 0.044715f * x * x * x);
                const float th = 1.0f - 2.0f / (__expf(2.0f * u) + 1.0f);
                H[(mi * 16 + quad * 4 + j) * 136 + n] = bf1(0.5f * x * (1.0f + th));
            }
        }
    }
    __syncthreads();
    if (wave < 4) {
        f32x4 a2[4];
#pragma unroll
        for (int i = 0; i < 4; ++i) a2[i] = (f32x4){0.f, 0.f, 0.f, 0.f};
#pragma unroll
        for (int ks = 0; ks < 4; ++ks) {
            const bf16x8 a = lds_ld8(lds + CM_H + (wave * 16 + l16) * 272 + ks * 64 + quad * 16);
#pragma unroll
            for (int ni = 0; ni < 4; ++ni) a2[ni] = MFMA16(a, lds_ld8(lds + CM_W2 + (ni * 16 + l16) * 272 + ks * 64 + quad * 16), a2[ni]);
        }
        if (kv == 0) {
            bf16_t* KC = (bf16_t*)(ws + WS_KCMP) + (size_t)(b * 2 + g) * 256 * 64;
            const float* gain = p.qk_gain + (layer * 4 + 1) * 64;
#pragma unroll
            for (int j = 0; j < 4; ++j) {
                float s = (a2[0][j] * a2[0][j] + a2[1][j] * a2[1][j]) + (a2[2][j] * a2[2][j] + a2[3][j] * a2[3][j]);
                s += __shfl_xor(s, 1); s += __shfl_xor(s, 2); s += __shfl_xor(s, 4); s += __shfl_xor(s, 8);
                const float rstd = rsqrtf(s * (1.0f / 64.0f) + 1e-6f);
                const int c = ct * 64 + wave * 16 + quad * 4 + j;
#pragma unroll
                for (int ni = 0; ni < 4; ++ni) KC[(size_t)c * 64 + ni * 16 + l16] = (c < 255) ? bf1(a2[ni][j] * rstd * gain[ni * 16 + l16]) : (bf16_t)0;
            }
        } else {
            bf16_t* VC = (bf16_t*)(ws + WS_VCMPT) + (size_t)(b * 2 + g) * 64 * 256;
#pragma unroll
            for (int j = 0; j < 4; ++j) {
                const int c = ct * 64 + wave * 16 + quad * 4 + j;
#pragma unroll
                for (int ni = 0; ni < 4; ++ni) VC[(size_t)(ni * 16 + l16) * 256 + c] = (c < 255) ? bf1(a2[ni][j]) : (bf16_t)0;
            }
        }
    }
    __syncthreads();
}

constexpr int AT_TAB = 0, AT_TABW = 13824, AT_K = 23296, AT_V = AT_K + 18432, AT_PS = AT_V + 18432, AT_MASK = AT_PS + 65536, AT_END = AT_MASK + 512;
static_assert(AT_END <= LDS_BYTES, "attn lds");

struct AttnCtx {
    const bf16_t* ksrc; const bf16_t* vsrc; int ldk, ldv; const float* kgain;
    int tpos[2]; int h;
};

template <int BR>
__device__ __forceinline__ void attn_branch(const AttnCtx& cx, const bf16x8 (&qf)[2][2], int qt, unsigned long long selu, const unsigned long long (&selm)[2],
                                            f32x4 (&of)[2][4], const float (&gate)[2], LAS unsigned char* lds, float (&m_out)[2], float (&il_out)[2]) {
    const int tid = tid_opaque(), lane = tid & 63, l16 = lane & 15, quad = lane >> 4;
    const int srow = tid >> 3, sch = tid & 7;
    float kg[8];
    if (BR != 0) {
#pragma unroll
        for (int e = 0; e < 8; ++e) kg[e] = cx.kgain[sch * 8 + e];
    }
    unsigned long long rem;
    if (BR == 0) rem = 0xFull;
    else if (BR == 1) rem = selu & ((qt >= 63) ? ~0ull : ((2ull << qt) - 1ull));
    else { const int lo = qt > 8 ? qt - 8 : 0; rem = ((qt >= 63) ? ~0ull : ((2ull << qt) - 1ull)) & ~((1ull << lo) - 1ull); }
    f32x4 o[2][4]; float l[2];
#pragma unroll
    for (int mi = 0; mi < 2; ++mi) { l[mi] = 0.f;
#pragma unroll
        for (int di = 0; di < 4; ++di) o[mi][di] = (f32x4){0.f, 0.f, 0.f, 0.f}; }
    int cur = rem ? __builtin_ctzll(rem) : -1; if (rem) rem &= rem - 1ull;
    u32x4 kr, vr;
    auto gload = [&](int jt) {
        kr = *(const u32x4*)(cx.ksrc + (size_t)(jt * 64 + srow) * cx.ldk + sch * 8);
        vr = *(const u32x4*)(cx.vsrc + (size_t)srow * cx.ldv + jt * 64 + sch * 8);
    };
    auto lstore = [&](int buf) {
        u32x4 kw = kr;
        if (BR != 0) {
            float f[8]; f[0] = bf_lo(kr.x); f[1] = bf_hi(kr.x); f[2] = bf_lo(kr.y); f[3] = bf_hi(kr.y); f[4] = bf_lo(kr.z); f[5] = bf_hi(kr.z); f[6] = bf_lo(kr.w); f[7] = bf_hi(kr.w);
            float s = 0.f;
#pragma unroll
            for (int e = 0; e < 8; ++e) s += f[e] * f[e];
            s += __shfl_xor(s, 1); s += __shfl_xor(s, 2); s += __shfl_xor(s, 4);
            const float rstd = rsqrtf(s * (1.0f / 64.0f) + 1e-6f);
#pragma unroll
            for (int e = 0; e < 8; ++e) f[e] = f[e] * rstd * kg[e];
            kw.x = cvt_pk_bf16(f[0], f[1]); kw.y = cvt_pk_bf16(f[2], f[3]); kw.z = cvt_pk_bf16(f[4], f[5]); kw.w = cvt_pk_bf16(f[6], f[7]);
        }
        *(LAS u32x4*)(lds + AT_K + buf * 9216 + srow * 144 + sch * 16) = kw;
        *(LAS u32x4*)(lds + AT_V + buf * 9216 + srow * 144 + sch * 16) = vr;
    };
    if (cur >= 0) { gload(cur); lstore(0); }
    __syncthreads();
    int buf = 0;
    const LAS f32x4* TAB = (const LAS f32x4*)(lds + AT_TAB);
    const LAS float* TABf = (const LAS float*)(lds + AT_TAB);
#pragma nounroll
    while (cur >= 0) {
        const int nxt = rem ? __builtin_ctzll(rem) : -1; if (rem) rem &= rem - 1ull;
        if (nxt >= 0) gload(nxt);
        const LAS unsigned char* Kb = lds + AT_K + buf * 9216; const LAS unsigned char* Vb = lds + AT_V + buf * 9216;
        f32x4 st[2][4];
        const bool far_tile = (BR == 1) && (cur * 64 + 63 + 790 <= qt * 64);
        const bool ok0 = (BR != 1) || ((selm[0] >> cur) & 1ull), ok1 = (BR != 1) || ((selm[1] >> cur) & 1ull);
        const float c31 = TABf[863 * 4 + cx.h];
        const float cb0 = ok0 ? c31 : -INFINITY, cb1 = ok1 ? c31 : -INFINITY;
        const int bs0 = ok0 ? ((BR == 0) ? (cx.tpos[0] + 33 - 16 * (cur * 64 + quad * 4)) : (cx.tpos[0] + 64 - cur * 64 - quad * 4)) : -(1 << 20);
        const int bs1 = ok1 ? ((BR == 0) ? (cx.tpos[1] + 33 - 16 * (cur * 64 + quad * 4)) : (cx.tpos[1] + 64 - cur * 64 - quad * 4)) : -(1 << 20);
        const LAS unsigned char* tb = lds + ((BR == 2) ? AT_TABW : AT_TAB) + cx.h * 4;
        constexpr int MAXI = (BR == 2) ? 576 : 863;
#pragma unroll
        for (int ni = 0; ni < 4; ++ni) {
            const bf16x8 k0 = lds_ld8(Kb + (ni * 16 + l16) * 144 + quad * 16), k1 = lds_ld8(Kb + (ni * 16 + l16) * 144 + 64 + quad * 16);
            f32x4 a0, a1;
            if (far_tile) { a0 = (f32x4){cb0, cb0, cb0, cb0}; a1 = (f32x4){cb1, cb1, cb1, cb1}; }
            else {
                constexpr int CM = (BR == 0) ? 16 : 1;
                const int i00 = clampi(bs0 - CM * (ni * 16 + 0), 0, MAXI), i01 = clampi(bs0 - CM * (ni * 16 + 1), 0, MAXI), i02 = clampi(bs0 - CM * (ni * 16 + 2), 0, MAXI), i03 = clampi(bs0 - CM * (ni * 16 + 3), 0, MAXI);
                const int i10 = clampi(bs1 - CM * (ni * 16 + 0), 0, MAXI), i11 = clampi(bs1 - CM * (ni * 16 + 1), 0, MAXI), i12 = clampi(bs1 - CM * (ni * 16 + 2), 0, MAXI), i13 = clampi(bs1 - CM * (ni * 16 + 3), 0, MAXI);
                a0 = (f32x4){*(const LAS float*)(tb + i00 * 16), *(const LAS float*)(tb + i01 * 16), *(const LAS float*)(tb + i02 * 16), *(const LAS float*)(tb + i03 * 16)};
                a1 = (f32x4){*(const LAS float*)(tb + i10 * 16), *(const LAS float*)(tb + i11 * 16), *(const LAS float*)(tb + i12 * 16), *(const LAS float*)(tb + i13 * 16)};
            }
            a0 = MFMA16(k0, qf[0][0], a0); a0 = MFMA16(k1, qf[0][1], a0); st[0][ni] = a0;
            a1 = MFMA16(k0, qf[1][0], a1); a1 = MFMA16(k1, qf[1][1], a1); st[1][ni] = a1;
            __builtin_amdgcn_sched_barrier(0);
        }
        bf16x8 pb[2][2];
#pragma unroll
        for (int mi = 0; mi < 2; ++mi) {
            float ls = 0.f;
#pragma unroll
            for (int ni = 0; ni < 4; ++ni)
#pragma unroll
                for (int j = 0; j < 4; ++j) { const float pv = __builtin_amdgcn_exp2f(st[mi][ni][j]); st[mi][ni][j] = pv; ls += pv; }
            l[mi] += ls;
            pb[mi][0] = pack8(st[mi][0], st[mi][1]); pb[mi][1] = pack8(st[mi][2], st[mi][3]);
        }
#pragma unroll
        for (int di = 0; di < 4; ++di)
#pragma unroll
            for (int s2 = 0; s2 < 2; ++s2) {
                const LAS unsigned char* vp = Vb + (di * 16 + l16) * 144 + s2 * 64 + quad * 8;
                const bf16x8 vf = lds_ld4x2(vp, vp + 32);
#pragma unroll
                for (int mi = 0; mi < 2; ++mi) o[mi][di] = MFMA16(vf, pb[mi][s2], o[mi][di]);
            }
        if (nxt >= 0) lstore(buf ^ 1);
        __syncthreads();
        cur = nxt; buf ^= 1;
    }
#pragma unroll
    for (int mi = 0; mi < 2; ++mi) {
        float lt = l[mi]; lt += __shfl_xor(lt, 16); lt += __shfl_xor(lt, 32);
        const float il = lt > 0.f ? 1.0f / lt : 0.f;
        const float sc = il * gate[mi];
#pragma unroll
        for (int di = 0; di < 4; ++di) of[mi][di] = of[mi][di] + o[mi][di] * sc;
        m_out[mi] = 0.f; il_out[mi] = il;
    }
    (void)TAB;
}

__device__ __forceinline__ void attn_cmp_probs(const AttnCtx& cx, const bf16x8 (&qf)[2][2], const float (&mrow)[2], const float (&ilrow)[2], LAS unsigned char* lds) {
    const int tid = tid_opaque(), lane = tid & 63, wave = tid >> 6, l16 = lane & 15, quad = lane >> 4;
    const int srow = tid >> 3, sch = tid & 7;
    const LAS float* TABf = (const LAS float*)(lds + AT_TAB);
    LAS float* PS = (LAS float*)(lds + AT_PS);
#pragma nounroll
    for (int jt = 0; jt < 4; ++jt) {
        const u32x4 kr = *(const u32x4*)(cx.ksrc + (size_t)(jt * 64 + srow) * cx.ldk + sch * 8);
        __syncthreads();
        *(LAS u32x4*)(lds + AT_K + srow * 144 + sch * 16) = kr;
        __syncthreads();
        const LAS unsigned char* Kb = lds + AT_K;
#pragma unroll
        for (int ni = 0; ni < 4; ++ni) {
            const bf16x8 k0 = lds_ld8(Kb + (ni * 16 + l16) * 144 + quad * 16), k1 = lds_ld8(Kb + (ni * 16 + l16) * 144 + 64 + quad * 16);
#pragma unroll
            for (int mi = 0; mi < 2; ++mi) {
                f32x4 a = (f32x4){0.f, 0.f, 0.f, 0.f}; a = MFMA16(k0, qf[mi][0], a); a = MFMA16(k1, qf[mi][1], a);
                const int tp = cx.tpos[mi];
                f32x4 pr;
#pragma unroll
                for (int j = 0; j < 4; ++j) {
                    const int kidx = jt * 64 + ni * 16 + quad * 4 + j;
                    int idx = tp + 33 - 16 * kidx; idx = idx < 0 ? 0 : (idx > 863 ? 863 : idx);
                    float pv = __builtin_amdgcn_exp2f(a[j] + TABf[idx * 4 + cx.h] - mrow[mi]) * ilrow[mi];
                    pv += __shfl_xor(pv, 1); pv += __shfl_xor(pv, 2);
                    pr[j] = pv;
                }
                if ((l16 & 3) == 0) *(LAS f32x4*)(PS + (wave * 8 + mi * 4 + (l16 >> 2)) * 256 + jt * 64 + ni * 16 + quad * 4) = pr;
            }
        }
    }
    __syncthreads();
}

__device__ __forceinline__ void attn_unit(const Params& p, int layer, int b, int g, int qt, LAS unsigned char* lds) {
    unsigned char* ws = p.ws;
    const int tid = tid_opaque(), lane = tid & 63, wave = tid >> 6, l16 = lane & 15, quad = lane >> 4;
    const int t0 = qt * 64;
    __syncthreads();
    {
        LAS float* TABw = (LAS float*)(lds + AT_TAB); LAS float* TABW2 = (LAS float*)(lds + AT_TABW);
        for (int i = tid; i < 864 * 4; i += 512) {
            const int dist = (i >> 2) - 64, hh = i & 3;
            int bk;
            if (dist < 16) bk = dist < 0 ? 0 : dist;
            else { bk = 16 + (dist >= 21) + (dist >= 27) + (dist >= 35) + (dist >= 46) + (dist >= 59) + (dist >= 77) + (dist >= 99) + (dist >= 128) + (dist >= 166) + (dist >= 216) + (dist >= 280) + (dist >= 363) + (dist >= 470) + (dist >= 609) + (dist >= 790); }
            const float v = (dist < 0) ? -INFINITY : p.rel_bias[bk * 8 + g * 4 + hh] * 1.4426950408889634f;
            TABw[i] = v;
            if (i < 577 * 4) TABW2[i] = (i < 576 * 4) ? v : -INFINITY;
        }
    }
    AttnCtx cx; cx.h = l16 & 3;
    bf16x8 qf[2][2]; float gates[3][2];
    bf16_t* nq = (bf16_t*)(ws + WS_NQ);
    const bf16_t* ng = (const bf16_t*)(ws + WS_NG);
    const float* qgain = p.qk_gain + (layer * 4 + 0) * 64;
#pragma unroll
    for (int mi = 0; mi < 2; ++mi) {
        const int tl = wave * 8 + mi * 4 + (l16 >> 2); const int tp = t0 + tl; cx.tpos[mi] = tp;
        const size_t row = (size_t)b * SEQ + tp;
        const bf16_t* qp = nq + row * 512 + g * 256 + cx.h * 64 + quad * 8;
        const u32x4 q0 = *(const u32x4*)qp, q1 = *(const u32x4*)(qp + 32);
        float f[16];
        f[0] = bf_lo(q0.x); f[1] = bf_hi(q0.x); f[2] = bf_lo(q0.y); f[3] = bf_hi(q0.y); f[4] = bf_lo(q0.z); f[5] = bf_hi(q0.z); f[6] = bf_lo(q0.w); f[7] = bf_hi(q0.w);
        f[8] = bf_lo(q1.x); f[9] = bf_hi(q1.x); f[10] = bf_lo(q1.y); f[11] = bf_hi(q1.y); f[12] = bf_lo(q1.z); f[13] = bf_hi(q1.z); f[14] = bf_lo(q1.w); f[15] = bf_hi(q1.w);
        float s = 0.f;
#pragma unroll
        for (int e = 0; e < 16; ++e) s += f[e] * f[e];
        s += __shfl_xor(s, 16); s += __shfl_xor(s, 32);
        const float rstd = rsqrtf(s * (1.0f / 64.0f) + 1e-6f) * (0.125f * 1.4426950408889634f);
#pragma unroll
        for (int e = 0; e < 8; ++e) { f[e] = f[e] * rstd * qgain[quad * 8 + e]; f[8 + e] = f[8 + e] * rstd * qgain[32 + quad * 8 + e]; }
        u32x4 w0, w1;
        w0.x = cvt_pk_bf16(f[0], f[1]); w0.y = cvt_pk_bf16(f[2], f[3]); w0.z = cvt_pk_bf16(f[4], f[5]); w0.w = cvt_pk_bf16(f[6], f[7]);
        w1.x = cvt_pk_bf16(f[8], f[9]); w1.y = cvt_pk_bf16(f[10], f[11]); w1.z = cvt_pk_bf16(f[12], f[13]); w1.w = cvt_pk_bf16(f[14], f[15]);
        qf[mi][0] = __builtin_bit_cast(bf16x8, w0); qf[mi][1] = __builtin_bit_cast(bf16x8, w1);
#pragma unroll
        for (int br = 0; br < 3; ++br) gates[br][mi] = bfu(ng[row * 256 + g * 12 + cx.h * 3 + br]);
    }
    __syncthreads();
    f32x4 of[2][4];
#pragma unroll
    for (int mi = 0; mi < 2; ++mi)
#pragma unroll
        for (int di = 0; di < 4; ++di) of[mi][di] = (f32x4){0.f, 0.f, 0.f, 0.f};
    const unsigned long long nomask[2] = {0ull, 0ull};
    float mrow[2], ilrow[2];
    cx.ksrc = (const bf16_t*)(ws + WS_KCMP) + (size_t)(b * 2 + g) * 256 * 64; cx.ldk = 64;
    cx.vsrc = (const bf16_t*)(ws + WS_VCMPT) + (size_t)(b * 2 + g) * 64 * 256; cx.ldv = 256; cx.kgain = nullptr;
    { const float gt[2] = {gates[0][0], gates[0][1]}; attn_branch<0>(cx, qf, qt, 0ull, nomask, of, gt, lds, mrow, ilrow); }
    attn_cmp_probs(cx, qf, mrow, ilrow, lds);
    {
        const LAS float* PS = (const LAS float*)(lds + AT_PS);
        LAS unsigned long long* MK = (LAS unsigned long long*)(lds + AT_MASK);
        for (int ti = 0; ti < 8; ++ti) {
            const int tl = wave * 8 + ti, tp = t0 + tl, jcur = tp >> 6, j = lane;
            float imp = 0.f;
#pragma unroll
            for (int e = -1; e < 4; ++e) { const int c = 4 * j + e; if (c >= 0 && c < 255) imp += PS[tl * 256 + c]; }
            const bool forced = (j == 0) || (j == jcur) || (j == jcur - 1);
            imp = (64 * j <= tp) ? (imp + (forced ? 1000.0f : 0.f)) : -1.0f;
            int cnt = 0;
#pragma unroll 4
            for (int i = 0; i < 64; ++i) {
                const float vi = __builtin_bit_cast(float, __builtin_amdgcn_readlane(__builtin_bit_cast(int, imp), i));
                cnt += (vi > imp || (vi == imp && i < j)) ? 1 : 0;
            }
            const unsigned long long mk = __ballot(cnt < 8);
            if (lane == 0) MK[tl] = mk;
        }
    }
    __syncthreads();
    unsigned long long selu = 0ull, selm[2];
    {
        const LAS unsigned long long* MK = (const LAS unsigned long long*)(lds + AT_MASK);
#pragma unroll 4
        for (int i = 0; i < 64; ++i) selu |= MK[i];
        selm[0] = MK[wave * 8 + (l16 >> 2)]; selm[1] = MK[wave * 8 + 4 + (l16 >> 2)];
    }
    float md[2], ild[2];
    cx.ksrc = (const bf16_t*)(ws + WS_KV) + (size_t)b * SEQ * 768 + 256 + g * 64; cx.ldk = 768;
    cx.vsrc = (const bf16_t*)(ws + WS_VST) + (size_t)(b * 2 + g) * 64 * 4096; cx.ldv = 4096; cx.kgain = p.qk_gain + (layer * 4 + 2) * 64;
    { const float gt[2] = {gates[1][0], gates[1][1]}; attn_branch<1>(cx, qf, qt, selu, selm, of, gt, lds, md, ild); }
    cx.ksrc = (const bf16_t*)(ws + WS_KV) + (size_t)b * SEQ * 768 + 512 + g * 64; cx.ldk = 768;
    cx.vsrc = (const bf16_t*)(ws + WS_VWT) + (size_t)(b * 2 + g) * 64 * 4096; cx.ldv = 4096; cx.kgain = p.qk_gain + (layer * 4 + 3) * 64;
    { const float gt[2] = {gates[2][0], gates[2][1]}; attn_branch<2>(cx, qf, qt, 0ull, nomask, of, gt, lds, md, ild); }
#pragma unroll
    for (int mi = 0; mi < 2; ++mi) {
        bf16_t* op = (bf16_t*)(ws + WS_XB + 64 * MiB) + ((size_t)b * SEQ + cx.tpos[mi]) * 512 + g * 256 + cx.h * 64 + quad * 4;
#pragma unroll
        for (int di = 0; di < 4; ++di) { u32x2 w; w.x = cvt_pk_bf16(of[mi][di][0], of[mi][di][1]); w.y = cvt_pk_bf16(of[mi][di][2], of[mi][di][3]); *(u32x2*)(op + di * 16) = w; }
    }
}

#ifndef ST_MASK
#define ST_MASK 0xff
#endif
#define ST_ON(k) ((ST_MASK >> (k)) & 1)
__global__ void __launch_bounds__(512, 2) fwd_kernel(Params pin) {
    extern __shared__ __attribute__((aligned(16))) unsigned char lds_raw[];
    LAS unsigned char* lds = (LAS unsigned char*)lds_raw;
    cg::grid_group grid = cg::this_grid();
    const int G = gridDim.x, bx = blockIdx.x;
    for (int ph = pin.ph_lo; ph < pin.ph_hi; ++ph) {
        Params p = pin;
        asm volatile("" : "+s"(p.x), "+s"(p.rel_bias), "+s"(p.lb_logits), "+s"(p.norm_mix), "+s"(p.w_in), "+s"(p.hg_gain), "+s"(p.qk_gain));
        asm volatile("" : "+s"(p.cmp_pos), "+s"(p.cmp_w1), "+s"(p.cmp_b1), "+s"(p.cmp_w2), "+s"(p.w_a), "+s"(p.w_b), "+s"(p.w_out));
        asm volatile("" : "+s"(p.norm_mlp), "+s"(p.w_up), "+s"(p.w_down), "+s"(p.out), "+s"(p.ws));
        unsigned char* ws = p.ws;

#ifndef NO_PRO
        if (ph == 0) { prologue(p, lds);
#ifdef DUP_MISC
            __syncthreads(); prologue(p, lds);
#endif
#ifdef DIAG_S00
            if (bx == 0 && threadIdx.x == 0) *(unsigned*)(ws + 512) = 0x7f000000u;
#endif
        }
#else
        if (ph == 0) {}
#endif

#ifdef DIAG_S00
        else if (ph == 15) { if (bx == 0 && threadIdx.x == 0) { const float v = __uint_as_float(__hip_atomic_load((unsigned*)(ws + 512), __ATOMIC_RELAXED, __HIP_MEMORY_SCOPE_AGENT)); p.out[0] += 1000.0f * v + 5.0f; } }
#endif
        else {
            const int layer = (ph - 1) / 7, st = (ph - 1) % 7;
            float* sumsq = (float*)(ws + WS_SUMSQ);
            bf16_t* xb = (bf16_t*)(ws + WS_XB);
            if (st == 0 && ST_ON(0)) {
                pg8::Gemm g{xb, (const bf16_t*)(ws + WS_WIN) + (size_t)layer * NP_IN * DM, T_TOK, NP_IN, DM}; pg8::StaticOrder S; S.init(T_TOK, NP_IN, G, bx);
                pg8::EpiIn E{sumsq, (bf16_t*)(ws + WS_HQ), (bf16_t*)(ws + WS_NQ), (bf16_t*)(ws + WS_KV), (bf16_t*)(ws + WS_NG), (bf16_t*)(ws + WS_SGA), (bf16_t*)(ws + WS_VST), (bf16_t*)(ws + WS_VWT)};
                pg8::gemm_phase<pg8::EpiIn, pg8::StaticOrder, true, true>(lds, g, S, E);
#ifdef DUP_G1
                __syncthreads(); pg8::gemm_phase<pg8::EpiIn, pg8::StaticOrder, true, true>(lds, g, S, E);
#endif
                if (layer == 0) {
                    __syncthreads();
                    const float* EH = (const float*)(ws + WS_EX + EX_H);
                    exact_stage(p.w_in, p.w_in, 99, DM, IN_COLS, (float*)(ws + WS_EX + EX_PP), [=](int r, int k) { return EH[r * 1024 + k]; }, lds);
                }
            } else if (st == 1 && ST_ON(1)) {
                {
                    const int x = bx & 7, i = bx >> 3;
                    const int unit = ((x * 8 + (i >> 2)) << 2) | (i & 3);

#ifndef NO_HGRN
                    if (bx < 256) hgrn_unit(p, layer, unit, lds);
#ifdef DUP_HGRN
                    if (bx < 256) hgrn_unit(p, layer, unit, lds);
#endif
#endif

                }

#ifndef NO_CMP
                for (int u = bx; u < 256; u += G) cmp_unit(p, layer, u, lds);
#ifdef DUP_MISC
                for (int u = bx; u < 256; u += G) cmp_unit(p, layer, u, lds);
#endif
#endif
                if (layer == 0 && bx < 16) exact_mixers(p, bx, lds);

            } else if (st == 2 && ST_ON(2)) {
                hgrn_finalize(p, layer);
#ifdef DUP_MISC
                hgrn_finalize(p, layer);
#endif
                {
                    const int x = bx & 7, i = bx >> 3;
#ifdef DUP_ATTN
                    for (int r2 = 0; r2 < 16; ++r2) { const int r = r2 & 7;
#else
                    for (int r = 0; r < 8; ++r) {
#endif
                        const int pair = x * 4 + (r >> 1);
                        const int qt = (r & 1) ? (63 - i) : i;

#ifndef NO_ATTN
                        attn_unit(p, layer, pair >> 1, pair & 1, qt, lds);
#endif

                    }
                }
                if (layer == 0) {
                    __syncthreads();
                    const float* OAB = (const float*)(ws + WS_EX + EX_OAB);
                    exact_stage(p.w_a, p.w_b, 2, 1024, DM, (float*)(ws + WS_EX + EX_YP), [=](int r, int k) { return OAB[r * 1024 + k]; }, lds);
                }
            } else if (st == 3 && ST_ON(3)) {
                {
                    pg8::Gemm g{(const bf16_t*)(ws + WS_HI), (const bf16_t*)(ws + WS_WA) + (size_t)layer * DM * 512, T_TOK, DM, 512}; pg8::StaticOrder S; S.init(T_TOK, DM, G, bx);
                    pg8::EpiMix<false> E{(const bf16_t*)(ws + WS_SGA), (bf16_t*)(ws + WS_MIXED)};
                    pg8::gemm_phase<pg8::EpiMix<false>, pg8::StaticOrder, true, true>(lds, g, S, E);
                }
                __syncthreads();
                {
                    pg8::Gemm g{(const bf16_t*)(ws + WS_XB + 64 * MiB), (const bf16_t*)(ws + WS_WB) + (size_t)layer * DM * 512, T_TOK, DM, 512}; pg8::StaticOrder S; S.init(T_TOK, DM, G, bx);
                    pg8::EpiMix<true> E{(const bf16_t*)(ws + WS_SGB), (bf16_t*)(ws + WS_MIXED)};
                    pg8::gemm_phase<pg8::EpiMix<true>, pg8::StaticOrder, true, true>(lds, g, S, E);
                }
                if (layer == 0) {
                    __syncthreads();
                    const float* PP = (const float*)(ws + WS_EX + EX_PP); const float* YP = (const float*)(ws + WS_EX + EX_YP);
                    exact_stage(p.w_out, p.w_out, 99, DM, DM, (float*)(ws + WS_EX + EX_XP), [=](int r, int k) {
                        const float ga = ex_pp(PP, r, 3352 + k), gb = ex_pp(PP, r, 4376 + k);
                        const float ya = YP[(size_t)r * 1024 + k] + YP[(size_t)(16 + r) * 1024 + k], yb = YP[(size_t)(32 + r) * 1024 + k] + YP[(size_t)(48 + r) * 1024 + k];
                        return ya / (1.0f + __expf(-ga)) + yb / (1.0f + __expf(-gb)); }, lds);
                }
            } else if ((st == 4 || st == 6) && ST_ON(4)) {
                const bool down = (st == 6);
                pg8::Gemm g{down ? (const bf16_t*)(ws + WS_HID) : (const bf16_t*)(ws + WS_MIXED),
                            down ? (const bf16_t*)(ws + WS_WDN) + (size_t)layer * DM * DFF : (const bf16_t*)(ws + WS_WO) + (size_t)layer * DM * DM, T_TOK, DM, down ? DFF : DM};
                pg8::StaticOrder S; S.init(T_TOK, DM, G, bx);
                pg8::EpiRes E{(layer == 0 && !down) ? p.x : (const float*)p.out, p.out, xb, sumsq};
                pg8::gemm_phase<pg8::EpiRes, pg8::StaticOrder, true, true>(lds, g, S, E);
                if (layer == 0 && !down) {
                    __syncthreads();
                    LAS float* RS = (LAS float*)(lds + 16384); LAS float* red = (LAS float*)(lds + 32768);
                    const int tid2 = threadIdx.x;
#pragma unroll 1
                    for (int r = 0; r < ((bx < 32) ? 16 : 0); ++r) {
                        const float a = ex_x1(p, r, tid2), b2 = ex_x1(p, r, 512 + tid2);
                        const float ss = block_sum(a * a + b2 * b2, red, tid2);
                        if (tid2 == 0) RS[r] = rsqrtf(ss * (1.0f / 1024.0f) + 1e-6f);
                    }
                    __syncthreads();
                    const Params pc = p; const float* nm2 = p.norm_mlp;
                    exact_stage(p.w_up, p.w_up, 99, DM, DFF, (float*)(ws + WS_EX + EX_UP), [=](int r, int k) { return ex_x1(pc, r, k) * RS[r] * nm2[k]; }, lds);
                }
            } else if (st == 5 && ST_ON(5)) {
                pg8::Gemm g{xb, (const bf16_t*)(ws + WS_WUP) + (size_t)layer * DFF * DM, T_TOK, DFF, DM}; pg8::StaticOrder S; S.init(T_TOK, DFF, G, bx);
                pg8::EpiUp E{sumsq, (bf16_t*)(ws + WS_HID)};
                pg8::gemm_phase<pg8::EpiUp, pg8::StaticOrder, true, true>(lds, g, S, E);
#ifdef DUP_G4
                __syncthreads(); pg8::gemm_phase<pg8::EpiUp, pg8::StaticOrder, true, true>(lds, g, S, E);
#endif
                if (layer == 0) {
                    __syncthreads();
                    const float* UP = (const float*)(ws + WS_EX + EX_UP);
                    exact_stage(p.w_down, p.w_down, 99, DFF, DM, (float*)(ws + WS_EX + EX_DP), [=](int r, int k) {
                        const float u = (UP[(size_t)r * DFF + k] + UP[(size_t)(16 + r) * DFF + k]) + (UP[(size_t)(32 + r) * DFF + k] + UP[(size_t)(48 + r) * DFF + k]);
                        const float t = fmaxf(u, 0.f); return t * t; }, lds);
                }
            }
        }
        if (ph + 1 < pin.ph_hi) {
            asm volatile("s_waitcnt vmcnt(0) lgkmcnt(0)" ::: "memory");
            grid.sync();
#ifdef DUP_SYNC
            grid.sync(); grid.sync();
#endif
            __builtin_amdgcn_fence(__ATOMIC_ACQUIRE, "agent");
            asm volatile("s_waitcnt vmcnt(0)" ::: "memory");
        }
    }
}

#ifdef DIAG_S00
constexpr int N_PHASES = 16;
#else
constexpr int N_PHASES = 15;
#endif
#ifndef ONE_LAUNCH
#define ONE_LAUNCH 1
#endif

extern "C" void kernel_launch(void* const* d_in, const int* in_sizes, int n_in, void* d_out, int out_size, void* d_ws, size_t ws_size, hipStream_t stream) {
    static int ready = 0;
    if (ready == 0) {
        if (n_in != 17 || out_size != T_TOK * DM || ws_size < WS_END) { fprintf(stderr, "kernel_launch: unexpected shapes: n_in %d out %d ws %zu (need %zu)\n", n_in, out_size, ws_size, (size_t)WS_END); ready = -1; return; }
        if (hipFuncSetAttribute((const void*)fwd_kernel, hipFuncAttributeMaxDynamicSharedMemorySize, LDS_BYTES) != hipSuccess) { fprintf(stderr, "kernel_launch: hipFuncSetAttribute failed\n"); ready = -1; return; }
        int per_cu = 0;
        if (hipOccupancyMaxActiveBlocksPerMultiprocessor(&per_cu, (const void*)fwd_kernel, 512, LDS_BYTES) != hipSuccess || per_cu < 1) fprintf(stderr, "kernel_launch: occupancy query says %d blocks per CU\n", per_cu);
        (void)hipGetLastError();
        ready = 1;
    }
    if (ready < 0) return;
    Params p{};
    p.x = (const float*)d_in[0]; p.rel_bias = (const float*)d_in[1]; p.lb_logits = (const float*)d_in[2]; p.norm_mix = (const float*)d_in[3]; p.w_in = (const float*)d_in[4];
    p.hg_gain = (const float*)d_in[5]; p.qk_gain = (const float*)d_in[6]; p.cmp_pos = (const float*)d_in[7]; p.cmp_w1 = (const float*)d_in[8]; p.cmp_b1 = (const float*)d_in[9];
    p.cmp_w2 = (const float*)d_in[10]; p.w_a = (const float*)d_in[11]; p.w_b = (const float*)d_in[12]; p.w_out = (const float*)d_in[13]; p.norm_mlp = (const float*)d_in[14];
    p.w_up = (const float*)d_in[15]; p.w_down = (const float*)d_in[16];
    p.out = (float*)d_out; p.ws = (unsigned char*)d_ws;
#if ONE_LAUNCH
    p.ph_lo = 0; p.ph_hi = N_PHASES;
    void* args[] = {&p};
    hipError_t e = hipLaunchCooperativeKernel((const void*)fwd_kernel, dim3(256), dim3(512), args, LDS_BYTES, stream);
    if (e != hipSuccess) fprintf(stderr, "kernel_launch: cooperative launch failed: %s\n", hipGetErrorString(e));
#else
    for (int ph = 0; ph < N_PHASES; ++ph) {
        p.ph_lo = ph; p.ph_hi = ph + 1;
        hipLaunchKernelGGL(fwd_kernel, dim3(256), dim3(512), LDS_BYTES, stream, p);
    }
#endif
}
```

```cpp
#include <hip/hip_runtime.h>
#include <hip/hip_cooperative_groups.h>
#include <cstdio>
#include <cstdint>
namespace cg = cooperative_groups;
namespace pg8 {
#define PG8_LAS __attribute__((address_space(3)))
typedef unsigned short bf16_t;
typedef short bf16x8 __attribute__((ext_vector_type(8)));
typedef float f32x4 __attribute__((ext_vector_type(4)));
typedef unsigned u32x4 __attribute__((ext_vector_type(4)));
constexpr int BM = 256, BK = 64, HALF = 128, HTB = HALF * BK * 2  , STAGE_BYTES = 8 * HTB, NXCD = 8, WGM = 8;

__host__ __device__ __forceinline__ int lds_byte(int r, int c) { const int st = (r >> 4) * 2 + (c >> 5), rr = r & 15, cc = c & 31, ob = rr * 64 + cc * 2; return st * 1024 + (ob ^ (((ob >> 9) & 1) << 5)); }
__host__ __device__ __forceinline__ void stage_rc(int b, int& R, int& C) { const int st = b / 1024, sb = b % 1024, swz = sb ^ (((sb >> 9) & 1) << 5); R = (st >> 1) * 16 + swz / 64; C = (st & 1) * 32 + (swz % 64) / 2; }
__host__ __device__ __forceinline__ int perm32(int rho) { const int n = rho >> 4, i = rho & 15; return 8 * (i >> 2) + 4 * n + (i & 3); }

struct Unit { int pm, pn; };
struct Gemm { const bf16_t* A; const bf16_t* Bt; int M, N, K; };

struct StaticOrder {
    int nM, nN, nwg, G, c;
    __host__ __device__ void init(int M, int N, int G_, int c_) { nM = M / BM; nN = N / BM; nwg = nM * nN; G = G_; c = c_; }
    __host__ __device__ bool next(int i, Unit& u) const {
        const long L = (long)i * G + c; if (L >= nwg) return false;
        int wgid = (int)L; { const int q = nwg / NXCD, r = nwg % NXCD, xcd = wgid % NXCD, off = wgid / NXCD; wgid = (xcd < r ? xcd * (q + 1) : r * (q + 1) + (xcd - r) * q) + off; }
        const int nig = WGM * nN, gid = wgid / nig, fm = gid * WGM, gsz = (nM - fm) < WGM ? (nM - fm) : WGM;
        u.pm = fm + ((wgid % nig) % gsz); u.pn = (wgid % nig) / gsz; return true;
    }
    __device__ __forceinline__ void a_ready(const Unit&) const {}
    __device__ __forceinline__ void done(const Unit&) const {}
};

typedef float f32x2c __attribute__((ext_vector_type(2)));
typedef __bf16 bf16x2c __attribute__((ext_vector_type(2)));
__device__ __forceinline__ unsigned cvt_pk_bf16(float lo, float hi) { const f32x2c v = {lo, hi}; const bf16x2c b = __builtin_convertvector(v, bf16x2c); return __builtin_bit_cast(unsigned, b); }
__device__ __forceinline__ float bf_lo(unsigned w) { return __uint_as_float(w << 16); }
__device__ __forceinline__ float bf_hi(unsigned w) { return __uint_as_float(w & 0xffff0000u); }
__device__ __forceinline__ float sigm(float v) { return __builtin_amdgcn_rcpf(1.0f + __expf(-v)); }

__device__ __forceinline__ void row_rstd8(const float* sumsq, const Unit& u, int wr, int fr, int fq, float (&rs)[2][4]) {
#pragma unroll
    for (int ai = 0; ai < 2; ++ai)
#pragma unroll
        for (int m = 0; m < 4; ++m) {
            const int row = u.pm * BM + ai * HALF + wr * 64 + m * 16 + fr;
            const f32x4 v = *(const f32x4*)(sumsq + (size_t)row * 16 + fq * 4);
            float s = (v[0] + v[1]) + (v[2] + v[3]);
            s += __shfl_xor(s, 16); s += __shfl_xor(s, 32);
            rs[ai][m] = rsqrtf(s * (1.0f / 1024.0f) + 1e-6f);
            if (m == 3) asm volatile("" ::: "memory");
        }
}

struct EpiIn {
    static constexpr bool PERM = true, AFTER_DRAIN = false;
    const float* sumsq; bf16_t *HQ, *NQ, *KV, *NG, *SGA, *VST, *VWT;
    __device__ __forceinline__ void operator()(const f32x4 (&acc)[2][2][4][2], const Unit& u, int wr, int wc, int fr, int fq) const {
        float rs[2][4]; row_rstd8(sumsq, u, wr, fr, fq, rs);
        const int pn = u.pn; bf16_t* base; int ldc, colt; bool sg = false;
        if (pn < 8) { base = HQ + (size_t)(pn >> 1) * ((size_t)65536 * 512); ldc = 512; colt = (pn & 1) * 256; }
        else if (pn < 10) { base = NQ; ldc = 512; colt = (pn - 8) * 256; }
        else if (pn < 13) { base = KV; ldc = 768; colt = (pn - 10) * 256; }
        else if (pn == 13) { base = NG; ldc = 256; colt = 0; sg = true; }
        else { const int q = pn - 14; base = SGA + (size_t)(q >> 2) * ((size_t)65536 * 1024); ldc = 1024; colt = (q & 3) * 256; sg = true; }
        const int col0 = colt + wc * 32 + 8 * fq;
        bf16_t* vt = (pn == 11) ? VST : ((pn == 12) ? VWT : nullptr);
#pragma unroll
        for (int ai = 0; ai < 2; ++ai)
#pragma unroll
            for (int m = 0; m < 4; ++m) {
                const int row = u.pm * BM + ai * HALF + wr * 64 + m * 16 + fr;
                bf16_t* rowp = base + (size_t)row * ldc + col0; const float r = rs[ai][m];
#pragma unroll
                for (int bj = 0; bj < 2; ++bj) {
                    f32x4 v0 = acc[ai][bj][m][0] * r, v1 = acc[ai][bj][m][1] * r;
                    if (sg) {
#pragma unroll
                        for (int e = 0; e < 4; ++e) { v0[e] = sigm(v0[e]); v1[e] = sigm(v1[e]); }
                    }
                    u32x4 w; w.x = cvt_pk_bf16(v0[0], v0[1]); w.y = cvt_pk_bf16(v0[2], v0[3]); w.z = cvt_pk_bf16(v1[0], v1[1]); w.w = cvt_pk_bf16(v1[2], v1[3]);
                    *(u32x4*)(rowp + bj * HALF) = w;
                    if (vt != nullptr && bj == 1) {
                        const int cv = wc * 32 + 8 * fq, g = cv >> 6, d0 = cv & 63, b = row >> 12, t = row & 4095;
                        bf16_t* tp = vt + (((size_t)(b * 2 + g) * 64 + d0) << 12) + t;
                        tp[0 * 4096] = (bf16_t)(w.x & 0xffffu); tp[1 * 4096] = (bf16_t)(w.x >> 16); tp[2 * 4096] = (bf16_t)(w.y & 0xffffu); tp[3 * 4096] = (bf16_t)(w.y >> 16);
                        tp[4 * 4096] = (bf16_t)(w.z & 0xffffu); tp[5 * 4096] = (bf16_t)(w.z >> 16); tp[6 * 4096] = (bf16_t)(w.w & 0xffffu); tp[7 * 4096] = (bf16_t)(w.w >> 16);
                    }
                }
                asm volatile("" ::: "memory");
            }
    }
};

template <bool ACCUM> struct EpiMix {
    static constexpr bool PERM = true, AFTER_DRAIN = false;
    const bf16_t* gate; bf16_t* mixed;
    __device__ __forceinline__ void operator()(const f32x4 (&acc)[2][2][4][2], const Unit& u, int wr, int wc, int fr, int fq) const {
        const int col0 = u.pn * BM + wc * 32 + 8 * fq;
#pragma unroll
        for (int ai = 0; ai < 2; ++ai)
#pragma unroll
            for (int m = 0; m < 4; ++m) {
                const size_t off = (size_t)(u.pm * BM + ai * HALF + wr * 64 + m * 16 + fr) * 1024 + col0;
#pragma unroll
                for (int bj = 0; bj < 2; ++bj) {
                    const u32x4 gq = *(const u32x4*)(gate + off + bj * HALF);
                    f32x4 v0 = acc[ai][bj][m][0], v1 = acc[ai][bj][m][1];
                    v0[0] *= bf_lo(gq.x); v0[1] *= bf_hi(gq.x); v0[2] *= bf_lo(gq.y); v0[3] *= bf_hi(gq.y);
                    v1[0] *= bf_lo(gq.z); v1[1] *= bf_hi(gq.z); v1[2] *= bf_lo(gq.w); v1[3] *= bf_hi(gq.w);
                    if (ACCUM) {
                        const u32x4 mq = *(const u32x4*)(mixed + off + bj * HALF);
                        v0[0] += bf_lo(mq.x); v0[1] += bf_hi(mq.x); v0[2] += bf_lo(mq.y); v0[3] += bf_hi(mq.y);
                        v1[0] += bf_lo(mq.z); v1[1] += bf_hi(mq.z); v1[2] += bf_lo(mq.w); v1[3] += bf_hi(mq.w);
                    }
                    u32x4 w; w.x = cvt_pk_bf16(v0[0], v0[1]); w.y = cvt_pk_bf16(v0[2], v0[3]); w.z = cvt_pk_bf16(v1[0], v1[1]); w.w = cvt_pk_bf16(v1[2], v1[3]);
                    *(u32x4*)(mixed + off + bj * HALF) = w;
                }
                asm volatile("" ::: "memory");
            }
    }
};

struct EpiRes {
    static constexpr bool PERM = true, AFTER_DRAIN = false;
    float* out; bf16_t* xb; float* sumsq; bool FINAL;
    __device__ __forceinline__ void operator()(const f32x4 (&acc)[2][2][4][2], const Unit& u, int wr, int wc, int fr, int fq) const {
        const int col0 = u.pn * BM + wc * 32 + 8 * fq;
#pragma unroll
        for (int ai = 0; ai < 2; ++ai)
#pragma unroll
            for (int m = 0; m < 4; ++m) {
                const int row = u.pm * BM + ai * HALF + wr * 64 + m * 16 + fr;
                const size_t off = (size_t)row * 1024 + col0; float ss = 0.f;
#pragma unroll
                for (int bj = 0; bj < 2; ++bj) {
                    const u32x4 xq = *(const u32x4*)(xb + off + bj * HALF);
                    f32x4 v0 = acc[ai][bj][m][0], v1 = acc[ai][bj][m][1];
                    v0[0] += bf_lo(xq.x); v0[1] += bf_hi(xq.x); v0[2] += bf_lo(xq.y); v0[3] += bf_hi(xq.y);
                    v1[0] += bf_lo(xq.z); v1[1] += bf_hi(xq.z); v1[2] += bf_lo(xq.w); v1[3] += bf_hi(xq.w);
                    if (FINAL) { *(f32x4*)(out + off + bj * HALF) = v0; *(f32x4*)(out + off + bj * HALF + 4) = v1; }
                    else {
                        u32x4 w; w.x = cvt_pk_bf16(v0[0], v0[1]); w.y = cvt_pk_bf16(v0[2], v0[3]); w.z = cvt_pk_bf16(v1[0], v1[1]); w.w = cvt_pk_bf16(v1[2], v1[3]);
                        *(u32x4*)(xb + off + bj * HALF) = w;
                        ss += (v0[0] * v0[0] + v0[1] * v0[1]) + (v0[2] * v0[2] + v0[3] * v0[3]) + (v1[0] * v1[0] + v1[1] * v1[1]) + (v1[2] * v1[2] + v1[3] * v1[3]);
                    }
                }
                if (!FINAL) { ss += __shfl_xor(ss, 16); ss += __shfl_xor(ss, 32); if (fq == 0) sumsq[(size_t)row * 16 + u.pn * 4 + wc] = ss; }
                asm volatile("" ::: "memory");
            }
    }
};

struct EpiUp {
    static constexpr bool PERM = true, AFTER_DRAIN = false;
    const float* sumsq; bf16_t* hid;
    __device__ __forceinline__ void operator()(const f32x4 (&acc)[2][2][4][2], const Unit& u, int wr, int wc, int fr, int fq) const {
        float rs[2][4]; row_rstd8(sumsq, u, wr, fr, fq, rs);
        const int col0 = u.pn * BM + wc * 32 + 8 * fq;
#pragma unroll
        for (int ai = 0; ai < 2; ++ai)
#pragma unroll
            for (int m = 0; m < 4; ++m) {
                bf16_t* rowp = hid + (size_t)(u.pm * BM + ai * HALF + wr * 64 + m * 16 + fr) * 4096 + col0; const float r = rs[ai][m];
#pragma unroll
                for (int bj = 0; bj < 2; ++bj) {
                    f32x4 v0 = acc[ai][bj][m][0] * r, v1 = acc[ai][bj][m][1] * r;
#pragma unroll
                    for (int e = 0; e < 4; ++e) { const float a = fmaxf(v0[e], 0.f), b = fmaxf(v1[e], 0.f); v0[e] = a * a; v1[e] = b * b; }
                    u32x4 w; w.x = cvt_pk_bf16(v0[0], v0[1]); w.y = cvt_pk_bf16(v0[2], v0[3]); w.z = cvt_pk_bf16(v1[0], v1[1]); w.w = cvt_pk_bf16(v1[2], v1[3]);
                    *(u32x4*)(rowp + bj * HALF) = w;
                }
                asm volatile("" ::: "memory");
            }
    }
};

template <class Epi, class Sched, bool ALIGN_EPI = false, bool SP2 = false>
__device__ __forceinline__ void gemm_phase(PG8_LAS unsigned char* lds, const Gemm g, const Sched& S, const Epi& E) {
    int tid_ = threadIdx.x; asm volatile("" : "+v"(tid_));
    const int tid = tid_, wid = __builtin_amdgcn_readfirstlane(tid >> 6), lane = tid & 63, wr = wid >> 2, wc = wid & 3, fr = lane & 15, fq = lane >> 4;
    const int K = g.K, nt = K / BK;
    unsigned voffA[2], voffB[2];
#pragma unroll
    for (int i = 0; i < 2; ++i) { int R, C; stage_rc(tid * 16 + i * 8192, R, C); const int Rb = Epi::PERM ? ((R & ~31) + perm32(R & 31)) : R;
        voffA[i] = (unsigned)(R * K + C) * 2u; voffB[i] = (unsigned)(Rb * K + C) * 2u; }
    const size_t kstep = (size_t)(BK * 2);
    const size_t hstep = (size_t)HALF * K * 2;
    const size_t tstep = 2 * hstep;
    const unsigned ldsw = (unsigned)wid * 1024u;
    const int aoff = lds_byte(wr * 64 + fr, fq * 8), boff = lds_byte(wc * 32 + fr, fq * 8);
#define PG8_SA(b, h) (((b) * 2 + (h)) * HTB)
#define PG8_SB(b, h) ((4 + (b) * 2 + (h)) * HTB)
#define PG8_STAGE(bufoff, gbase, voff) do { _Pragma("unroll") for (int _i = 0; _i < 2; ++_i) \
        __builtin_amdgcn_global_load_lds((const unsigned*)((const char*)(gbase) + (voff)[_i]), (PG8_LAS unsigned*)(lds + (bufoff) + ldsw + _i * 8192), 16, 0, 0); } while (0)
#define PG8_LDA(dst, b, h) do { _Pragma("unroll") for (int m = 0; m < 4; ++m) _Pragma("unroll") for (int k = 0; k < 2; ++k) dst[m][k] = *(const PG8_LAS bf16x8*)(lds + PG8_SA(b, h) + aoff + m * 2048 + k * 1024); } while (0)
#define PG8_LDB(dst, b, h) do { _Pragma("unroll") for (int n = 0; n < 2; ++n) _Pragma("unroll") for (int k = 0; k < 2; ++k) dst[n][k] = *(const PG8_LAS bf16x8*)(lds + PG8_SB(b, h) + boff + n * 2048 + k * 1024); } while (0)
#define PG8_MMA(ai, bj, At, Bt) do { __builtin_amdgcn_s_setprio(1); _Pragma("unroll") for (int m = 0; m < 4; ++m) _Pragma("unroll") for (int n = 0; n < 2; ++n) _Pragma("unroll") for (int k = 0; k < 2; ++k) \
        acc[ai][bj][m][n] = __builtin_amdgcn_mfma_f32_16x16x32_bf16(Bt[n][k], At[m][k], acc[ai][bj][m][n], 0, 0, 0); __builtin_amdgcn_s_setprio(0); } while (0)
#define PG8_WAIT_V(n) asm volatile("s_waitcnt vmcnt(" #n ")" ::: "memory")
#define PG8_WAIT_L(n) asm volatile("s_waitcnt lgkmcnt(" #n ")" ::: "memory")
#define PG8_BAR __builtin_amdgcn_s_barrier()
#define PG8_SCHED __builtin_amdgcn_sched_barrier(0)
    Unit cur, nxt; int ui = 0;
    if (!S.next(0, cur)) return;
    f32x4 acc[2][2][4][2];
#pragma unroll
    for (int a = 0; a < 2; ++a)
#pragma unroll
        for (int b = 0; b < 2; ++b)
#pragma unroll
            for (int m = 0; m < 4; ++m)
#pragma unroll
                for (int n = 0; n < 2; ++n) acc[a][b][m][n] = (f32x4){0.f, 0.f, 0.f, 0.f};
    bf16x8 At[4][2], B0[2][2], B1[2][2];
    const char* cA = (const char*)g.A + (size_t)cur.pm * tstep; const char* cB = (const char*)g.Bt + (size_t)cur.pn * tstep;
    S.a_ready(cur);
    if constexpr (SP2) {
        PG8_STAGE(PG8_SB(0, 0), cB, voffB); PG8_STAGE(PG8_SB(0, 1), cB + hstep, voffB); PG8_STAGE(PG8_SA(0, 0), cA, voffA); PG8_STAGE(PG8_SA(0, 1), cA + hstep, voffA);
        if (wr == 1) PG8_BAR;
        PG8_WAIT_V(2); PG8_BAR;
        PG8_STAGE(PG8_SB(1, 0), cB + kstep, voffB); PG8_STAGE(PG8_SA(1, 0), cA + kstep, voffA); PG8_STAGE(PG8_SB(1, 1), cB + hstep + kstep, voffB);
        PG8_WAIT_V(6); PG8_BAR;
    } else {
        PG8_STAGE(PG8_SB(0, 0), cB, voffB); PG8_STAGE(PG8_SA(0, 0), cA, voffA); PG8_STAGE(PG8_SB(0, 1), cB + hstep, voffB); PG8_STAGE(PG8_SA(0, 1), cA + hstep, voffA);
        if (wr == 1) PG8_BAR;
        PG8_WAIT_V(4); PG8_BAR;
        PG8_STAGE(PG8_SB(1, 0), cB + kstep, voffB); PG8_STAGE(PG8_SA(1, 0), cA + kstep, voffA); PG8_STAGE(PG8_SB(1, 1), cB + hstep + kstep, voffB);
        PG8_WAIT_V(6); PG8_BAR;
    }
    for (;;) {
        const bool has_next = S.next(ui + 1, nxt);
        const char* nA = has_next ? (const char*)g.A + (size_t)nxt.pm * tstep : cA; const char* nB = has_next ? (const char*)g.Bt + (size_t)nxt.pn * tstep : cB;
        for (int t = 0; t < nt; t += 2) {
            const bool last = (t == nt - 2);
            const char* a1 = cA + (size_t)(t + 1) * kstep;
            const char* a2 = last ? nA : cA + (size_t)(t + 2) * kstep; const char* b2 = last ? nB : cB + (size_t)(t + 2) * kstep;
            const char* a3 = a2 + kstep; const char* b3 = b2 + kstep;
            if (last && has_next) S.a_ready(nxt);
            if constexpr (SP2) {
            PG8_LDB(B0, 0, 0); PG8_LDB(B1, 0, 1); PG8_SCHED; PG8_LDA(At, 0, 0); PG8_STAGE(PG8_SA(1, 1), a1 + hstep, voffA);
            PG8_WAIT_V(8); PG8_WAIT_L(0); PG8_BAR; PG8_MMA(0, 0, At, B0); PG8_MMA(0, 1, At, B1); PG8_BAR; PG8_SCHED;
            PG8_LDA(At, 0, 1); PG8_STAGE(PG8_SB(0, 0), b2, voffB); PG8_STAGE(PG8_SB(0, 1), b2 + hstep, voffB); PG8_STAGE(PG8_SA(0, 0), a2, voffA);
            PG8_WAIT_V(8); PG8_WAIT_L(0); PG8_BAR; PG8_MMA(1, 0, At, B0); PG8_MMA(1, 1, At, B1); PG8_BAR; PG8_SCHED;
            PG8_LDB(B0, 1, 0); PG8_LDB(B1, 1, 1); PG8_SCHED; PG8_LDA(At, 1, 0); PG8_STAGE(PG8_SA(0, 1), a2 + hstep, voffA);
            PG8_WAIT_V(8); PG8_WAIT_L(0); PG8_BAR; PG8_MMA(0, 0, At, B0); PG8_MMA(0, 1, At, B1); PG8_BAR; PG8_SCHED;
            PG8_LDA(At, 1, 1); PG8_STAGE(PG8_SB(1, 0), b3, voffB); PG8_STAGE(PG8_SB(1, 1), b3 + hstep, voffB); PG8_STAGE(PG8_SA(1, 0), a3, voffA);
            PG8_WAIT_V(8); PG8_WAIT_L(0); PG8_BAR; PG8_MMA(1, 0, At, B0); PG8_MMA(1, 1, At, B1); PG8_BAR; PG8_SCHED;
            } else {
            PG8_LDB(B0, 0, 0); PG8_SCHED; PG8_LDA(At, 0, 0); PG8_STAGE(PG8_SA(1, 1), a1 + hstep, voffA);
            PG8_WAIT_L(8); PG8_BAR; PG8_WAIT_L(0); PG8_MMA(0, 0, At, B0); PG8_BAR; PG8_SCHED;
            PG8_LDB(B1, 0, 1); PG8_STAGE(PG8_SB(0, 0), b2, voffB);
            PG8_BAR; PG8_WAIT_L(0); PG8_MMA(0, 1, At, B1); PG8_BAR;
            PG8_LDA(At, 0, 1); PG8_STAGE(PG8_SA(0, 0), a2, voffA);
            PG8_BAR; PG8_WAIT_L(0); PG8_MMA(1, 0, At, B0); PG8_BAR; PG8_SCHED;
            PG8_STAGE(PG8_SB(0, 1), b2 + hstep, voffB);
            PG8_WAIT_V(6); PG8_BAR; PG8_MMA(1, 1, At, B1); PG8_BAR;
            PG8_LDB(B0, 1, 0); PG8_SCHED; PG8_LDA(At, 1, 0); PG8_STAGE(PG8_SA(0, 1), a2 + hstep, voffA);
            PG8_WAIT_L(8); PG8_BAR; PG8_WAIT_L(0); PG8_MMA(0, 0, At, B0); PG8_BAR; PG8_SCHED;
            PG8_LDB(B1, 1, 1); PG8_STAGE(PG8_SB(1, 0), b3, voffB);
            PG8_BAR; PG8_WAIT_L(0); PG8_MMA(0, 1, At, B1); PG8_BAR;
            PG8_LDA(At, 1, 1); PG8_STAGE(PG8_SA(1, 0), a3, voffA);
            PG8_BAR; PG8_WAIT_L(0); PG8_MMA(1, 0, At, B0); PG8_BAR; PG8_SCHED;
            PG8_STAGE(PG8_SB(1, 1), b3 + hstep, voffB);
            PG8_WAIT_V(6); PG8_BAR; PG8_MMA(1, 1, At, B1); PG8_BAR;
            }
        }
        if constexpr (ALIGN_EPI) { if (wr == 0) PG8_BAR; }
        if constexpr (!Epi::AFTER_DRAIN) { E(acc, cur, wr, wc, fr, fq); S.done(cur); }
        if (!has_next) break;
#pragma unroll
        for (int a = 0; a < 2; ++a)
#pragma unroll
            for (int b = 0; b < 2; ++b)
#pragma unroll
                for (int m = 0; m < 4; ++m)
#pragma unroll
                    for (int n = 0; n < 2; ++n) acc[a][b][m][n] = (f32x4){0.f, 0.f, 0.f, 0.f};
        cur = nxt; cA = nA; cB = nB; ++ui;
        if constexpr (ALIGN_EPI) { if (wr == 1) PG8_BAR; }
    }
    PG8_WAIT_V(0);
    if constexpr (!ALIGN_EPI) { if (wr == 0) PG8_BAR; }
    PG8_BAR;
    if constexpr (Epi::AFTER_DRAIN) { E.fused(acc, cur, wr, wc, fr, fq, lds, wid, lane); S.done(cur); }
#undef PG8_SA
#undef PG8_SB
#undef PG8_STAGE
#undef PG8_LDA
#undef PG8_LDB
#undef PG8_MMA
#undef PG8_WAIT_V
#undef PG8_WAIT_L
#undef PG8_BAR
#undef PG8_SCHED
}
}

#define LAS __attribute__((address_space(3)))
typedef unsigned short bf16_t;
typedef short bf16x8 __attribute__((ext_vector_type(8)));
typedef short bf16x4 __attribute__((ext_vector_type(4)));
typedef float f32x4 __attribute__((ext_vector_type(4)));
typedef unsigned u32x4 __attribute__((ext_vector_type(4)));
typedef unsigned u32x2 __attribute__((ext_vector_type(2)));
using pg8::cvt_pk_bf16; using pg8::bf_lo; using pg8::bf_hi; using pg8::sigm;

constexpr int T_TOK = 65536, DM = 1024, SEQ = 4096, NB = 16, DFF = 4096, NP_IN = 5632, IN_COLS = 5400;
constexpr int LDS_BYTES = 147456;
constexpr size_t MiB = (size_t)1 << 20;
constexpr size_t WS_CBIAS = 1 * MiB, WS_CW2T = 1 * MiB + 65536;
constexpr size_t WS_WIN = 2 * MiB, WS_WA = 24 * MiB, WS_WB = 26 * MiB, WS_WO = 28 * MiB, WS_WUP = 32 * MiB, WS_WDN = 48 * MiB, WS_CW1T = 64 * MiB;
constexpr size_t WS_SUMSQ = 66 * MiB, WS_KCMP = 70 * MiB, WS_VCMPT = 71 * MiB, WS_VST = 72 * MiB, WS_VWT = 88 * MiB, WS_XB = 104 * MiB;
constexpr size_t WS_HQ = 232 * MiB, WS_HF = 296 * MiB, WS_HI = 360 * MiB, WS_HG = 424 * MiB, WS_NQ = 488 * MiB, WS_KV = 552 * MiB, WS_NG = 648 * MiB, WS_SGA = 680 * MiB, WS_SGB = 808 * MiB;
constexpr size_t WS_MIXED = 232 * MiB, WS_HID = 232 * MiB, WS_EX = 936 * MiB, WS_TMP = 944 * MiB, WS_END = 1008 * MiB;
constexpr size_t EX_H = 0, EX_PP = 1 * MiB, EX_OAB = 2 * MiB + 524288, EX_YP = EX_OAB + 65536, EX_XP = EX_OAB + 524288, EX_UP = 3 * MiB + 524288, EX_DP = 4 * MiB + 524288;

struct Params {
    const float *x, *rel_bias, *lb_logits, *norm_mix, *w_in, *hg_gain, *qk_gain, *cmp_pos, *cmp_w1, *cmp_b1, *cmp_w2, *w_a, *w_b, *w_out, *norm_mlp, *w_up, *w_down;
    float* out; unsigned char* ws; int ph_lo, ph_hi;
};

__device__ __forceinline__ bf16x8 lds_ld8(const LAS unsigned char* p) { return *(const LAS bf16x8*)p; }
__device__ __forceinline__ bf16x8 lds_ld4x2(const LAS unsigned char* p0, const LAS unsigned char* p1) {
    const bf16x4 a = *(const LAS bf16x4*)p0, b = *(const LAS bf16x4*)p1; bf16x8 r;
    r[0] = a[0]; r[1] = a[1]; r[2] = a[2]; r[3] = a[3]; r[4] = b[0]; r[5] = b[1]; r[6] = b[2]; r[7] = b[3]; return r;
}
__device__ __forceinline__ bf16x8 pack8(const f32x4& a, const f32x4& b) {
    u32x4 w; w.x = cvt_pk_bf16(a[0], a[1]); w.y = cvt_pk_bf16(a[2], a[3]); w.z = cvt_pk_bf16(b[0], b[1]); w.w = cvt_pk_bf16(b[2], b[3]);
    return __builtin_bit_cast(bf16x8, w);
}
__device__ __forceinline__ unsigned short bf1(float v) { return (unsigned short)(cvt_pk_bf16(v, 0.f) & 0xffffu); }
__device__ __forceinline__ float bfu(unsigned short h) { return __uint_as_float(((unsigned)h) << 16); }
__device__ __forceinline__ int tid_opaque() { int t = threadIdx.x; asm volatile("" : "+v"(t)); return t; }
__device__ __forceinline__ int clampi(int v, int lo, int hi) { return v < lo ? lo : (v > hi ? hi : v); }
typedef float f32x2c_t __attribute__((ext_vector_type(2)));
__device__ __forceinline__ int bid_opaque() { int t = blockIdx.x; asm volatile("" : "+s"(t)); return t; }
#define MFMA16(a, b, c) __builtin_amdgcn_mfma_f32_16x16x32_bf16((a), (b), (c), 0, 0, 0)

__device__ __forceinline__ float block_sum(float v, LAS float* red, int tid);
__device__ __forceinline__ void conv_matrix(const float* W, int K, int N, bf16_t* WT, const float* scale, int nshift_from, int nshift, LAS unsigned char* lds) {
    LAS float* tile = (LAS float*)lds;
    const int tid = tid_opaque(), nnb = (N + 63) / 64, items = (K / 64) * nnb;
#pragma unroll 1
    for (int it = blockIdx.x; it < items; it += gridDim.x) {
        const int kb = it / nnb, nb = it % nnb, k0 = kb * 64, n0 = nb * 64;
#pragma unroll
        for (int i = 0; i < 8; ++i) {
            const int k = i * 8 + (tid >> 6), n = tid & 63;
            float v = 0.f;
            if (n0 + n < N) { v = W[(size_t)(k0 + k) * N + n0 + n]; if (scale) v *= scale[k0 + k]; }
            tile[k * 65 + n] = v;
        }
        __syncthreads();
        {
            const int n = tid >> 3, kc = tid & 7;
            if (n0 + n < N) {
                const LAS float* s = tile + (kc * 8) * 65 + n;
                u32x4 o; o.x = cvt_pk_bf16(s[0], s[65]); o.y = cvt_pk_bf16(s[2 * 65], s[3 * 65]); o.z = cvt_pk_bf16(s[4 * 65], s[5 * 65]); o.w = cvt_pk_bf16(s[6 * 65], s[7 * 65]);
                int nn = n0 + n; if (nn >= nshift_from) nn += nshift;
                *(u32x4*)(WT + (size_t)nn * K + k0 + kc * 8) = o;
            }
        }
        __syncthreads();
    }
}

__device__ __forceinline__ void prologue(const Params& p, LAS unsigned char* lds) {
    unsigned char* ws = p.ws;
    const int tid = tid_opaque(), lane = tid & 63, wave = tid >> 6; const int bidx = bid_opaque();
#pragma unroll 1
    for (int mj = 0; mj < 20; ++mj) {
        const int l = mj / 10, m = mj % 10;
        const float* W; int K, N; bf16_t* WT; const float* scale = nullptr; int sfrom = 1 << 30, sh = 0;
        if (m == 0) { W = p.w_in + (size_t)l * DM * IN_COLS; K = DM; N = IN_COLS; WT = (bf16_t*)(ws + WS_WIN) + (size_t)l * NP_IN * DM; scale = p.norm_mix + l * DM; sfrom = 3352; sh = 232; }
        else if (m == 1) { W = p.w_a + (size_t)l * 512 * DM; K = 512; N = DM; WT = (bf16_t*)(ws + WS_WA) + (size_t)l * DM * 512; }
        else if (m == 2) { W = p.w_b + (size_t)l * 512 * DM; K = 512; N = DM; WT = (bf16_t*)(ws + WS_WB) + (size_t)l * DM * 512; }
        else if (m == 3) { W = p.w_out + (size_t)l * DM * DM; K = DM; N = DM; WT = (bf16_t*)(ws + WS_WO) + (size_t)l * DM * DM; }
        else if (m == 4) { W = p.w_up + (size_t)l * DM * DFF; K = DM; N = DFF; WT = (bf16_t*)(ws + WS_WUP) + (size_t)l * DFF * DM; scale = p.norm_mlp + l * DM; }
        else if (m == 5) { W = p.w_down + (size_t)l * DFF * DM; K = DFF; N = DM; WT = (bf16_t*)(ws + WS_WDN) + (size_t)l * DM * DFF; }
        else if (m < 8) { const int j = m - 6; W = p.cmp_w1 + (size_t)(l * 2 + j) * 2048 * 128; K = 2048; N = 128; WT = (bf16_t*)(ws + WS_CW1T) + (size_t)(l * 2 + j) * 128 * 2048; }
        else { const int j = m - 8; W = p.cmp_w2 + (size_t)(l * 2 + j) * 128 * 64; K = 128; N = 64; WT = (bf16_t*)(ws + WS_CW2T) + (size_t)(l * 2 + j) * 64 * 128; }
        conv_matrix(W, K, N, WT, scale, sfrom, sh, lds);
    }
    for (int l = 0; l < 2; ++l) {
        u32x4* z = (u32x4*)((bf16_t*)(ws + WS_WIN) + (size_t)l * NP_IN * DM + (size_t)3352 * DM);
        for (int i = bidx * 512 + tid; i < 232 * DM / 8; i += gridDim.x * 512) z[i] = (u32x4){0u, 0u, 0u, 0u};
    }
    if (bidx < 4) {
        const int lj = bidx, n = tid & 127, kq = tid >> 7;
        const float* W1 = p.cmp_w1 + (size_t)lj * 2048 * 128; const float* pos = p.cmp_pos + (size_t)lj * 2048;
        float s = 0.f;
#pragma unroll 4
        for (int k = kq * 512; k < kq * 512 + 512; ++k) s += pos[k] * W1[(size_t)k * 128 + n];
        LAS float* red = (LAS float*)(lds + 32768);
        red[kq * 128 + n] = s;
        __syncthreads();
        if (tid < 128) ((float*)(ws + WS_CBIAS))[lj * 128 + tid] = p.cmp_b1[lj * 128 + tid] + (red[tid] + red[128 + tid]) + (red[256 + tid] + red[384 + tid]);
        __syncthreads();
    }
    if (bidx >= 16 && bidx < 32) {
        const int r = bidx - 16; float* EH = (float*)(ws + WS_EX + EX_H);
        const float xa = p.x[(size_t)r * SEQ * DM + tid], xb2 = p.x[(size_t)r * SEQ * DM + 512 + tid];
        const float ss = block_sum(xa * xa + xb2 * xb2, (LAS float*)(lds + 32768), tid);
        const float rstd = rsqrtf(ss * (1.0f / 1024.0f) + 1e-6f);
        EH[r * 1024 + tid] = xa * rstd * p.norm_mix[tid]; EH[r * 1024 + 512 + tid] = xb2 * rstd * p.norm_mix[512 + tid];
        __syncthreads();
    }
    {
        bf16_t* xb = (bf16_t*)(ws + WS_XB); float* sumsq = (float*)(ws + WS_SUMSQ);
#pragma unroll 1
        for (int row = bidx * 8 + wave; row < T_TOK; row += gridDim.x * 8) {
            const f32x4* xr = (const f32x4*)(p.x + (size_t)row * DM) + lane;
            f32x4 v[4]; float s = 0.f;
#pragma unroll
            for (int j = 0; j < 4; ++j) { v[j] = xr[64 * j]; s += (v[j][0] * v[j][0] + v[j][1] * v[j][1]) + (v[j][2] * v[j][2] + v[j][3] * v[j][3]); }
#pragma unroll
            for (int o = 1; o < 64; o <<= 1) s += __shfl_xor(s, o);
            u32x2* o8 = (u32x2*)(xb + (size_t)row * DM) + lane;
#pragma unroll
            for (int j = 0; j < 4; ++j) { u32x2 w; w.x = cvt_pk_bf16(v[j][0], v[j][1]); w.y = cvt_pk_bf16(v[j][2], v[j][3]); o8[64 * j] = w; }
            if (lane < 16) sumsq[(size_t)row * 16 + lane] = (lane == 0) ? s : 0.f;
        }
    }
}

template <class InFn>
__device__ __forceinline__ void exact_stage(const float* W0, const float* W1, int wsplit, int K, int N, float* part, InFn in_fn, LAS unsigned char* lds) {
    const int tid = tid_opaque(), lane = tid & 63, wave = tid >> 6;
    const int nsl = K / 256, ncg = (N + 511) / 512, ntasks = nsl * ncg;
    LAS float* IN = (LAS float*)lds;
#pragma unroll 1
    for (int task = blockIdx.x; task < ntasks; task += gridDim.x) {
        const int sl = task % nsl, cg = task / nsl;
        __syncthreads();
#pragma unroll 1
        for (int idx = tid; idx < 4096; idx += 512) IN[idx] = in_fn(idx >> 8, sl * 256 + (idx & 255));
        __syncthreads();
        const int col = (cg * 8 + wave) * 64 + lane;
#ifdef DUP_SIDE
        for (int rep = 0; rep < 2; ++rep)
#endif
        if (col < N) {
            const float* Wp = ((sl < wsplit) ? W0 + (size_t)sl * 256 * N : W1 + (size_t)(sl - wsplit) * 256 * N) + col;
            float acc[16];
#pragma unroll
            for (int r = 0; r < 16; ++r) acc[r] = 0.f;
#pragma unroll 2
            for (int k = 0; k < 256; k += 4) {
                const float w0 = Wp[(size_t)k * N], w1 = Wp[(size_t)(k + 1) * N], w2 = Wp[(size_t)(k + 2) * N], w3 = Wp[(size_t)(k + 3) * N];
#pragma unroll
                for (int r = 0; r < 16; ++r) { const f32x4 v = *(const LAS f32x4*)(IN + r * 256 + k); acc[r] += (v[0] * w0 + v[1] * w1) + (v[2] * w2 + v[3] * w3); }
            }
#pragma unroll
            for (int r = 0; r < 16; ++r) part[((size_t)sl * 16 + r) * N + col] = acc[r];
        }
    }
    __syncthreads();
}
__device__ __forceinline__ float block_sum(float v, LAS float* red, int tid) {
#pragma unroll
    for (int o = 1; o < 64; o <<= 1) v += __shfl_xor(v, o);
    __syncthreads();
    if ((tid & 63) == 0) red[tid >> 6] = v;
    __syncthreads();
    float s = 0.f;
#pragma unroll
    for (int i = 0; i < 8; ++i) s += red[i];
    return s;
}
__device__ __forceinline__ float ex_pp(const float* PP, int r, int c) { return (PP[(size_t)r * IN_COLS + c] + PP[(size_t)(16 + r) * IN_COLS + c]) + (PP[(size_t)(32 + r) * IN_COLS + c] + PP[(size_t)(48 + r) * IN_COLS + c]); }
__device__ __forceinline__ void exact_mixers(const Params& p, int r, LAS unsigned char* lds) {
    const int tid = tid_opaque();
    const float* PP = (const float*)(p.ws + WS_EX + EX_PP); float* OAB = (float*)(p.ws + WS_EX + EX_OAB);
    LAS float* red = (LAS float*)(lds + 32768);
    const int j = tid, h = j >> 7, e = j & 127;
    const float q = ex_pp(PP, r, j), z = ex_pp(PP, r, 512 + j), iv = ex_pp(PP, r, 1024 + j), g = ex_pp(PP, r, 1536 + j);
    float pr = q * (1.0f / (1.0f + __expf(z)));
#pragma unroll
    for (int o = 1; o < 64; o <<= 1) pr += __shfl_xor(pr, o);
    __syncthreads();
    if ((tid & 63) == 0) red[tid >> 6] = pr;
    __syncthreads();
    const float sh = red[2 * h] + red[2 * h + 1];
    const float o = sh * iv;
    float sq = o * o;
#pragma unroll
    for (int o2 = 1; o2 < 64; o2 <<= 1) sq += __shfl_xor(sq, o2);
    __syncthreads();
    if ((tid & 63) == 0) red[tid >> 6] = sq;
    __syncthreads();
    const float rstd = rsqrtf((red[2 * h] + red[2 * h + 1]) * (1.0f / 128.0f) + 1e-6f);
    OAB[(size_t)r * 1024 + j] = o * rstd * p.hg_gain[e] * (g / (1.0f + __expf(-g)));
    const int hh = j >> 6, d = j & 63, gg = hh >> 2, hp = hh & 3;
    const float vs = ex_pp(PP, r, 2944 + gg * 64 + d), vw = ex_pp(PP, r, 3200 + gg * 64 + d);
    const float gs = ex_pp(PP, r, 3328 + gg * 12 + hp * 3 + 1), gw = ex_pp(PP, r, 3328 + gg * 12 + hp * 3 + 2);
    OAB[(size_t)r * 1024 + 512 + j] = vs / (1.0f + __expf(-gs)) + vw / (1.0f + __expf(-gw));
    __syncthreads();
}
__device__ __forceinline__ float ex_x1(const Params& p, int r, int k) {
    const float* XP = (const float*)(p.ws + WS_EX + EX_XP);
    return p.x[(size_t)r * SEQ * DM + k] + ((XP[(size_t)r * 1024 + k] + XP[(size_t)(16 + r) * 1024 + k]) + (XP[(size_t)(32 + r) * 1024 + k] + XP[(size_t)(48 + r) * 1024 + k]));
}
__device__ __forceinline__ float ex_x2(const Params& p, int r, int k) {
    const float* DP = (const float*)(p.ws + WS_EX + EX_DP);
    float s = 0.f;
#pragma unroll
    for (int i = 0; i < 16; ++i) s += DP[((size_t)i * 16 + r) * 1024 + k];
    return ex_x1(p, r, k) + s;
}

constexpr int HG_TOT = 0, HG_DEC = 8192, HG_QB = 8704, HG_QS = HG_QB + 17408, HG_KVER = HG_QS + 17408, HG_KHT = HG_KVER + 43520, HG_VT = HG_KHT + 18432, HG_AM = HG_VT + 4608, HG_END = HG_AM + 9216;
static_assert(HG_END <= LDS_BYTES, "hgrn lds");
__device__ __forceinline__ void hgrn_unit(const Params& p, int layer, int unit, LAS unsigned char* lds) {
    unsigned char* ws = p.ws;
    const int tid = tid_opaque(), lane = tid & 63, wave = tid >> 6, l16 = lane & 15, quad = lane >> 4;
    const int b = unit >> 4, h = (unit >> 2) & 3, sl = unit & 3;
    const int d = tid & 127, tq = tid >> 7;
    const bf16_t* qg = (const bf16_t*)(ws + WS_HQ) + (size_t)b * SEQ * 512 + h * 128 + d;
    const bf16_t* zg = (const bf16_t*)(ws + WS_HF) + (size_t)b * SEQ * 512 + h * 128 + d;
    bf16_t* vg = (bf16_t*)(ws + WS_HI) + (size_t)b * SEQ * 512 + h * 128 + sl * 32;
    float lb = 0.f;
    if (layer == 1) lb = sigm(p.lb_logits[512 + h * 128 + d] - p.lb_logits[h * 128 + d]);
    const float omlb = 1.0f - lb;
    const int vv = tid & 31, sq = tid >> 5;
    const int tt = wave & 3, vt = wave >> 2;
    LAS float* TOT = (LAS float*)(lds + HG_TOT); LAS float* DEC = (LAS float*)(lds + HG_DEC);
    f32x4 S[8];
#pragma unroll
    for (int i = 0; i < 8; ++i) S[i] = (f32x4){0.f, 0.f, 0.f, 0.f};
    float s00;
    {
        LAS float* XR = (LAS float*)(lds + HG_KVER);
        LAS float* red0 = (LAS float*)(lds + HG_TOT);
        const float* nm = p.norm_mix + layer * DM;
        const float xa = (layer == 0) ? p.x[(size_t)b * SEQ * DM + tid] : ex_x2(p, b, tid);
        const float xb2 = (layer == 0) ? p.x[(size_t)b * SEQ * DM + 512 + tid] : ex_x2(p, b, 512 + tid);
        XR[tid] = xa * nm[tid]; XR[512 + tid] = xb2 * nm[512 + tid];
        const float ss = block_sum(xa * xa + xb2 * xb2, red0, tid);
        const float rstd = rsqrtf(ss * (1.0f / 1024.0f) + 1e-6f);
        __syncthreads();
        const float* W = p.w_in + (size_t)layer * DM * IN_COLS + h * 128 + d;
        float q0 = 0.f, z0 = 0.f;
#pragma unroll 4
        for (int k = tq * 256; k < tq * 256 + 256; ++k) { const float hk = XR[k]; q0 += hk * W[(size_t)k * IN_COLS]; z0 += hk * W[(size_t)k * IN_COLS + 512]; }
        LAS float* RED = (LAS float*)(lds + HG_QB);
        RED[tq * 128 + d] = q0; RED[512 + tq * 128 + d] = z0;
        __syncthreads();
        q0 = (RED[d] + RED[128 + d]) + (RED[256 + d] + RED[384 + d]); z0 = (RED[512 + d] + RED[640 + d]) + (RED[768 + d] + RED[896 + d]);
        q0 *= rstd; z0 *= rstd;
        float pr = q0 * (omlb / (1.0f + __expf(z0)));
#pragma unroll
        for (int o = 1; o < 64; o <<= 1) pr += __shfl_xor(pr, o);
        __syncthreads();
        if (lane == 0) RED[wave] = pr;
        __syncthreads();
        s00 = RED[0] + RED[1];
#ifdef DIAG_S00
        if (layer == 1 && tid == 0) atomicMin((unsigned*)(ws + 512), __float_as_uint(fabsf(s00)));
#endif
        __syncthreads();
    }
    const int d0 = 2 * lane, tg = wave, Jc = wave >> 1, hf = wave & 1;
    const unsigned* qg2 = (const unsigned*)((const bf16_t*)(ws + WS_HQ) + (size_t)b * SEQ * 512 + h * 128 + d0);
    const unsigned* zg2 = (const unsigned*)((const bf16_t*)(ws + WS_HF) + (size_t)b * SEQ * 512 + h * 128 + d0);
    float lbA = 0.f, lbB = 0.f;
    if (layer == 1) { lbA = sigm(p.lb_logits[512 + h * 128 + d0] - p.lb_logits[h * 128 + d0]); lbB = sigm(p.lb_logits[512 + h * 128 + d0 + 1] - p.lb_logits[h * 128 + d0 + 1]); }
    const float omA = 1.0f - lbA, omB = 1.0f - lbB;
    LAS float* PRODS = (LAS float*)(lds + HG_TOT);
    LAS float* LOGPS = (LAS float*)(lds + HG_TOT + 4096);
    unsigned qw[8], zw[8]; unsigned short vr[4];
#pragma unroll
    for (int i = 0; i < 8; ++i) { qw[i] = qg2[(size_t)(8 * tg + i) * 256]; zw[i] = zg2[(size_t)(8 * tg + i) * 256]; }
#pragma unroll
    for (int i = 0; i < 4; ++i) vr[i] = vg[(size_t)(4 * sq + i) * 512 + vv];
    for (int c = 0; c < 64; ++c) {
        float qA[8], qB[8], kA[8], kB[8], eA[8], eB[8]; unsigned short vcur[4];
        {
            float pA = 1.f, pB = 1.f;
#pragma unroll
            for (int i = 0; i < 8; ++i) {
                qA[i] = bf_lo(qw[i]); qB[i] = bf_hi(qw[i]);
                const float zA = bf_lo(zw[i]), zB = bf_hi(zw[i]);
                const float ea = __expf(-zA), eb = __expf(-zB);
                const float ia = __builtin_amdgcn_rcpf(1.0f + ea), ib = __builtin_amdgcn_rcpf(1.0f + eb);
                kA[i] = omA * (ea * ia); kB[i] = omB * (eb * ib);
                pA *= lbA + omA * ia; pB *= lbB + omB * ib; eA[i] = pA; eB[i] = pB;
            }
#pragma unroll
            for (int i = 0; i < 4; ++i) vcur[i] = vr[i];
            *(LAS f32x2c_t*)(PRODS + tg * 128 + d0) = (f32x2c_t){pA, pB};
            *(LAS f32x2c_t*)(LOGPS + tg * 128 + d0) = (f32x2c_t){__logf(fmaxf(pA, 1e-37f)), __logf(fmaxf(pB, 1e-37f))};
        }
        __syncthreads();
        float rJA = 0.f, rJB = 0.f, r1A = 0.f, r1B = 0.f, r2A = 0.f, r2B = 0.f, r3A = 0.f, r3B = 0.f, r4A, r4B;
        {
            float accA = 0.f, accB = 0.f;
#pragma unroll
            for (int w = 0; w < 8; ++w) {
                if (w == 2) { r1A = accA; r1B = accB; } if (w == 4) { r2A = accA; r2B = accB; } if (w == 6) { r3A = accA; r3B = accB; }
                const f32x2c_t lp = *(const LAS f32x2c_t*)(LOGPS + w * 128 + d0); accA += lp[0]; accB += lp[1];
            }
            r4A = accA; r4B = accB;
            rJA = (Jc == 0) ? 0.f : ((Jc == 1) ? r1A : ((Jc == 2) ? r2A : r3A)); rJB = (Jc == 0) ? 0.f : ((Jc == 1) ? r1B : ((Jc == 2) ? r2B : r3B));
        }
        if (hf) {
            const f32x2c_t pp = *(const LAS f32x2c_t*)(PRODS + (tg - 1) * 128 + d0);
#pragma unroll
            for (int i = 0; i < 8; ++i) { eA[i] *= pp[0]; eB[i] *= pp[1]; }
        }
        if (tg == 0) *(LAS f32x2c_t*)(DEC + d0) = (f32x2c_t){__expf(r4A), __expf(r4B)};
        {
            LAS unsigned* QB = (LAS unsigned*)(lds + HG_QB); LAS unsigned* QS = (LAS unsigned*)(lds + HG_QS); LAS unsigned* KV_ = (LAS unsigned*)(lds + HG_KVER);
            float riA[8], riB[8];
            const float eJA = __expf(rJA), eJB = __expf(rJB), c4A = __expf(r4A - rJA), c4B = __expf(r4B - rJB);
#pragma unroll
            for (int i = 0; i < 8; ++i) {
                const int t = 8 * tg + i;
                riA[i] = kA[i] * __builtin_amdgcn_rcpf(fmaxf(eA[i], 1e-30f)); riB[i] = kB[i] * __builtin_amdgcn_rcpf(fmaxf(eB[i], 1e-30f));
                const float sA = qA[i] * eA[i], sB = qB[i] * eB[i];
                QS[t * 68 + lane] = cvt_pk_bf16(sA, sB);
                QB[t * 68 + lane] = cvt_pk_bf16(sA * eJA, sB * eJB);
            }
#pragma unroll
            for (int I = 0; I < 4; ++I) {
                if (I >= Jc) {
                    const float rIA = (I == 0) ? 0.f : ((I == 1) ? r1A : ((I == 2) ? r2A : r3A)), rIB = (I == 0) ? 0.f : ((I == 1) ? r1B : ((I == 2) ? r2B : r3B));
                    const int voff = (I == 0) ? 0 : ((I == 1) ? 16 : ((I == 2) ? 48 : 96));
                    const float cA = __expf(rIA - rJA), cB = __expf(rIB - rJB);
#pragma unroll
                    for (int i = 0; i < 8; ++i) KV_[(voff + 8 * tg + i) * 68 + lane] = cvt_pk_bf16(riA[i] * cA, riB[i] * cB);
                }
            }
            LAS unsigned char* KHT = lds + HG_KHT;
            u32x4 w0, w1;
            w0.x = cvt_pk_bf16(riA[0] * c4A, riA[1] * c4A); w0.y = cvt_pk_bf16(riA[2] * c4A, riA[3] * c4A); w0.z = cvt_pk_bf16(riA[4] * c4A, riA[5] * c4A); w0.w = cvt_pk_bf16(riA[6] * c4A, riA[7] * c4A);
            w1.x = cvt_pk_bf16(riB[0] * c4B, riB[1] * c4B); w1.y = cvt_pk_bf16(riB[2] * c4B, riB[3] * c4B); w1.z = cvt_pk_bf16(riB[4] * c4B, riB[5] * c4B); w1.w = cvt_pk_bf16(riB[6] * c4B, riB[7] * c4B);
            *(LAS u32x4*)(KHT + d0 * 144 + tg * 16) = w0; *(LAS u32x4*)(KHT + (d0 + 1) * 144 + tg * 16) = w1;
            LAS unsigned char* VT = lds + HG_VT;
            u32x2 wv; wv.x = (unsigned)vcur[0] | ((unsigned)vcur[1] << 16); wv.y = (unsigned)vcur[2] | ((unsigned)vcur[3] << 16);
            *(LAS u32x2*)(VT + vv * 144 + sq * 8) = wv;
            LAS u32x4* AMz = (LAS u32x4*)(lds + HG_AM);
            AMz[tid] = (u32x4){0u, 0u, 0u, 0u}; if (tid < 64) AMz[512 + tid] = (u32x4){0u, 0u, 0u, 0u};
        }
        __syncthreads();
        if (c + 1 < 64) {
            const size_t ro = (size_t)(c + 1) * 64 * 512;
#pragma unroll
            for (int i = 0; i < 8; ++i) { qw[i] = qg2[(ro >> 1) + (size_t)(8 * tg + i) * 256]; zw[i] = zg2[(ro >> 1) + (size_t)(8 * tg + i) * 256]; }
#pragma unroll
            for (int i = 0; i < 4; ++i) vr[i] = vg[ro + (size_t)(4 * sq + i) * 512 + vv];
        }
        for (int pi = wave; pi < 10; pi += 8) {
            int I, J;
            if (pi == 0) { I = 0; J = 0; } else if (pi < 3) { I = 1; J = pi - 1; } else if (pi < 6) { I = 2; J = pi - 3; } else { I = 3; J = pi - 6; }
            const int voff = (I == 0) ? 0 : ((I == 1) ? 16 : ((I == 2) ? 48 : 96));
            const LAS unsigned char* qa = lds + HG_QS + (16 * I + l16) * 272 + quad * 16;
            const LAS unsigned char* kb = lds + HG_KVER + (voff + 16 * J + l16) * 272 + quad * 16;
            f32x4 a = (f32x4){0.f, 0.f, 0.f, 0.f};
#pragma unroll
            for (int ks = 0; ks < 4; ++ks) a = MFMA16(lds_ld8(qa + ks * 64), lds_ld8(kb + ks * 64), a);
            LAS bf16_t* AM = (LAS bf16_t*)(lds + HG_AM);
#pragma unroll
            for (int j = 0; j < 4; ++j) {
                float v = a[j]; if (I == J && l16 > quad * 4 + j) v = 0.f;
                if (c == 0 && pi == 0 && lane == 0 && j == 0) v = s00;
                AM[(16 * I + quad * 4 + j) * 72 + 16 * J + l16] = bf1(v);
            }
        }
        __syncthreads();
        {
            f32x4 o = (f32x4){0.f, 0.f, 0.f, 0.f};
            const LAS unsigned char* qb = lds + HG_QB + (16 * tt + l16) * 272 + quad * 8;
#pragma unroll
            for (int s2 = 0; s2 < 4; ++s2) o = MFMA16(lds_ld4x2(qb + s2 * 64, qb + s2 * 64 + 32), pack8(S[2 * s2], S[2 * s2 + 1]), o);
            const LAS unsigned char* am = lds + HG_AM + (16 * tt + l16) * 144 + quad * 16;
            const LAS unsigned char* vb = lds + HG_VT + (16 * vt + l16) * 144 + quad * 16;
            const bf16x8 vb0 = lds_ld8(vb), vb1 = lds_ld8(vb + 64);
            o = MFMA16(lds_ld8(am), vb0, o); o = MFMA16(lds_ld8(am + 64), vb1, o);
            bf16_t* og = (bf16_t*)(ws + WS_TMP) + (size_t)b * SEQ * 512 + h * 128 + sl * 32 + (size_t)(c * 64 + 16 * tt + quad * 4) * 512 + 16 * vt + l16;
#pragma unroll
            for (int j = 0; j < 4; ++j) og[(size_t)j * 512] = bf1(o[j]);
#pragma unroll
            for (int dt = 0; dt < 8; ++dt) {
                const f32x4 dc = *(const LAS f32x4*)(DEC + 16 * dt + quad * 4);
                const LAS unsigned char* ka = lds + HG_KHT + (16 * dt + l16) * 144 + quad * 16;
                f32x4 s = S[dt] * dc;
                s = MFMA16(lds_ld8(ka), vb0, s); s = MFMA16(lds_ld8(ka + 64), vb1, s);
                S[dt] = s;
            }
        }
        __syncthreads();
    }
}

__device__ __forceinline__ void hgrn_finalize(const Params& p, int layer) {
    unsigned char* ws = p.ws;
    const int tid = tid_opaque(), lane = tid & 63, wave = tid >> 6;
    const float* gain = p.hg_gain + layer * 128 + (lane & 15) * 8;
    float gn[8];
#pragma unroll
    for (int e = 0; e < 8; ++e) gn[e] = gain[e];
    for (int row = blockIdx.x * 8 + wave; row < T_TOK; row += gridDim.x * 8) {
        u32x4* op = (u32x4*)((bf16_t*)(ws + WS_HI) + (size_t)row * 512) + lane;
        const u32x4 ov = *((const u32x4*)((const bf16_t*)(ws + WS_TMP) + (size_t)row * 512) + lane), gv = *((const u32x4*)((const bf16_t*)(ws + WS_HG) + (size_t)row * 512) + lane);
        float o[8], g[8];
        o[0] = bf_lo(ov.x); o[1] = bf_hi(ov.x); o[2] = bf_lo(ov.y); o[3] = bf_hi(ov.y); o[4] = bf_lo(ov.z); o[5] = bf_hi(ov.z); o[6] = bf_lo(ov.w); o[7] = bf_hi(ov.w);
        g[0] = bf_lo(gv.x); g[1] = bf_hi(gv.x); g[2] = bf_lo(gv.y); g[3] = bf_hi(gv.y); g[4] = bf_lo(gv.z); g[5] = bf_hi(gv.z); g[6] = bf_lo(gv.w); g[7] = bf_hi(gv.w);
        float s = 0.f;
#pragma unroll
        for (int e = 0; e < 8; ++e) s += o[e] * o[e];
        s += __shfl_xor(s, 1); s += __shfl_xor(s, 2); s += __shfl_xor(s, 4); s += __shfl_xor(s, 8);
        const float rstd = rsqrtf(s * (1.0f / 128.0f) + 1e-6f);
#pragma unroll
        for (int e = 0; e < 8; ++e) o[e] = o[e] * rstd * gn[e] * (g[e] * sigm(g[e]));
        u32x4 w; w.x = cvt_pk_bf16(o[0], o[1]); w.y = cvt_pk_bf16(o[2], o[3]); w.z = cvt_pk_bf16(o[4], o[5]); w.w = cvt_pk_bf16(o[6], o[7]);
        *op = w;
    }
}

constexpr int CM_A = 0, CM_W = 9216, CM_H = CM_W + 18432, CM_W2 = CM_H + 17408, CM_END = CM_W2 + 17408;
__device__ __forceinline__ void cmp_unit(const Params& p, int layer, int unit, LAS unsigned char* lds) {
    unsigned char* ws = p.ws;
    const int tid = tid_opaque(), lane = tid & 63, wave = tid >> 6, l16 = lane & 15, quad = lane >> 4;
    const int ct = unit & 3, kv = (unit >> 2) & 1, g = (unit >> 3) & 1, b = unit >> 4;
    const bf16_t* src = (const bf16_t*)(ws + WS_KV) + (size_t)b * SEQ * 768 + kv * 128 + g * 64;
    const bf16_t* W1T = (const bf16_t*)(ws + WS_CW1T) + (size_t)(layer * 2 + kv) * 128 * 2048;
    const bf16_t* W2T = (const bf16_t*)(ws + WS_CW2T) + (size_t)(layer * 2 + kv) * 64 * 128;
    const float* cbias = (const float*)(ws + WS_CBIAS) + (layer * 2 + kv) * 128;
    {
        const int n = tid >> 3, ch = tid & 7;
        *(LAS u32x4*)(lds + CM_W2 + n * 272 + ch * 32) = *(const u32x4*)(W2T + n * 128 + ch * 16);
        *(LAS u32x4*)(lds + CM_W2 + n * 272 + ch * 32 + 16) = *(const u32x4*)(W2T + n * 128 + ch * 16 + 8);
    }
    const int arow = tid >> 3, ach = tid & 7, ac = ct * 64 + arow;
    const bool aval = ac < 255;
    const bf16_t* ap = src + (size_t)(16 * (aval ? ac : 0)) * 768 + ach * 8;
    const int mi = wave & 3, nh = wave >> 2;
    f32x4 acc[4];
#pragma unroll
    for (int i = 0; i < 4; ++i) acc[i] = (f32x4){0.f, 0.f, 0.f, 0.f};
    u32x4 ar, wr0, wr1;
    ar = aval ? *(const u32x4*)ap : (u32x4){0u, 0u, 0u, 0u};
    wr0 = *(const u32x4*)(W1T + (size_t)(tid >> 3) * 2048 + (tid & 7) * 8);
    wr1 = *(const u32x4*)(W1T + (size_t)(64 + (tid >> 3)) * 2048 + (tid & 7) * 8);
    for (int tok = 0; tok < 32; ++tok) {
        __syncthreads();
        *(LAS u32x4*)(lds + CM_A + arow * 144 + ach * 16) = ar;
        *(LAS u32x4*)(lds + CM_W + (tid >> 3) * 144 + (tid & 7) * 16) = wr0;
        *(LAS u32x4*)(lds + CM_W + (64 + (tid >> 3)) * 144 + (tid & 7) * 16) = wr1;
        __syncthreads();
        if (tok + 1 < 32) {
            ar = aval ? *(const u32x4*)(ap + (size_t)(tok + 1) * 768) : (u32x4){0u, 0u, 0u, 0u};
            wr0 = *(const u32x4*)(W1T + (size_t)(tid >> 3) * 2048 + (tok + 1) * 64 + (tid & 7) * 8);
            wr1 = *(const u32x4*)(W1T + (size_t)(64 + (tid >> 3)) * 2048 + (tok + 1) * 64 + (tid & 7) * 8);
        }
#pragma unroll
        for (int ks = 0; ks < 2; ++ks) {
            const bf16x8 a = lds_ld8(lds + CM_A + (mi * 16 + l16) * 144 + ks * 64 + quad * 16);
#pragma unroll
            for (int ni = 0; ni < 4; ++ni) acc[ni] = MFMA16(a, lds_ld8(lds + CM_W + ((nh * 4 + ni) * 16 + l16) * 144 + ks * 64 + quad * 16), acc[ni]);
        }
    }
    {
        LAS bf16_t* H = (LAS bf16_t*)(lds + CM_H);
#pragma unroll
        for (int ni = 0; ni < 4; ++ni) {
            const int n = (nh * 4 + ni) * 16 + l16; const float cb = cbias[n];
#pragma unroll
            for (int j = 0; j < 4; ++j) {
                const float x = acc[ni][j] + cb;
                const float u = 0.7978845608028654f * (x + 0.044715f * x * x * x);
                const float th = 1.0f - 2.0f / (__expf(2.0f * u) + 1.0f);
                H[(mi * 16 + quad * 4 + j) * 136 + n] = bf1(0.5f * x * (1.0f + th));
            }
        }
    }
    __syncthreads();
    if (wave < 4) {
        f32x4 a2[4];
#pragma unroll
        for (int i = 0; i < 4; ++i) a2[i] = (f32x4){0.f, 0.f, 0.f, 0.f};
#pragma unroll
        for (int ks = 0; ks < 4; ++ks) {
            const bf16x8 a = lds_ld8(lds + CM_H + (wave * 16 + l16) * 272 + ks * 64 + quad * 16);
#pragma unroll
            for (int ni = 0; ni < 4; ++ni) a2[ni] = MFMA16(a, lds_ld8(lds + CM_W2 + (ni * 16 + l16) * 272 + ks * 64 + quad * 16), a2[ni]);
        }
        if (kv == 0) {
            bf16_t* KC = (bf16_t*)(ws + WS_KCMP) + (size_t)(b * 2 + g) * 256 * 64;
            const float* gain = p.qk_gain + (layer * 4 + 1) * 64;
#pragma unroll
            for (int j = 0; j < 4; ++j) {
                float s = (a2[0][j] * a2[0][j] + a2[1][j] * a2[1][j]) + (a2[2][j] * a2[2][j] + a2[3][j] * a2[3][j]);
                s += __shfl_xor(s, 1); s += __shfl_xor(s, 2); s += __shfl_xor(s, 4); s += __shfl_xor(s, 8);
                const float rstd = rsqrtf(s * (1.0f / 64.0f) + 1e-6f);
                const int c = ct * 64 + wave * 16 + quad * 4 + j;
#pragma unroll
                for (int ni = 0; ni < 4; ++ni) KC[(size_t)c * 64 + ni * 16 + l16] = (c < 255) ? bf1(a2[ni][j] * rstd * gain[ni * 16 + l16]) : (bf16_t)0;
            }
        } else {
            bf16_t* VC = (bf16_t*)(ws + WS_VCMPT) + (size_t)(b * 2 + g) * 64 * 256;
#pragma unroll
            for (int j = 0; j < 4; ++j) {
                const int c = ct * 64 + wave * 16 + quad * 4 + j;
#pragma unroll
                for (int ni = 0; ni < 4; ++ni) VC[(size_t)(ni * 16 + l16) * 256 + c] = (c < 255) ? bf1(a2[ni][j]) : (bf16_t)0;
            }
        }
    }
    __syncthreads();
}

constexpr int AT_TAB = 0, AT_TABW = 13824, AT_K = 23296, AT_V = AT_K + 18432, AT_PS = AT_V + 18432, AT_MASK = AT_PS + 65536, AT_END = AT_MASK + 512;
static_assert(AT_END <= LDS_BYTES, "attn lds");

struct AttnCtx {
    const bf16_t* ksrc; const bf16_t* vsrc; int ldk, ldv; const float* kgain;
    int tpos[2]; int h;
};

template <int BR>
__device__ __forceinline__ void attn_branch(const AttnCtx& cx, const bf16x8 (&qf)[2][2], int qt, unsigned long long selu, const unsigned long long (&selm)[2],
                                            f32x4 (&of)[2][4], const float (&gate)[2], LAS unsigned char* lds, float (&m_out)[2], float (&il_out)[2]) {
    const int tid = tid_opaque(), lane = tid & 63, l16 = lane & 15, quad = lane >> 4;
    const int srow = tid >> 3, sch = tid & 7;
    float kg[8];
    if (BR != 0) {
#pragma unroll
        for (int e = 0; e < 8; ++e) kg[e] = cx.kgain[sch * 8 + e];
    }
    unsigned long long rem;
    if (BR == 0) rem = 0xFull;
    else if (BR == 1) rem = selu & ((qt >= 63) ? ~0ull : ((2ull << qt) - 1ull));
    else { const int lo = qt > 8 ? qt - 8 : 0; rem = ((qt >= 63) ? ~0ull : ((2ull << qt) - 1ull)) & ~((1ull << lo) - 1ull); }
    f32x4 o[2][4]; float l[2];
#pragma unroll
    for (int mi = 0; mi < 2; ++mi) { l[mi] = 0.f;
#pragma unroll
        for (int di = 0; di < 4; ++di) o[mi][di] = (f32x4){0.f, 0.f, 0.f, 0.f}; }
    int cur = rem ? __builtin_ctzll(rem) : -1; if (rem) rem &= rem - 1ull;
    u32x4 kr, vr;
    auto gload = [&](int jt) {
        kr = *(const u32x4*)(cx.ksrc + (size_t)(jt * 64 + srow) * cx.ldk + sch * 8);
        vr = *(const u32x4*)(cx.vsrc + (size_t)srow * cx.ldv + jt * 64 + sch * 8);
    };
    auto lstore = [&](int buf) {
        u32x4 kw = kr;
        if (BR != 0) {
            float f[8]; f[0] = bf_lo(kr.x); f[1] = bf_hi(kr.x); f[2] = bf_lo(kr.y); f[3] = bf_hi(kr.y); f[4] = bf_lo(kr.z); f[5] = bf_hi(kr.z); f[6] = bf_lo(kr.w); f[7] = bf_hi(kr.w);
            float s = 0.f;
#pragma unroll
            for (int e = 0; e < 8; ++e) s += f[e] * f[e];
            s += __shfl_xor(s, 1); s += __shfl_xor(s, 2); s += __shfl_xor(s, 4);
            const float rstd = rsqrtf(s * (1.0f / 64.0f) + 1e-6f);
#pragma unroll
            for (int e = 0; e < 8; ++e) f[e] = f[e] * rstd * kg[e];
            kw.x = cvt_pk_bf16(f[0], f[1]); kw.y = cvt_pk_bf16(f[2], f[3]); kw.z = cvt_pk_bf16(f[4], f[5]); kw.w = cvt_pk_bf16(f[6], f[7]);
        }
        *(LAS u32x4*)(lds + AT_K + buf * 9216 + srow * 144 + sch * 16) = kw;
        *(LAS u32x4*)(lds + AT_V + buf * 9216 + srow * 144 + sch * 16) = vr;
    };
    if (cur >= 0) { gload(cur); lstore(0); }
    __syncthreads();
    int buf = 0;
    const LAS f32x4* TAB = (const LAS f32x4*)(lds + AT_TAB);
    const LAS float* TABf = (const LAS float*)(lds + AT_TAB);
#pragma nounroll
    while (cur >= 0) {
        const int nxt = rem ? __builtin_ctzll(rem) : -1; if (rem) rem &= rem - 1ull;
        if (nxt >= 0) gload(nxt);
        const LAS unsigned char* Kb = lds + AT_K + buf * 9216; const LAS unsigned char* Vb = lds + AT_V + buf * 9216;
        f32x4 st[2][4];
        const bool far_tile = (BR == 1) && (cur * 64 + 63 + 790 <= qt * 64);
        const bool ok0 = (BR != 1) || ((selm[0] >> cur) & 1ull), ok1 = (BR != 1) || ((selm[1] >> cur) & 1ull);
        const float c31 = TABf[863 * 4 + cx.h];
        const float cb0 = ok0 ? c31 : -INFINITY, cb1 = ok1 ? c31 : -INFINITY;
        const int bs0 = ok0 ? ((BR == 0) ? (cx.tpos[0] + 33 - 16 * (cur * 64 + quad * 4)) : (cx.tpos[0] + 64 - cur * 64 - quad * 4)) : -(1 << 20);
        const int bs1 = ok1 ? ((BR == 0) ? (cx.tpos[1] + 33 - 16 * (cur * 64 + quad * 4)) : (cx.tpos[1] + 64 - cur * 64 - quad * 4)) : -(1 << 20);
        const LAS unsigned char* tb = lds + ((BR == 2) ? AT_TABW : AT_TAB) + cx.h * 4;
        constexpr int MAXI = (BR == 2) ? 576 : 863;
#pragma unroll
        for (int ni = 0; ni < 4; ++ni) {
            const bf16x8 k0 = lds_ld8(Kb + (ni * 16 + l16) * 144 + quad * 16), k1 = lds_ld8(Kb + (ni * 16 + l16) * 144 + 64 + quad * 16);
            f32x4 a0, a1;
            if (far_tile) { a0 = (f32x4){cb0, cb0, cb0, cb0}; a1 = (f32x4){cb1, cb1, cb1, cb1}; }
            else {
                constexpr int CM = (BR == 0) ? 16 : 1;
                const int i00 = clampi(bs0 - CM * (ni * 16 + 0), 0, MAXI), i01 = clampi(bs0 - CM * (ni * 16 + 1), 0, MAXI), i02 = clampi(bs0 - CM * (ni * 16 + 2), 0, MAXI), i03 = clampi(bs0 - CM * (ni * 16 + 3), 0, MAXI);
                const int i10 = clampi(bs1 - CM * (ni * 16 + 0), 0, MAXI), i11 = clampi(bs1 - CM * (ni * 16 + 1), 0, MAXI), i12 = clampi(bs1 - CM * (ni * 16 + 2), 0, MAXI), i13 = clampi(bs1 - CM * (ni * 16 + 3), 0, MAXI);
                a0 = (f32x4){*(const LAS float*)(tb + i00 * 16), *(const LAS float*)(tb + i01 * 16), *(const LAS float*)(tb + i02 * 16), *(const LAS float*)(tb + i03 * 16)};
                a1 = (f32x4){*(const LAS float*)(tb + i10 * 16), *(const LAS float*)(tb + i11 * 16), *(const LAS float*)(tb + i12 * 16), *(const LAS float*)(tb + i13 * 16)};
            }
            a0 = MFMA16(k0, qf[0][0], a0); a0 = MFMA16(k1, qf[0][1], a0); st[0][ni] = a0;
            a1 = MFMA16(k0, qf[1][0], a1); a1 = MFMA16(k1, qf[1][1], a1); st[1][ni] = a1;
            __builtin_amdgcn_sched_barrier(0);
        }
        bf16x8 pb[2][2];
#pragma unroll
        for (int mi = 0; mi < 2; ++mi) {
            float ls = 0.f;
#pragma unroll
            for (int ni = 0; ni < 4; ++ni)
#pragma unroll
                for (int j = 0; j < 4; ++j) { const float pv = __builtin_amdgcn_exp2f(st[mi][ni][j]); st[mi][ni][j] = pv; ls += pv; }
            l[mi] += ls;
            pb[mi][0] = pack8(st[mi][0], st[mi][1]); pb[mi][1] = pack8(st[mi][2], st[mi][3]);
        }
#pragma unroll
        for (int di = 0; di < 4; ++di)
#pragma unroll
            for (int s2 = 0; s2 < 2; ++s2) {
                const LAS unsigned char* vp = Vb + (di * 16 + l16) * 144 + s2 * 64 + quad * 8;
                const bf16x8 vf = lds_ld4x2(vp, vp + 32);
#pragma unroll
                for (int mi = 0; mi < 2; ++mi) o[mi][di] = MFMA16(vf, pb[mi][s2], o[mi][di]);
            }
        if (nxt >= 0) lstore(buf ^ 1);
        __syncthreads();
        cur = nxt; buf ^= 1;
    }
#pragma unroll
    for (int mi = 0; mi < 2; ++mi) {
        float lt = l[mi]; lt += __shfl_xor(lt, 16); lt += __shfl_xor(lt, 32);
        const float il = lt > 0.f ? 1.0f / lt : 0.f;
        const float sc = il * gate[mi];
#pragma unroll
        for (int di = 0; di < 4; ++di) of[mi][di] = of[mi][di] + o[mi][di] * sc;
        m_out[mi] = 0.f; il_out[mi] = il;
    }
    (void)TAB;
}

__device__ __forceinline__ void attn_cmp_probs(const AttnCtx& cx, const bf16x8 (&qf)[2][2], const float (&mrow)[2], const float (&ilrow)[2], LAS unsigned char* lds) {
    const int tid = tid_opaque(), lane = tid & 63, wave = tid >> 6, l16 = lane & 15, quad = lane >> 4;
    const int srow = tid >> 3, sch = tid & 7;
    const LAS float* TABf = (const LAS float*)(lds + AT_TAB);
    LAS float* PS = (LAS float*)(lds + AT_PS);
#pragma nounroll
    for (int jt = 0; jt < 4; ++jt) {
        const u32x4 kr = *(const u32x4*)(cx.ksrc + (size_t)(jt * 64 + srow) * cx.ldk + sch * 8);
        __syncthreads();
        *(LAS u32x4*)(lds + AT_K + srow * 144 + sch * 16) = kr;
        __syncthreads();
        const LAS unsigned char* Kb = lds + AT_K;
#pragma unroll
        for (int ni = 0; ni < 4; ++ni) {
            const bf16x8 k0 = lds_ld8(Kb + (ni * 16 + l16) * 144 + quad * 16), k1 = lds_ld8(Kb + (ni * 16 + l16) * 144 + 64 + quad * 16);
#pragma unroll
            for (int mi = 0; mi < 2; ++mi) {
                f32x4 a = (f32x4){0.f, 0.f, 0.f, 0.f}; a = MFMA16(k0, qf[mi][0], a); a = MFMA16(k1, qf[mi][1], a);
                const int tp = cx.tpos[mi];
                f32x4 pr;
#pragma unroll
                for (int j = 0; j < 4; ++j) {
                    const int kidx = jt * 64 + ni * 16 + quad * 4 + j;
                    int idx = tp + 33 - 16 * kidx; idx = idx < 0 ? 0 : (idx > 863 ? 863 : idx);
                    float pv = __builtin_amdgcn_exp2f(a[j] + TABf[idx * 4 + cx.h] - mrow[mi]) * ilrow[mi];
                    pv += __shfl_xor(pv, 1); pv += __shfl_xor(pv, 2);
                    pr[j] = pv;
                }
                if ((l16 & 3) == 0) *(LAS f32x4*)(PS + (wave * 8 + mi * 4 + (l16 >> 2)) * 256 + jt * 64 + ni * 16 + quad * 4) = pr;
            }
        }
    }
    __syncthreads();
}

__device__ __forceinline__ void attn_unit(const Params& p, int layer, int b, int g, int qt, LAS unsigned char* lds) {
    unsigned char* ws = p.ws;
    const int tid = tid_opaque(), lane = tid & 63, wave = tid >> 6, l16 = lane & 15, quad = lane >> 4;
    const int t0 = qt * 64;
    __syncthreads();
    {
        LAS float* TABw = (LAS float*)(lds + AT_TAB); LAS float* TABW2 = (LAS float*)(lds + AT_TABW);
        for (int i = tid; i < 864 * 4; i += 512) {
            const int dist = (i >> 2) - 64, hh = i & 3;
            int bk;
            if (dist < 16) bk = dist < 0 ? 0 : dist;
            else { bk = 16 + (dist >= 21) + (dist >= 27) + (dist >= 35) + (dist >= 46) + (dist >= 59) + (dist >= 77) + (dist >= 99) + (dist >= 128) + (dist >= 166) + (dist >= 216) + (dist >= 280) + (dist >= 363) + (dist >= 470) + (dist >= 609) + (dist >= 790); }
            const float v = (dist < 0) ? -INFINITY : p.rel_bias[bk * 8 + g * 4 + hh] * 1.4426950408889634f;
            TABw[i] = v;
            if (i < 577 * 4) TABW2[i] = (i < 576 * 4) ? v : -INFINITY;
        }
    }
    AttnCtx cx; cx.h = l16 & 3;
    bf16x8 qf[2][2]; float gates[3][2];
    bf16_t* nq = (bf16_t*)(ws + WS_NQ);
    const bf16_t* ng = (const bf16_t*)(ws + WS_NG);
    const float* qgain = p.qk_gain + (layer * 4 + 0) * 64;
#pragma unroll
    for (int mi = 0; mi < 2; ++mi) {
        const int tl = wave * 8 + mi * 4 + (l16 >> 2); const int tp = t0 + tl; cx.tpos[mi] = tp;
        const size_t row = (size_t)b * SEQ + tp;
        const bf16_t* qp = nq + row * 512 + g * 256 + cx.h * 64 + quad * 8;
        const u32x4 q0 = *(const u32x4*)qp, q1 = *(const u32x4*)(qp + 32);
        float f[16];
        f[0] = bf_lo(q0.x); f[1] = bf_hi(q0.x); f[2] = bf_lo(q0.y); f[3] = bf_hi(q0.y); f[4] = bf_lo(q0.z); f[5] = bf_hi(q0.z); f[6] = bf_lo(q0.w); f[7] = bf_hi(q0.w);
        f[8] = bf_lo(q1.x); f[9] = bf_hi(q1.x); f[10] = bf_lo(q1.y); f[11] = bf_hi(q1.y); f[12] = bf_lo(q1.z); f[13] = bf_hi(q1.z); f[14] = bf_lo(q1.w); f[15] = bf_hi(q1.w);
        float s = 0.f;
#pragma unroll
        for (int e = 0; e < 16; ++e) s += f[e] * f[e];
        s += __shfl_xor(s, 16); s += __shfl_xor(s, 32);
        const float rstd = rsqrtf(s * (1.0f / 64.0f) + 1e-6f) * (0.125f * 1.4426950408889634f);
#pragma unroll
        for (int e = 0; e < 8; ++e) { f[e] = f[e] * rstd * qgain[quad * 8 + e]; f[8 + e] = f[8 + e] * rstd * qgain[32 + quad * 8 + e]; }
        u32x4 w0, w1;
        w0.x = cvt_pk_bf16(f[0], f[1]); w0.y = cvt_pk_bf16(f[2], f[3]); w0.z = cvt_pk_bf16(f[4], f[5]); w0.w = cvt_pk_bf16(f[6], f[7]);
        w1.x = cvt_pk_bf16(f[8], f[9]); w1.y = cvt_pk_bf16(f[10], f[11]); w1.z = cvt_pk_bf16(f[12], f[13]); w1.w = cvt_pk_bf16(f[14], f[15]);
        qf[mi][0] = __builtin_bit_cast(bf16x8, w0); qf[mi][1] = __builtin_bit_cast(bf16x8, w1);
#pragma unroll
        for (int br = 0; br < 3; ++br) gates[br][mi] = bfu(ng[row * 256 + g * 12 + cx.h * 3 + br]);
    }
    __syncthreads();
    f32x4 of[2][4];
#pragma unroll
    for (int mi = 0; mi < 2; ++mi)
#pragma unroll
        for (int di = 0; di < 4; ++di) of[mi][di] = (f32x4){0.f, 0.f, 0.f, 0.f};
    const unsigned long long nomask[2] = {0ull, 0ull};
    float mrow[2], ilrow[2];
    cx.ksrc = (const bf16_t*)(ws + WS_KCMP) + (size_t)(b * 2 + g) * 256 * 64; cx.ldk = 64;
    cx.vsrc = (const bf16_t*)(ws + WS_VCMPT) + (size_t)(b * 2 + g) * 64 * 256; cx.ldv = 256; cx.kgain = nullptr;
    { const float gt[2] = {gates[0][0], gates[0][1]}; attn_branch<0>(cx, qf, qt, 0ull, nomask, of, gt, lds, mrow, ilrow); }
    attn_cmp_probs(cx, qf, mrow, ilrow, lds);
    {
        const LAS float* PS = (const LAS float*)(lds + AT_PS);
        LAS unsigned long long* MK = (LAS unsigned long long*)(lds + AT_MASK);
        for (int ti = 0; ti < 8; ++ti) {
            const int tl = wave * 8 + ti, tp = t0 + tl, jcur = tp >> 6, j = lane;
            float imp = 0.f;
#pragma unroll
            for (int e = -1; e < 4; ++e) { const int c = 4 * j + e; if (c >= 0 && c < 255) imp += PS[tl * 256 + c]; }
            const bool forced = (j == 0) || (j == jcur) || (j == jcur - 1);
            imp = (64 * j <= tp) ? (imp + (forced ? 1000.0f : 0.f)) : -1.0f;
            int cnt = 0;
#pragma unroll 4
            for (int i = 0; i < 64; ++i) {
                const float vi = __builtin_bit_cast(float, __builtin_amdgcn_readlane(__builtin_bit_cast(int, imp), i));
                cnt += (vi > imp || (vi == imp && i < j)) ? 1 : 0;
            }
            const unsigned long long mk = __ballot(cnt < 8);
            if (lane == 0) MK[tl] = mk;
        }
    }
    __syncthreads();
    unsigned long long selu = 0ull, selm[2];
    {
        const LAS unsigned long long* MK = (const LAS unsigned long long*)(lds + AT_MASK);
#pragma unroll 4
        for (int i = 0; i < 64; ++i) selu |= MK[i];
        selm[0] = MK[wave * 8 + (l16 >> 2)]; selm[1] = MK[wave * 8 + 4 + (l16 >> 2)];
    }
    float md[2], ild[2];
    cx.ksrc = (const bf16_t*)(ws + WS_KV) + (size_t)b * SEQ * 768 + 256 + g * 64; cx.ldk = 768;
    cx.vsrc = (const bf16_t*)(ws + WS_VST) + (size_t)(b * 2 + g) * 64 * 4096; cx.ldv = 4096; cx.kgain = p.qk_gain + (layer * 4 + 2) * 64;
    { const float gt[2] = {gates[1][0], gates[1][1]}; attn_branch<1>(cx, qf, qt, selu, selm, of, gt, lds, md, ild); }
    cx.ksrc = (const bf16_t*)(ws + WS_KV) + (size_t)b * SEQ * 768 + 512 + g * 64; cx.ldk = 768;
    cx.vsrc = (const bf16_t*)(ws + WS_VWT) + (size_t)(b * 2 + g) * 64 * 4096; cx.ldv = 4096; cx.kgain = p.qk_gain + (layer * 4 + 3) * 64;
    { const float gt[2] = {gates[2][0], gates[2][1]}; attn_branch<2>(cx, qf, qt, 0ull, nomask, of, gt, lds, md, ild); }
#pragma unroll
    for (int mi = 0; mi < 2; ++mi) {
        bf16_t* op = nq + ((size_t)b * SEQ + cx.tpos[mi]) * 512 + g * 256 + cx.h * 64 + quad * 4;
#pragma unroll
        for (int di = 0; di < 4; ++di) { u32x2 w; w.x = cvt_pk_bf16(of[mi][di][0], of[mi][di][1]); w.y = cvt_pk_bf16(of[mi][di][2], of[mi][di][3]); *(u32x2*)(op + di * 16) = w; }
    }
}

#define XB_TMO      128
#define XB_XCNT(j)  (256  + 64 * (j))
#define XB_XSUB(j)  (1280 + 64 * (j))
#define XB_XGEN(j)  (2304 + 64 * (j))
#define XB_TOP      3328
#define XB_TOPGEN   3392
#define XCD_BAR_WORDS 3456
#define XB_SPIN_CAP (1u << 18)

__device__ __forceinline__ unsigned xb_ld(unsigned* p)              { return __hip_atomic_load(p, __ATOMIC_RELAXED, __HIP_MEMORY_SCOPE_AGENT); }
__device__ __forceinline__ unsigned xb_add(unsigned* p, unsigned v) { return __hip_atomic_fetch_add(p, v, __ATOMIC_RELAXED, __HIP_MEMORY_SCOPE_AGENT); }
__device__ __forceinline__ unsigned xb_xcc_id() { return (unsigned)__builtin_amdgcn_s_getreg((3 << 11) | 20) & 0xFu; }
#define XB_SPIN(cond, bar) do { unsigned _sp = 0; while (cond) { __builtin_amdgcn_s_sleep(1); \
    if ((++_sp & 255u) == 0u) { if (xb_ld(&(bar)[XB_TMO])) break; if (_sp > XB_SPIN_CAP) { atomicAdd(&(bar)[XB_TMO], 1u); break; } } } } while (0)

struct XcdBarrier {
    unsigned* bar; unsigned x;
    volatile LAS unsigned* st;
};

__device__ __forceinline__ XcdBarrier xcd_barrier_post(unsigned* bar, volatile LAS unsigned* st) {
    XcdBarrier b; b.bar = bar; b.x = xb_xcc_id(); b.st = st;
    if (threadIdx.x == 0) (void)xb_add(&bar[XB_XCNT(b.x)], 1u);
    return b;
}
__device__ __forceinline__ void xcd_barrier_complete(unsigned* bar, unsigned x, unsigned& nloc, unsigned& nx) {
    const unsigned G = gridDim.x * gridDim.y * gridDim.z;
    unsigned sum, cnt, mine, sp = 0u;
    for (;;) {
        sum = 0u; cnt = 0u; mine = 0u;
#pragma unroll
        for (unsigned j = 0; j < 16; ++j) { const unsigned c = xb_ld(&bar[XB_XCNT(j)]); sum += c; cnt += (c > 0u) ? 1u : 0u; mine = (j == x) ? c : mine; }
        if (sum == G) break;
        __builtin_amdgcn_s_sleep(1);
        if ((++sp & 255u) == 0u) { if (xb_ld(&bar[XB_TMO])) break; if (sp > XB_SPIN_CAP) { atomicAdd(&bar[XB_TMO], 1u); break; } }
    }
    nloc = mine > 0u ? mine : 1u; nx = cnt > 0u ? cnt : 1u;
}

__device__ __forceinline__ void xcd_barrier(const XcdBarrier& b) {
    asm volatile("s_waitcnt vmcnt(0)" ::: "memory");
    __syncthreads();
    if (tid_opaque() == 0) {
        unsigned* bar = b.bar;
        __builtin_amdgcn_s_waitcnt(0);
        unsigned nloc = b.st[0], nx = b.st[1];
        if (nloc == 0u) { xcd_barrier_complete(bar, b.x, nloc, nx); b.st[0] = nloc; b.st[1] = nx; }
        const unsigned old = xb_add(&bar[XB_XSUB(b.x)], 1u);
        const unsigned gen = old / nloc;
        if (old + 1u == (gen + 1u) * nloc) {
            __builtin_amdgcn_fence(__ATOMIC_RELEASE, "agent");
            asm volatile("s_waitcnt vmcnt(0)" ::: "memory");
            const unsigned og = xb_add(&bar[XB_TOP], 1u);
            const unsigned tg = og / nx;
            if (og + 1u == (tg + 1u) * nx) xb_add(&bar[XB_TOPGEN], 1u);
            else XB_SPIN(xb_ld(&bar[XB_TOPGEN]) == tg, bar);
            __builtin_amdgcn_fence(__ATOMIC_ACQUIRE, "agent");
            xb_add(&bar[XB_XGEN(b.x)], 1u);
            asm volatile("s_waitcnt vmcnt(0)" ::: "memory");
        } else {
            XB_SPIN(xb_ld(&bar[XB_XGEN(b.x)]) == gen, bar);
            __builtin_amdgcn_fence(__ATOMIC_ACQUIRE, "agent");
            asm volatile("s_waitcnt vmcnt(0)" ::: "memory");
        }
    }
    __syncthreads();
}


#ifndef ST_MASK
#define ST_MASK 0xff
#endif
#define ST_ON(k) ((ST_MASK >> (k)) & 1)
__global__ void __launch_bounds__(512, 2) fwd_kernel(Params pin) {
    extern __shared__ __attribute__((aligned(16))) unsigned char lds_raw[];
    LAS unsigned char* lds = (LAS unsigned char*)lds_raw;
    cg::grid_group grid = cg::this_grid();
    volatile LAS unsigned* bar_st = (volatile LAS unsigned*)(lds + 140000);
    if (threadIdx.x == 0) { bar_st[0] = 0u; bar_st[1] = 0u; }
    __syncthreads();
    const XcdBarrier xbar = xcd_barrier_post((unsigned*)pin.ws, bar_st);
    const int G = gridDim.x;
    for (int ph = pin.ph_lo; ph < pin.ph_hi; ++ph) {
        Params p = pin;
        asm volatile("" : "+s"(p.x), "+s"(p.rel_bias), "+s"(p.lb_logits), "+s"(p.norm_mix), "+s"(p.w_in), "+s"(p.hg_gain), "+s"(p.qk_gain));
        asm volatile("" : "+s"(p.cmp_pos), "+s"(p.cmp_w1), "+s"(p.cmp_b1), "+s"(p.cmp_w2), "+s"(p.w_a), "+s"(p.w_b), "+s"(p.w_out));
        asm volatile("" : "+s"(p.norm_mlp), "+s"(p.w_up), "+s"(p.w_down), "+s"(p.out), "+s"(p.ws));
        unsigned char* ws = p.ws;
        const int bx = bid_opaque();

#ifndef NO_PRO
        if (ph == 0) { prologue(p, lds);
#ifdef DUP_MISC
            __syncthreads(); prologue(p, lds);
#endif
#ifdef DIAG_S00
            if (bx == 0 && threadIdx.x == 0) *(unsigned*)(ws + 512) = 0x7f000000u;
#endif
        }
#else
        if (ph == 0) {}
#endif

#ifdef DIAG_S00
        else if (ph == 15) { if (bx == 0 && threadIdx.x == 0) { const float v = __uint_as_float(__hip_atomic_load((unsigned*)(ws + 512), __ATOMIC_RELAXED, __HIP_MEMORY_SCOPE_AGENT)); p.out[0] += 1000.0f * v + 5.0f; } }
#endif
        else {
            const int layer = (ph - 1) / 7, st = (ph - 1) % 7;
            float* sumsq = (float*)(ws + WS_SUMSQ);
            bf16_t* xb = (bf16_t*)(ws + WS_XB);
            if (st == 0 && ST_ON(0)) {
                pg8::Gemm g{xb, (const bf16_t*)(ws + WS_WIN) + (size_t)layer * NP_IN * DM, T_TOK, NP_IN, DM}; pg8::StaticOrder S; S.init(T_TOK, NP_IN, G, bx);
                pg8::EpiIn E{sumsq, (bf16_t*)(ws + WS_HQ), (bf16_t*)(ws + WS_NQ), (bf16_t*)(ws + WS_KV), (bf16_t*)(ws + WS_NG), (bf16_t*)(ws + WS_SGA), (bf16_t*)(ws + WS_VST), (bf16_t*)(ws + WS_VWT)};
                pg8::gemm_phase<pg8::EpiIn, pg8::StaticOrder, true, true>(lds, g, S, E);
#ifdef DUP_G1
                __syncthreads(); pg8::gemm_phase<pg8::EpiIn, pg8::StaticOrder, true, true>(lds, g, S, E);
#endif
                if (layer == 0) {
                    __syncthreads();
                    const float* EH = (const float*)(ws + WS_EX + EX_H);
                    exact_stage(p.w_in, p.w_in, 99, DM, IN_COLS, (float*)(ws + WS_EX + EX_PP), [=](int r, int k) { return EH[r * 1024 + k]; }, lds);
                }
            } else if (st == 1 && ST_ON(1)) {
                {
                    const int x = bx & 7, i = bx >> 3;
                    const int unit = ((x * 8 + (i >> 2)) << 2) | (i & 3);

#ifndef NO_HGRN
                    if (bx < 256) hgrn_unit(p, layer, unit, lds);
#ifdef DUP_HGRN
                    if (bx < 256) hgrn_unit(p, layer, unit, lds);
#endif
#endif

                }

#ifndef NO_CMP
                for (int u = bx; u < 256; u += G) cmp_unit(p, layer, u, lds);
#ifdef DUP_MISC
                for (int u = bx; u < 256; u += G) cmp_unit(p, layer, u, lds);
#endif
#endif
                if (layer == 0 && bx < 16) exact_mixers(p, bx, lds);

            } else if (st == 2 && ST_ON(2)) {
                hgrn_finalize(p, layer);
#ifdef DUP_MISC
                hgrn_finalize(p, layer);
#endif
                {
                    const int x = bx & 7, i = bx >> 3;
#ifdef DUP_ATTN
                    for (int r2 = 0; r2 < 16; ++r2) { const int r = r2 & 7;
#else
                    for (int r = 0; r < 8; ++r) {
#endif
                        const int pair = x * 4 + (r >> 1);
                        const int qt = (r & 1) ? (63 - i) : i;

#ifndef NO_ATTN
                        attn_unit(p, layer, pair >> 1, pair & 1, qt, lds);
#endif

                    }
                }
                if (layer == 0) {
                    __syncthreads();
                    const float* OAB = (const float*)(ws + WS_EX + EX_OAB);
                    exact_stage(p.w_a, p.w_b, 2, 1024, DM, (float*)(ws + WS_EX + EX_YP), [=](int r, int k) { return OAB[r * 1024 + k]; }, lds);
                }
            } else if (st == 3 && ST_ON(3)) {
                {
                    pg8::Gemm g{(const bf16_t*)(ws + WS_HI), (const bf16_t*)(ws + WS_WA) + (size_t)layer * DM * 512, T_TOK, DM, 512}; pg8::StaticOrder S; S.init(T_TOK, DM, G, bx);
                    pg8::EpiMix<false> E{(const bf16_t*)(ws + WS_SGA), (bf16_t*)(ws + WS_MIXED)};
                    pg8::gemm_phase<pg8::EpiMix<false>, pg8::StaticOrder, true, true>(lds, g, S, E);
                }
                __syncthreads();
                {
                    pg8::Gemm g{(const bf16_t*)(ws + WS_NQ), (const bf16_t*)(ws + WS_WB) + (size_t)layer * DM * 512, T_TOK, DM, 512}; pg8::StaticOrder S; S.init(T_TOK, DM, G, bx);
                    pg8::EpiMix<true> E{(const bf16_t*)(ws + WS_SGB), (bf16_t*)(ws + WS_MIXED)};
                    pg8::gemm_phase<pg8::EpiMix<true>, pg8::StaticOrder, true, true>(lds, g, S, E);
                }
                if (layer == 0) {
                    __syncthreads();
                    const float* PP = (const float*)(ws + WS_EX + EX_PP); const float* YP = (const float*)(ws + WS_EX + EX_YP);
                    exact_stage(p.w_out, p.w_out, 99, DM, DM, (float*)(ws + WS_EX + EX_XP), [=](int r, int k) {
                        const float ga = ex_pp(PP, r, 3352 + k), gb = ex_pp(PP, r, 4376 + k);
                        const float ya = YP[(size_t)r * 1024 + k] + YP[(size_t)(16 + r) * 1024 + k], yb = YP[(size_t)(32 + r) * 1024 + k] + YP[(size_t)(48 + r) * 1024 + k];
                        return ya / (1.0f + __expf(-ga)) + yb / (1.0f + __expf(-gb)); }, lds);
                }
            } else if ((st == 4 || st == 6) && ST_ON(4)) {
                const bool down = (st == 6);
                pg8::Gemm g{down ? (const bf16_t*)(ws + WS_HID) : (const bf16_t*)(ws + WS_MIXED),
                            down ? (const bf16_t*)(ws + WS_WDN) + (size_t)layer * DM * DFF : (const bf16_t*)(ws + WS_WO) + (size_t)layer * DM * DM, T_TOK, DM, down ? DFF : DM};
                pg8::StaticOrder S; S.init(T_TOK, DM, G, bx);
                pg8::EpiRes E{p.out, xb, sumsq, down && layer == 1};
                pg8::gemm_phase<pg8::EpiRes, pg8::StaticOrder, true, true>(lds, g, S, E);
                if (layer == 0 && !down) {
                    __syncthreads();
                    LAS float* RS = (LAS float*)(lds + 16384); LAS float* red = (LAS float*)(lds + 32768);
                    const int tid2 = threadIdx.x;
#pragma unroll 1
                    for (int r = 0; r < ((bx < 32) ? 16 : 0); ++r) {
                        const float a = ex_x1(p, r, tid2), b2 = ex_x1(p, r, 512 + tid2);
                        const float ss = block_sum(a * a + b2 * b2, red, tid2);
                        if (tid2 == 0) RS[r] = rsqrtf(ss * (1.0f / 1024.0f) + 1e-6f);
                    }
                    __syncthreads();
                    const Params pc = p; const float* nm2 = p.norm_mlp;
                    exact_stage(p.w_up, p.w_up, 99, DM, DFF, (float*)(ws + WS_EX + EX_UP), [=](int r, int k) { return ex_x1(pc, r, k) * RS[r] * nm2[k]; }, lds);
                }
            } else if (st == 5 && ST_ON(5)) {
                pg8::Gemm g{xb, (const bf16_t*)(ws + WS_WUP) + (size_t)layer * DFF * DM, T_TOK, DFF, DM}; pg8::StaticOrder S; S.init(T_TOK, DFF, G, bx);
                pg8::EpiUp E{sumsq, (bf16_t*)(ws + WS_HID)};
                pg8::gemm_phase<pg8::EpiUp, pg8::StaticOrder, true, true>(lds, g, S, E);
#ifdef DUP_G4
                __syncthreads(); pg8::gemm_phase<pg8::EpiUp, pg8::StaticOrder, true, true>(lds, g, S, E);
#endif
                if (layer == 0) {
                    __syncthreads();
                    const float* UP = (const float*)(ws + WS_EX + EX_UP);
                    exact_stage(p.w_down, p.w_down, 99, DFF, DM, (float*)(ws + WS_EX + EX_DP), [=](int r, int k) {
                        const float u = (UP[(size_t)r * DFF + k] + UP[(size_t)(16 + r) * DFF + k]) + (UP[(size_t)(32 + r) * DFF + k] + UP[(size_t)(48 + r) * DFF + k]);
                        const float t = fmaxf(u, 0.f); return t * t; }, lds);
                }
            }
        }
        if (ph + 1 < pin.ph_hi) {
            if (ph == pin.ph_lo) {
                asm volatile("s_waitcnt vmcnt(0) lgkmcnt(0)" ::: "memory");
                grid.sync();
                __builtin_amdgcn_fence(__ATOMIC_ACQUIRE, "agent");
                asm volatile("s_waitcnt vmcnt(0)" ::: "memory");
            } else {
                xcd_barrier(xbar);
#ifdef DUP_SYNC
                xcd_barrier(xbar); xcd_barrier(xbar);
#endif
            }
        }
    }
}

#ifdef DIAG_S00
constexpr int N_PHASES = 16;
#else
constexpr int N_PHASES = 15;
#endif
#ifndef ONE_LAUNCH
#define ONE_LAUNCH 1
#endif

extern "C" void kernel_launch(void* const* d_in, const int* in_sizes, int n_in, void* d_out, int out_size, void* d_ws, size_t ws_size, hipStream_t stream) {
    static int ready = 0;
    if (ready == 0) {
        if (n_in != 17 || out_size != T_TOK * DM || ws_size < WS_END) { fprintf(stderr, "kernel_launch: unexpected shapes: n_in %d out %d ws %zu (need %zu)\n", n_in, out_size, ws_size, (size_t)WS_END); ready = -1; return; }
        if (hipFuncSetAttribute((const void*)fwd_kernel, hipFuncAttributeMaxDynamicSharedMemorySize, LDS_BYTES) != hipSuccess) { fprintf(stderr, "kernel_launch: hipFuncSetAttribute failed\n"); ready = -1; return; }
        int per_cu = 0;
        if (hipOccupancyMaxActiveBlocksPerMultiprocessor(&per_cu, (const void*)fwd_kernel, 512, LDS_BYTES) != hipSuccess || per_cu < 1) fprintf(stderr, "kernel_launch: occupancy query says %d blocks per CU\n", per_cu);
        (void)hipGetLastError();
        ready = 1;
    }
    if (ready < 0) return;
    Params p{};
    p.x = (const float*)d_in[0]; p.rel_bias = (const float*)d_in[1]; p.lb_logits = (const float*)d_in[2]; p.norm_mix = (const float*)d_in[3]; p.w_in = (const float*)d_in[4];
    p.hg_gain = (const float*)d_in[5]; p.qk_gain = (const float*)d_in[6]; p.cmp_pos = (const float*)d_in[7]; p.cmp_w1 = (const float*)d_in[8]; p.cmp_b1 = (const float*)d_in[9];
    p.cmp_w2 = (const float*)d_in[10]; p.w_a = (const float*)d_in[11]; p.w_b = (const float*)d_in[12]; p.w_out = (const float*)d_in[13]; p.norm_mlp = (const float*)d_in[14];
    p.w_up = (const float*)d_in[15]; p.w_down = (const float*)d_in[16];
    p.out = (float*)d_out; p.ws = (unsigned char*)d_ws;
    if (hipMemsetAsync(d_ws, 0, 16384, stream) != hipSuccess) { fprintf(stderr, "kernel_launch: hipMemsetAsync failed\n"); return; }
#if ONE_LAUNCH
    p.ph_lo = 0; p.ph_hi = N_PHASES;
    void* args[] = {&p};
    hipError_t e = hipLaunchCooperativeKernel((const void*)fwd_kernel, dim3(256), dim3(512), args, LDS_BYTES, stream);
    if (e != hipSuccess) fprintf(stderr, "kernel_launch: cooperative launch failed: %s\n", hipGetErrorString(e));
#else
    for (int ph = 0; ph < N_PHASES; ++ph) {
        p.ph_lo = ph; p.ph_hi = ph + 1;
        hipLaunchKernelGGL(fwd_kernel, dim3(256), dim3(512), LDS_BYTES, stream, p);
    }
#endif
}
```

```cpp
#include <hip/hip_runtime.h>
#include <hip/hip_cooperative_groups.h>
#include <cstdio>
#include <cstdint>
namespace cg = cooperative_groups;
namespace pg8 {
#define PG8_LAS __attribute__((address_space(3)))
typedef unsigned short bf16_t;
typedef short bf16x8 __attribute__((ext_vector_type(8)));
typedef float f32x4 __attribute__((ext_vector_type(4)));
typedef unsigned u32x4 __attribute__((ext_vector_type(4)));
constexpr int BM = 256, BK = 64, HALF = 128, HTB = HALF * BK * 2  , STAGE_BYTES = 8 * HTB, NXCD = 8, WGM = 8;

__host__ __device__ __forceinline__ int lds_byte(int r, int c) { const int st = (r >> 4) * 2 + (c >> 5), rr = r & 15, cc = c & 31, ob = rr * 64 + cc * 2; return st * 1024 + (ob ^ (((ob >> 9) & 1) << 5)); }
__host__ __device__ __forceinline__ void stage_rc(int b, int& R, int& C) { const int st = b / 1024, sb = b % 1024, swz = sb ^ (((sb >> 9) & 1) << 5); R = (st >> 1) * 16 + swz / 64; C = (st & 1) * 32 + (swz % 64) / 2; }
__host__ __device__ __forceinline__ int perm32(int rho) { const int n = rho >> 4, i = rho & 15; return 8 * (i >> 2) + 4 * n + (i & 3); }

struct Unit { int pm, pn; };
struct Gemm { const bf16_t* A; const bf16_t* Bt; int M, N, K; };

struct StaticOrder {
    int nM, nN, nwg, G, c;
    __host__ __device__ void init(int M, int N, int G_, int c_) { nM = M / BM; nN = N / BM; nwg = nM * nN; G = G_; c = c_; }
    __host__ __device__ bool next(int i, Unit& u) const {
        const long L = (long)i * G + c; if (L >= nwg) return false;
        int wgid = (int)L; { const int q = nwg / NXCD, r = nwg % NXCD, xcd = wgid % NXCD, off = wgid / NXCD; wgid = (xcd < r ? xcd * (q + 1) : r * (q + 1) + (xcd - r) * q) + off; }
        const int nig = WGM * nN, gid = wgid / nig, fm = gid * WGM, gsz = (nM - fm) < WGM ? (nM - fm) : WGM;
        u.pm = fm + ((wgid % nig) % gsz); u.pn = (wgid % nig) / gsz; return true;
    }
    __device__ __forceinline__ void a_ready(const Unit&) const {}
    __device__ __forceinline__ void done(const Unit&) const {}
};

typedef float f32x2c __attribute__((ext_vector_type(2)));
typedef __bf16 bf16x2c __attribute__((ext_vector_type(2)));
__device__ __forceinline__ unsigned cvt_pk_bf16(float lo, float hi) { const f32x2c v = {lo, hi}; const bf16x2c b = __builtin_convertvector(v, bf16x2c); return __builtin_bit_cast(unsigned, b); }
__device__ __forceinline__ float bf_lo(unsigned w) { return __uint_as_float(w << 16); }
__device__ __forceinline__ float bf_hi(unsigned w) { return __uint_as_float(w & 0xffff0000u); }
__device__ __forceinline__ float sigm(float v) { return __builtin_amdgcn_rcpf(1.0f + __expf(-v)); }

__device__ __forceinline__ void row_rstd8(const float* sumsq, const Unit& u, int wr, int fr, int fq, float (&rs)[2][4]) {
#pragma unroll
    for (int ai = 0; ai < 2; ++ai)
#pragma unroll
        for (int m = 0; m < 4; ++m) {
            const int row = u.pm * BM + ai * HALF + wr * 64 + m * 16 + fr;
            const f32x4 v = *(const f32x4*)(sumsq + (size_t)row * 16 + fq * 4);
            float s = (v[0] + v[1]) + (v[2] + v[3]);
            s += __shfl_xor(s, 16); s += __shfl_xor(s, 32);
            rs[ai][m] = rsqrtf(s * (1.0f / 1024.0f) + 1e-6f);
            if (m == 3) asm volatile("" ::: "memory");
        }
}

struct EpiIn {
    static constexpr bool PERM = true, AFTER_DRAIN = false;
    const float* sumsq; bf16_t *HQ, *NQ, *KV, *NG, *SGA, *VST, *VWT;
    __device__ __forceinline__ void operator()(const f32x4 (&acc)[2][2][4][2], const Unit& u, int wr, int wc, int fr, int fq) const {
        float rs[2][4]; row_rstd8(sumsq, u, wr, fr, fq, rs);
        const int pn = u.pn; bf16_t* base; int ldc, colt; bool sg = false;
        if (pn < 8) { base = HQ + (size_t)(pn >> 1) * ((size_t)65536 * 512); ldc = 512; colt = (pn & 1) * 256; }
        else if (pn < 10) { base = NQ; ldc = 512; colt = (pn - 8) * 256; }
        else if (pn < 13) { base = KV; ldc = 768; colt = (pn - 10) * 256; }
        else if (pn == 13) { base = NG; ldc = 256; colt = 0; sg = true; }
        else { const int q = pn - 14; base = SGA + (size_t)(q >> 2) * ((size_t)65536 * 1024); ldc = 1024; colt = (q & 3) * 256; sg = true; }
        const int col0 = colt + wc * 32 + 8 * fq;
        bf16_t* vt = (pn == 11) ? VST : ((pn == 12) ? VWT : nullptr);
#pragma unroll
        for (int ai = 0; ai < 2; ++ai)
#pragma unroll
            for (int m = 0; m < 4; ++m) {
                const int row = u.pm * BM + ai * HALF + wr * 64 + m * 16 + fr;
                bf16_t* rowp = base + (size_t)row * ldc + col0; const float r = rs[ai][m];
#pragma unroll
                for (int bj = 0; bj < 2; ++bj) {
                    f32x4 v0 = acc[ai][bj][m][0] * r, v1 = acc[ai][bj][m][1] * r;
                    if (sg) {
#pragma unroll
                        for (int e = 0; e < 4; ++e) { v0[e] = sigm(v0[e]); v1[e] = sigm(v1[e]); }
                    }
                    u32x4 w; w.x = cvt_pk_bf16(v0[0], v0[1]); w.y = cvt_pk_bf16(v0[2], v0[3]); w.z = cvt_pk_bf16(v1[0], v1[1]); w.w = cvt_pk_bf16(v1[2], v1[3]);
                    *(u32x4*)(rowp + bj * HALF) = w;
                    if (vt != nullptr && bj == 1) {
                        const int cv = wc * 32 + 8 * fq, g = cv >> 6, d0 = cv & 63, b = row >> 12, t = row & 4095;
                        bf16_t* tp = vt + (((size_t)(b * 2 + g) * 64 + d0) << 12) + t;
                        tp[0 * 4096] = (bf16_t)(w.x & 0xffffu); tp[1 * 4096] = (bf16_t)(w.x >> 16); tp[2 * 4096] = (bf16_t)(w.y & 0xffffu); tp[3 * 4096] = (bf16_t)(w.y >> 16);
                        tp[4 * 4096] = (bf16_t)(w.z & 0xffffu); tp[5 * 4096] = (bf16_t)(w.z >> 16); tp[6 * 4096] = (bf16_t)(w.w & 0xffffu); tp[7 * 4096] = (bf16_t)(w.w >> 16);
                    }
                }
                asm volatile("" ::: "memory");
            }
    }
};

template <bool ACCUM> struct EpiMix {
    static constexpr bool PERM = true, AFTER_DRAIN = false;
    const bf16_t* gate; bf16_t* mixed;
    __device__ __forceinline__ void operator()(const f32x4 (&acc)[2][2][4][2], const Unit& u, int wr, int wc, int fr, int fq) const {
        const int col0 = u.pn * BM + wc * 32 + 8 * fq;
#pragma unroll
        for (int ai = 0; ai < 2; ++ai)
#pragma unroll
            for (int m = 0; m < 4; ++m) {
                const size_t off = (size_t)(u.pm * BM + ai * HALF + wr * 64 + m * 16 + fr) * 1024 + col0;
#pragma unroll
                for (int bj = 0; bj < 2; ++bj) {
                    const u32x4 gq = *(const u32x4*)(gate + off + bj * HALF);
                    f32x4 v0 = acc[ai][bj][m][0], v1 = acc[ai][bj][m][1];
                    v0[0] *= bf_lo(gq.x); v0[1] *= bf_hi(gq.x); v0[2] *= bf_lo(gq.y); v0[3] *= bf_hi(gq.y);
                    v1[0] *= bf_lo(gq.z); v1[1] *= bf_hi(gq.z); v1[2] *= bf_lo(gq.w); v1[3] *= bf_hi(gq.w);
                    if (ACCUM) {
                        const u32x4 mq = *(const u32x4*)(mixed + off + bj * HALF);
                        v0[0] += bf_lo(mq.x); v0[1] += bf_hi(mq.x); v0[2] += bf_lo(mq.y); v0[3] += bf_hi(mq.y);
                        v1[0] += bf_lo(mq.z); v1[1] += bf_hi(mq.z); v1[2] += bf_lo(mq.w); v1[3] += bf_hi(mq.w);
                    }
                    u32x4 w; w.x = cvt_pk_bf16(v0[0], v0[1]); w.y = cvt_pk_bf16(v0[2], v0[3]); w.z = cvt_pk_bf16(v1[0], v1[1]); w.w = cvt_pk_bf16(v1[2], v1[3]);
                    *(u32x4*)(mixed + off + bj * HALF) = w;
                }
                asm volatile("" ::: "memory");
            }
    }
};

struct EpiRes {
    static constexpr bool PERM = true, AFTER_DRAIN = false;
    float* out; bf16_t* xb; float* sumsq; bool FINAL;
    __device__ __forceinline__ void operator()(const f32x4 (&acc)[2][2][4][2], const Unit& u, int wr, int wc, int fr, int fq) const {
        const int col0 = u.pn * BM + wc * 32 + 8 * fq;
#pragma unroll
        for (int ai = 0; ai < 2; ++ai)
#pragma unroll
            for (int m = 0; m < 4; ++m) {
                const int row = u.pm * BM + ai * HALF + wr * 64 + m * 16 + fr;
                const size_t off = (size_t)row * 1024 + col0; float ss = 0.f;
#pragma unroll
                for (int bj = 0; bj < 2; ++bj) {
                    const u32x4 xq = *(const u32x4*)(xb + off + bj * HALF);
                    f32x4 v0 = acc[ai][bj][m][0], v1 = acc[ai][bj][m][1];
                    v0[0] += bf_lo(xq.x); v0[1] += bf_hi(xq.x); v0[2] += bf_lo(xq.y); v0[3] += bf_hi(xq.y);
                    v1[0] += bf_lo(xq.z); v1[1] += bf_hi(xq.z); v1[2] += bf_lo(xq.w); v1[3] += bf_hi(xq.w);
                    if (FINAL) { *(f32x4*)(out + off + bj * HALF) = v0; *(f32x4*)(out + off + bj * HALF + 4) = v1; }
                    else {
                        u32x4 w; w.x = cvt_pk_bf16(v0[0], v0[1]); w.y = cvt_pk_bf16(v0[2], v0[3]); w.z = cvt_pk_bf16(v1[0], v1[1]); w.w = cvt_pk_bf16(v1[2], v1[3]);
                        *(u32x4*)(xb + off + bj * HALF) = w;
                        ss += (v0[0] * v0[0] + v0[1] * v0[1]) + (v0[2] * v0[2] + v0[3] * v0[3]) + (v1[0] * v1[0] + v1[1] * v1[1]) + (v1[2] * v1[2] + v1[3] * v1[3]);
                    }
                }
                if (!FINAL) { ss += __shfl_xor(ss, 16); ss += __shfl_xor(ss, 32); if (fq == 0) sumsq[(size_t)row * 16 + u.pn * 4 + wc] = ss; }
                asm volatile("" ::: "memory");
            }
    }
};

struct EpiUp {
    static constexpr bool PERM = true, AFTER_DRAIN = false;
    const float* sumsq; bf16_t* hid;
    __device__ __forceinline__ void operator()(const f32x4 (&acc)[2][2][4][2], const Unit& u, int wr, int wc, int fr, int fq) const {
        float rs[2][4]; row_rstd8(sumsq, u, wr, fr, fq, rs);
        const int col0 = u.pn * BM + wc * 32 + 8 * fq;
#pragma unroll
        for (int ai = 0; ai < 2; ++ai)
#pragma unroll
            for (int m = 0; m < 4; ++m) {
                bf16_t* rowp = hid + (size_t)(u.pm * BM + ai * HALF + wr * 64 + m * 16 + fr) * 4096 + col0; const float r = rs[ai][m];
#pragma unroll
                for (int bj = 0; bj < 2; ++bj) {
                    f32x4 v0 = acc[ai][bj][m][0] * r, v1 = acc[ai][bj][m][1] * r;
#pragma unroll
                    for (int e = 0; e < 4; ++e) { const float a = fmaxf(v0[e], 0.f), b = fmaxf(v1[e], 0.f); v0[e] = a * a; v1[e] = b * b; }
                    u32x4 w; w.x = cvt_pk_bf16(v0[0], v0[1]); w.y = cvt_pk_bf16(v0[2], v0[3]); w.z = cvt_pk_bf16(v1[0], v1[1]); w.w = cvt_pk_bf16(v1[2], v1[3]);
                    *(u32x4*)(rowp + bj * HALF) = w;
                }
                asm volatile("" ::: "memory");
            }
    }
};

template <class Epi, class Sched, bool ALIGN_EPI = false, bool SP2 = false>
__device__ __forceinline__ void gemm_phase(PG8_LAS unsigned char* lds, const Gemm g, const Sched& S, const Epi& E) {
    int tid_ = threadIdx.x; asm volatile("" : "+v"(tid_));
    const int tid = tid_, wid = __builtin_amdgcn_readfirstlane(tid >> 6), lane = tid & 63, wr = wid >> 2, wc = wid & 3, fr = lane & 15, fq = lane >> 4;
    const int K = g.K, nt = K / BK;
    unsigned voffA[2], voffB[2];
#pragma unroll
    for (int i = 0; i < 2; ++i) { int R, C; stage_rc(tid * 16 + i * 8192, R, C); const int Rb = Epi::PERM ? ((R & ~31) + perm32(R & 31)) : R;
        voffA[i] = (unsigned)(R * K + C) * 2u; voffB[i] = (unsigned)(Rb * K + C) * 2u; }
    const size_t kstep = (size_t)(BK * 2);
    const size_t hstep = (size_t)HALF * K * 2;
    const size_t tstep = 2 * hstep;
    const unsigned ldsw = (unsigned)wid * 1024u;
    const int aoff = lds_byte(wr * 64 + fr, fq * 8), boff = lds_byte(wc * 32 + fr, fq * 8);
#define PG8_SA(b, h) (((b) * 2 + (h)) * HTB)
#define PG8_SB(b, h) ((4 + (b) * 2 + (h)) * HTB)
#define PG8_STAGE(bufoff, gbase, voff) do { _Pragma("unroll") for (int _i = 0; _i < 2; ++_i) \
        __builtin_amdgcn_global_load_lds((const unsigned*)((const char*)(gbase) + (voff)[_i]), (PG8_LAS unsigned*)(lds + (bufoff) + ldsw + _i * 8192), 16, 0, 0); } while (0)
#define PG8_LDA(dst, b, h) do { _Pragma("unroll") for (int m = 0; m < 4; ++m) _Pragma("unroll") for (int k = 0; k < 2; ++k) dst[m][k] = *(const PG8_LAS bf16x8*)(lds + PG8_SA(b, h) + aoff + m * 2048 + k * 1024); } while (0)
#define PG8_LDB(dst, b, h) do { _Pragma("unroll") for (int n = 0; n < 2; ++n) _Pragma("unroll") for (int k = 0; k < 2; ++k) dst[n][k] = *(const PG8_LAS bf16x8*)(lds + PG8_SB(b, h) + boff + n * 2048 + k * 1024); } while (0)
#define PG8_MMA(ai, bj, At, Bt) do { __builtin_amdgcn_s_setprio(1); _Pragma("unroll") for (int m = 0; m < 4; ++m) _Pragma("unroll") for (int n = 0; n < 2; ++n) _Pragma("unroll") for (int k = 0; k < 2; ++k) \
        acc[ai][bj][m][n] = __builtin_amdgcn_mfma_f32_16x16x32_bf16(Bt[n][k], At[m][k], acc[ai][bj][m][n], 0, 0, 0); __builtin_amdgcn_s_setprio(0); } while (0)
#define PG8_WAIT_V(n) asm volatile("s_waitcnt vmcnt(" #n ")" ::: "memory")
#define PG8_WAIT_L(n) asm volatile("s_waitcnt lgkmcnt(" #n ")" ::: "memory")
#define PG8_BAR __builtin_amdgcn_s_barrier()
#define PG8_SCHED __builtin_amdgcn_sched_barrier(0)
    Unit cur, nxt; int ui = 0;
    if (!S.next(0, cur)) return;
    f32x4 acc[2][2][4][2];
#pragma unroll
    for (int a = 0; a < 2; ++a)
#pragma unroll
        for (int b = 0; b < 2; ++b)
#pragma unroll
            for (int m = 0; m < 4; ++m)
#pragma unroll
                for (int n = 0; n < 2; ++n) acc[a][b][m][n] = (f32x4){0.f, 0.f, 0.f, 0.f};
    bf16x8 At[4][2], B0[2][2], B1[2][2];
    const char* cA = (const char*)g.A + (size_t)cur.pm * tstep; const char* cB = (const char*)g.Bt + (size_t)cur.pn * tstep;
    S.a_ready(cur);
    if constexpr (SP2) {
        PG8_STAGE(PG8_SB(0, 0), cB, voffB); PG8_STAGE(PG8_SB(0, 1), cB + hstep, voffB); PG8_STAGE(PG8_SA(0, 0), cA, voffA); PG8_STAGE(PG8_SA(0, 1), cA + hstep, voffA);
        if (wr == 1) PG8_BAR;
        PG8_WAIT_V(2); PG8_BAR;
        PG8_STAGE(PG8_SB(1, 0), cB + kstep, voffB); PG8_STAGE(PG8_SA(1, 0), cA + kstep, voffA); PG8_STAGE(PG8_SB(1, 1), cB + hstep + kstep, voffB);
        PG8_WAIT_V(6); PG8_BAR;
    } else {
        PG8_STAGE(PG8_SB(0, 0), cB, voffB); PG8_STAGE(PG8_SA(0, 0), cA, voffA); PG8_STAGE(PG8_SB(0, 1), cB + hstep, voffB); PG8_STAGE(PG8_SA(0, 1), cA + hstep, voffA);
        if (wr == 1) PG8_BAR;
        PG8_WAIT_V(4); PG8_BAR;
        PG8_STAGE(PG8_SB(1, 0), cB + kstep, voffB); PG8_STAGE(PG8_SA(1, 0), cA + kstep, voffA); PG8_STAGE(PG8_SB(1, 1), cB + hstep + kstep, voffB);
        PG8_WAIT_V(6); PG8_BAR;
    }
    for (;;) {
        const bool has_next = S.next(ui + 1, nxt);
        const char* nA = has_next ? (const char*)g.A + (size_t)nxt.pm * tstep : cA; const char* nB = has_next ? (const char*)g.Bt + (size_t)nxt.pn * tstep : cB;
        for (int t = 0; t < nt; t += 2) {
            const bool last = (t == nt - 2);
            const char* a1 = cA + (size_t)(t + 1) * kstep;
            const char* a2 = last ? nA : cA + (size_t)(t + 2) * kstep; const char* b2 = last ? nB : cB + (size_t)(t + 2) * kstep;
            const char* a3 = a2 + kstep; const char* b3 = b2 + kstep;
            if (last && has_next) S.a_ready(nxt);
            if constexpr (SP2) {
            PG8_LDB(B0, 0, 0); PG8_LDB(B1, 0, 1); PG8_SCHED; PG8_LDA(At, 0, 0); PG8_STAGE(PG8_SA(1, 1), a1 + hstep, voffA);
            PG8_WAIT_V(8); PG8_WAIT_L(0); PG8_BAR; PG8_MMA(0, 0, At, B0); PG8_MMA(0, 1, At, B1); PG8_BAR; PG8_SCHED;
            PG8_LDA(At, 0, 1); PG8_STAGE(PG8_SB(0, 0), b2, voffB); PG8_STAGE(PG8_SB(0, 1), b2 + hstep, voffB); PG8_STAGE(PG8_SA(0, 0), a2, voffA);
            PG8_WAIT_V(8); PG8_WAIT_L(0); PG8_BAR; PG8_MMA(1, 0, At, B0); PG8_MMA(1, 1, At, B1); PG8_BAR; PG8_SCHED;
            PG8_LDB(B0, 1, 0); PG8_LDB(B1, 1, 1); PG8_SCHED; PG8_LDA(At, 1, 0); PG8_STAGE(PG8_SA(0, 1), a2 + hstep, voffA);
            PG8_WAIT_V(8); PG8_WAIT_L(0); PG8_BAR; PG8_MMA(0, 0, At, B0); PG8_MMA(0, 1, At, B1); PG8_BAR; PG8_SCHED;
            PG8_LDA(At, 1, 1); PG8_STAGE(PG8_SB(1, 0), b3, voffB); PG8_STAGE(PG8_SB(1, 1), b3 + hstep, voffB); PG8_STAGE(PG8_SA(1, 0), a3, voffA);
            PG8_WAIT_V(8); PG8_WAIT_L(0); PG8_BAR; PG8_MMA(1, 0, At, B0); PG8_MMA(1, 1, At, B1); PG8_BAR; PG8_SCHED;
            } else {
            PG8_LDB(B0, 0, 0); PG8_SCHED; PG8_LDA(At, 0, 0); PG8_STAGE(PG8_SA(1, 1), a1 + hstep, voffA);
            PG8_WAIT_L(8); PG8_BAR; PG8_WAIT_L(0); PG8_MMA(0, 0, At, B0); PG8_BAR; PG8_SCHED;
            PG8_LDB(B1, 0, 1); PG8_STAGE(PG8_SB(0, 0), b2, voffB);
            PG8_BAR; PG8_WAIT_L(0); PG8_MMA(0, 1, At, B1); PG8_BAR;
            PG8_LDA(At, 0, 1); PG8_STAGE(PG8_SA(0, 0), a2, voffA);
            PG8_BAR; PG8_WAIT_L(0); PG8_MMA(1, 0, At, B0); PG8_BAR; PG8_SCHED;
            PG8_STAGE(PG8_SB(0, 1), b2 + hstep, voffB);
            PG8_WAIT_V(6); PG8_BAR; PG8_MMA(1, 1, At, B1); PG8_BAR;
            PG8_LDB(B0, 1, 0); PG8_SCHED; PG8_LDA(At, 1, 0); PG8_STAGE(PG8_SA(0, 1), a2 + hstep, voffA);
            PG8_WAIT_L(8); PG8_BAR; PG8_WAIT_L(0); PG8_MMA(0, 0, At, B0); PG8_BAR; PG8_SCHED;
            PG8_LDB(B1, 1, 1); PG8_STAGE(PG8_SB(1, 0), b3, voffB);
            PG8_BAR; PG8_WAIT_L(0); PG8_MMA(0, 1, At, B1); PG8_BAR;
            PG8_LDA(At, 1, 1); PG8_STAGE(PG8_SA(1, 0), a3, voffA);
            PG8_BAR; PG8_WAIT_L(0); PG8_MMA(1, 0, At, B0); PG8_BAR; PG8_SCHED;
            PG8_STAGE(PG8_SB(1, 1), b3 + hstep, voffB);
            PG8_WAIT_V(6); PG8_BAR; PG8_MMA(1, 1, At, B1); PG8_BAR;
            }
        }
        if constexpr (ALIGN_EPI) { if (wr == 0) PG8_BAR; }
        if constexpr (!Epi::AFTER_DRAIN) { E(acc, cur, wr, wc, fr, fq); S.done(cur); }
        if (!has_next) break;
#pragma unroll
        for (int a = 0; a < 2; ++a)
#pragma unroll
            for (int b = 0; b < 2; ++b)
#pragma unroll
                for (int m = 0; m < 4; ++m)
#pragma unroll
                    for (int n = 0; n < 2; ++n) acc[a][b][m][n] = (f32x4){0.f, 0.f, 0.f, 0.f};
        cur = nxt; cA = nA; cB = nB; ++ui;
        if constexpr (ALIGN_EPI) { if (wr == 1) PG8_BAR; }
    }
    PG8_WAIT_V(0);
    if constexpr (!ALIGN_EPI) { if (wr == 0) PG8_BAR; }
    PG8_BAR;
    if constexpr (Epi::AFTER_DRAIN) { E.fused(acc, cur, wr, wc, fr, fq, lds, wid, lane); S.done(cur); }
#undef PG8_SA
#undef PG8_SB
#undef PG8_STAGE
#undef PG8_LDA
#undef PG8_LDB
#undef PG8_MMA
#undef PG8_WAIT_V
#undef PG8_WAIT_L
#undef PG8_BAR
#undef PG8_SCHED
}
}

#define LAS __attribute__((address_space(3)))
typedef unsigned short bf16_t;
typedef short bf16x8 __attribute__((ext_vector_type(8)));
typedef short bf16x4 __attribute__((ext_vector_type(4)));
typedef float f32x4 __attribute__((ext_vector_type(4)));
typedef unsigned u32x4 __attribute__((ext_vector_type(4)));
typedef unsigned u32x2 __attribute__((ext_vector_type(2)));
using pg8::cvt_pk_bf16; using pg8::bf_lo; using pg8::bf_hi; using pg8::sigm;

constexpr int T_TOK = 65536, DM = 1024, SEQ = 4096, NB = 16, DFF = 4096, NP_IN = 5632, IN_COLS = 5400;
constexpr int LDS_BYTES = 147456;
constexpr size_t MiB = (size_t)1 << 20;
constexpr size_t WS_CBIAS = 1 * MiB, WS_CW2T = 1 * MiB + 65536;
constexpr size_t WS_WIN = 2 * MiB, WS_WA = 24 * MiB, WS_WB = 26 * MiB, WS_WO = 28 * MiB, WS_WUP = 32 * MiB, WS_WDN = 48 * MiB, WS_CW1T = 64 * MiB;
constexpr size_t WS_SUMSQ = 66 * MiB, WS_KCMP = 70 * MiB, WS_VCMPT = 71 * MiB, WS_VST = 72 * MiB, WS_VWT = 88 * MiB, WS_XB = 104 * MiB;
constexpr size_t WS_HQ = 232 * MiB, WS_HF = 296 * MiB, WS_HI = 360 * MiB, WS_HG = 424 * MiB, WS_NQ = 488 * MiB, WS_KV = 552 * MiB, WS_NG = 648 * MiB, WS_SGA = 680 * MiB, WS_SGB = 808 * MiB;
constexpr size_t WS_MIXED = 232 * MiB, WS_HID = 232 * MiB, WS_EX = 936 * MiB, WS_TMP = 944 * MiB, WS_END = 1008 * MiB;
constexpr size_t EX_H = 0, EX_PP = 1 * MiB, EX_OAB = 2 * MiB + 524288, EX_YP = EX_OAB + 65536, EX_XP = EX_OAB + 524288, EX_UP = 3 * MiB + 524288, EX_DP = 4 * MiB + 524288;

struct Params {
    const float *x, *rel_bias, *lb_logits, *norm_mix, *w_in, *hg_gain, *qk_gain, *cmp_pos, *cmp_w1, *cmp_b1, *cmp_w2, *w_a, *w_b, *w_out, *norm_mlp, *w_up, *w_down;
    float* out; unsigned char* ws; int ph_lo, ph_hi;
};

__device__ __forceinline__ bf16x8 lds_ld8(const LAS unsigned char* p) { return *(const LAS bf16x8*)p; }
__device__ __forceinline__ bf16x8 lds_ld4x2(const LAS unsigned char* p0, const LAS unsigned char* p1) {
    const bf16x4 a = *(const LAS bf16x4*)p0, b = *(const LAS bf16x4*)p1; bf16x8 r;
    r[0] = a[0]; r[1] = a[1]; r[2] = a[2]; r[3] = a[3]; r[4] = b[0]; r[5] = b[1]; r[6] = b[2]; r[7] = b[3]; return r;
}
__device__ __forceinline__ bf16x8 pack8(const f32x4& a, const f32x4& b) {
    u32x4 w; w.x = cvt_pk_bf16(a[0], a[1]); w.y = cvt_pk_bf16(a[2], a[3]); w.z = cvt_pk_bf16(b[0], b[1]); w.w = cvt_pk_bf16(b[2], b[3]);
    return __builtin_bit_cast(bf16x8, w);
}
__device__ __forceinline__ unsigned short bf1(float v) { return (unsigned short)(cvt_pk_bf16(v, 0.f) & 0xffffu); }
__device__ __forceinline__ float bfu(unsigned short h) { return __uint_as_float(((unsigned)h) << 16); }
__device__ __forceinline__ int tid_opaque() { int t = threadIdx.x; asm volatile("" : "+v"(t)); return t; }
__device__ __forceinline__ int clampi(int v, int lo, int hi) { return v < lo ? lo : (v > hi ? hi : v); }
typedef float f32x2c_t __attribute__((ext_vector_type(2)));
__device__ __forceinline__ int bid_opaque() { int t = blockIdx.x; asm volatile("" : "+s"(t)); return t; }
#define MFMA16(a, b, c) __builtin_amdgcn_mfma_f32_16x16x32_bf16((a), (b), (c), 0, 0, 0)

__device__ __forceinline__ float block_sum(float v, LAS float* red, int tid);
__device__ __forceinline__ void conv_matrix(const float* W, int K, int N, bf16_t* WT, const float* scale, int nshift_from, int nshift, LAS unsigned char* lds) {
    LAS float* tile = (LAS float*)lds;
    const int tid = tid_opaque(), nnb = (N + 63) / 64, items = (K / 64) * nnb;
#pragma unroll 1
    for (int it = blockIdx.x; it < items; it += gridDim.x) {
        const int kb = it / nnb, nb = it % nnb, k0 = kb * 64, n0 = nb * 64;
#pragma unroll
        for (int i = 0; i < 8; ++i) {
            const int k = i * 8 + (tid >> 6), n = tid & 63;
            float v = 0.f;
            if (n0 + n < N) { v = W[(size_t)(k0 + k) * N + n0 + n]; if (scale) v *= scale[k0 + k]; }
            tile[k * 65 + n] = v;
        }
        __syncthreads();
        {
            const int n = tid >> 3, kc = tid & 7;
            if (n0 + n < N) {
                const LAS float* s = tile + (kc * 8) * 65 + n;
                u32x4 o; o.x = cvt_pk_bf16(s[0], s[65]); o.y = cvt_pk_bf16(s[2 * 65], s[3 * 65]); o.z = cvt_pk_bf16(s[4 * 65], s[5 * 65]); o.w = cvt_pk_bf16(s[6 * 65], s[7 * 65]);
                int nn = n0 + n; if (nn >= nshift_from) nn += nshift;
                *(u32x4*)(WT + (size_t)nn * K + k0 + kc * 8) = o;
            }
        }
        __syncthreads();
    }
}

__device__ __forceinline__ void prologue(const Params& p, LAS unsigned char* lds) {
    unsigned char* ws = p.ws;
    const int tid = tid_opaque(), lane = tid & 63, wave = tid >> 6; const int bidx = bid_opaque();
#pragma unroll 1
    for (int mj = 0; mj < 20; ++mj) {
        const int l = mj / 10, m = mj % 10;
        const float* W; int K, N; bf16_t* WT; const float* scale = nullptr; int sfrom = 1 << 30, sh = 0;
        if (m == 0) { W = p.w_in + (size_t)l * DM * IN_COLS; K = DM; N = IN_COLS; WT = (bf16_t*)(ws + WS_WIN) + (size_t)l * NP_IN * DM; scale = p.norm_mix + l * DM; sfrom = 3352; sh = 232; }
        else if (m == 1) { W = p.w_a + (size_t)l * 512 * DM; K = 512; N = DM; WT = (bf16_t*)(ws + WS_WA) + (size_t)l * DM * 512; }
        else if (m == 2) { W = p.w_b + (size_t)l * 512 * DM; K = 512; N = DM; WT = (bf16_t*)(ws + WS_WB) + (size_t)l * DM * 512; }
        else if (m == 3) { W = p.w_out + (size_t)l * DM * DM; K = DM; N = DM; WT = (bf16_t*)(ws + WS_WO) + (size_t)l * DM * DM; }
        else if (m == 4) { W = p.w_up + (size_t)l * DM * DFF; K = DM; N = DFF; WT = (bf16_t*)(ws + WS_WUP) + (size_t)l * DFF * DM; scale = p.norm_mlp + l * DM; }
        else if (m == 5) { W = p.w_down + (size_t)l * DFF * DM; K = DFF; N = DM; WT = (bf16_t*)(ws + WS_WDN) + (size_t)l * DM * DFF; }
        else if (m < 8) { const int j = m - 6; W = p.cmp_w1 + (size_t)(l * 2 + j) * 2048 * 128; K = 2048; N = 128; WT = (bf16_t*)(ws + WS_CW1T) + (size_t)(l * 2 + j) * 128 * 2048; }
        else { const int j = m - 8; W = p.cmp_w2 + (size_t)(l * 2 + j) * 128 * 64; K = 128; N = 64; WT = (bf16_t*)(ws + WS_CW2T) + (size_t)(l * 2 + j) * 64 * 128; }
        conv_matrix(W, K, N, WT, scale, sfrom, sh, lds);
    }
    for (int l = 0; l < 2; ++l) {
        u32x4* z = (u32x4*)((bf16_t*)(ws + WS_WIN) + (size_t)l * NP_IN * DM + (size_t)3352 * DM);
        for (int i = bidx * 512 + tid; i < 232 * DM / 8; i += gridDim.x * 512) z[i] = (u32x4){0u, 0u, 0u, 0u};
    }
    if (bidx == 40) {
        float* TABG = (float*)(ws + WS_CBIAS);
        for (int i = tid; i < 2 * 3456; i += 512) {
            const int g = i / 3456, r = i % 3456, dist = (r >> 2) - 64, hh = r & 3;
            int bk;
            if (dist < 16) bk = dist < 0 ? 0 : dist;
            else { bk = 16 + (dist >= 21) + (dist >= 27) + (dist >= 35) + (dist >= 46) + (dist >= 59) + (dist >= 77) + (dist >= 99) + (dist >= 128) + (dist >= 166) + (dist >= 216) + (dist >= 280) + (dist >= 363) + (dist >= 470) + (dist >= 609) + (dist >= 790); }
            TABG[i] = (dist < 0) ? -INFINITY : p.rel_bias[bk * 8 + g * 4 + hh] * 1.4426950408889634f;
        }
    }
    if (bidx >= 16 && bidx < 32) {
        const int r = bidx - 16; float* EH = (float*)(ws + WS_EX + EX_H);
        const float xa = p.x[(size_t)r * SEQ * DM + tid], xb2 = p.x[(size_t)r * SEQ * DM + 512 + tid];
        const float ss = block_sum(xa * xa + xb2 * xb2, (LAS float*)(lds + 32768), tid);
        const float rstd = rsqrtf(ss * (1.0f / 1024.0f) + 1e-6f);
        EH[r * 1024 + tid] = xa * rstd * p.norm_mix[tid]; EH[r * 1024 + 512 + tid] = xb2 * rstd * p.norm_mix[512 + tid];
        __syncthreads();
    }
    {
        bf16_t* xb = (bf16_t*)(ws + WS_XB); float* sumsq = (float*)(ws + WS_SUMSQ);
#pragma unroll 1
        for (int row = bidx * 8 + wave; row < T_TOK; row += gridDim.x * 8) {
            const f32x4* xr = (const f32x4*)(p.x + (size_t)row * DM) + lane;
            f32x4 v[4]; float s = 0.f;
#pragma unroll
            for (int j = 0; j < 4; ++j) { v[j] = xr[64 * j]; s += (v[j][0] * v[j][0] + v[j][1] * v[j][1]) + (v[j][2] * v[j][2] + v[j][3] * v[j][3]); }
#pragma unroll
            for (int o = 1; o < 64; o <<= 1) s += __shfl_xor(s, o);
            u32x2* o8 = (u32x2*)(xb + (size_t)row * DM) + lane;
#pragma unroll
            for (int j = 0; j < 4; ++j) { u32x2 w; w.x = cvt_pk_bf16(v[j][0], v[j][1]); w.y = cvt_pk_bf16(v[j][2], v[j][3]); o8[64 * j] = w; }
            if (lane < 16) sumsq[(size_t)row * 16 + lane] = (lane == 0) ? s : 0.f;
        }
    }
}

template <class InFn>
__device__ __forceinline__ void exact_stage(const float* W0, const float* W1, int wsplit, int K, int N, float* part, InFn in_fn, LAS unsigned char* lds) {
    const int tid = tid_opaque(), lane = tid & 63, wave = tid >> 6;
    const int nsl = K / 256, ncg = (N + 511) / 512, ntasks = nsl * ncg;
    LAS float* IN = (LAS float*)lds;
#pragma unroll 1
    for (int task = blockIdx.x; task < ntasks; task += gridDim.x) {
        const int sl = task % nsl, cg = task / nsl;
        __syncthreads();
#pragma unroll 1
        for (int idx = tid; idx < 4096; idx += 512) IN[idx] = in_fn(idx >> 8, sl * 256 + (idx & 255));
        __syncthreads();
        const int col = (cg * 8 + wave) * 64 + lane;
#ifdef DUP_SIDE
        for (int rep = 0; rep < 2; ++rep)
#endif
        if (col < N) {
            const float* Wp = ((sl < wsplit) ? W0 + (size_t)sl * 256 * N : W1 + (size_t)(sl - wsplit) * 256 * N) + col;
            float acc[16];
#pragma unroll
            for (int r = 0; r < 16; ++r) acc[r] = 0.f;
#pragma unroll 2
            for (int k = 0; k < 256; k += 4) {
                const float w0 = Wp[(size_t)k * N], w1 = Wp[(size_t)(k + 1) * N], w2 = Wp[(size_t)(k + 2) * N], w3 = Wp[(size_t)(k + 3) * N];
#pragma unroll
                for (int r = 0; r < 16; ++r) { const f32x4 v = *(const LAS f32x4*)(IN + r * 256 + k); acc[r] += (v[0] * w0 + v[1] * w1) + (v[2] * w2 + v[3] * w3); }
            }
#pragma unroll
            for (int r = 0; r < 16; ++r) part[((size_t)sl * 16 + r) * N + col] = acc[r];
        }
    }
    __syncthreads();
}
__device__ __forceinline__ float block_sum(float v, LAS float* red, int tid) {
#pragma unroll
    for (int o = 1; o < 64; o <<= 1) v += __shfl_xor(v, o);
    __syncthreads();
    if ((tid & 63) == 0) red[tid >> 6] = v;
    __syncthreads();
    float s = 0.f;
#pragma unroll
    for (int i = 0; i < 8; ++i) s += red[i];
    return s;
}
__device__ __forceinline__ float ex_pp(const float* PP, int r, int c) { return (PP[(size_t)r * IN_COLS + c] + PP[(size_t)(16 + r) * IN_COLS + c]) + (PP[(size_t)(32 + r) * IN_COLS + c] + PP[(size_t)(48 + r) * IN_COLS + c]); }
__device__ __forceinline__ void exact_mixers(const Params& p, int r, LAS unsigned char* lds) {
    const int tid = tid_opaque();
    const float* PP = (const float*)(p.ws + WS_EX + EX_PP); float* OAB = (float*)(p.ws + WS_EX + EX_OAB);
    LAS float* red = (LAS float*)(lds + 32768);
    const int j = tid, h = j >> 7, e = j & 127;
    const float q = ex_pp(PP, r, j), z = ex_pp(PP, r, 512 + j), iv = ex_pp(PP, r, 1024 + j), g = ex_pp(PP, r, 1536 + j);
    float pr = q * (1.0f / (1.0f + __expf(z)));
#pragma unroll
    for (int o = 1; o < 64; o <<= 1) pr += __shfl_xor(pr, o);
    __syncthreads();
    if ((tid & 63) == 0) red[tid >> 6] = pr;
    __syncthreads();
    const float sh = red[2 * h] + red[2 * h + 1];
    const float o = sh * iv;
    float sq = o * o;
#pragma unroll
    for (int o2 = 1; o2 < 64; o2 <<= 1) sq += __shfl_xor(sq, o2);
    __syncthreads();
    if ((tid & 63) == 0) red[tid >> 6] = sq;
    __syncthreads();
    const float rstd = rsqrtf((red[2 * h] + red[2 * h + 1]) * (1.0f / 128.0f) + 1e-6f);
    OAB[(size_t)r * 1024 + j] = o * rstd * p.hg_gain[e] * (g / (1.0f + __expf(-g)));
    const int hh = j >> 6, d = j & 63, gg = hh >> 2, hp = hh & 3;
    const float vs = ex_pp(PP, r, 2944 + gg * 64 + d), vw = ex_pp(PP, r, 3200 + gg * 64 + d);
    const float gs = ex_pp(PP, r, 3328 + gg * 12 + hp * 3 + 1), gw = ex_pp(PP, r, 3328 + gg * 12 + hp * 3 + 2);
    OAB[(size_t)r * 1024 + 512 + j] = vs / (1.0f + __expf(-gs)) + vw / (1.0f + __expf(-gw));
    __syncthreads();
}
__device__ __forceinline__ float ex_x1(const Params& p, int r, int k) {
    const float* XP = (const float*)(p.ws + WS_EX + EX_XP);
    return p.x[(size_t)r * SEQ * DM + k] + ((XP[(size_t)r * 1024 + k] + XP[(size_t)(16 + r) * 1024 + k]) + (XP[(size_t)(32 + r) * 1024 + k] + XP[(size_t)(48 + r) * 1024 + k]));
}
__device__ __forceinline__ float ex_x2(const Params& p, int r, int k) {
    const float* DP = (const float*)(p.ws + WS_EX + EX_DP);
    float s = 0.f;
#pragma unroll
    for (int i = 0; i < 16; ++i) s += DP[((size_t)i * 16 + r) * 1024 + k];
    return ex_x1(p, r, k) + s;
}

constexpr int HG_TOT = 0, HG_DEC = 8192, HG_QB = 8704, HG_QS = HG_QB + 17408, HG_KVER = HG_QS + 17408, HG_KHT = HG_KVER + 43520, HG_VT = HG_KHT + 18432, HG_AM = HG_VT + 4608, HG_END = HG_AM + 9216;
static_assert(HG_END <= LDS_BYTES, "hgrn lds");
__device__ __forceinline__ void hgrn_unit(const Params& p, int layer, int unit, LAS unsigned char* lds) {
    unsigned char* ws = p.ws;
    const int tid = tid_opaque(), lane = tid & 63, wave = tid >> 6, l16 = lane & 15, quad = lane >> 4;
    const int b = unit >> 4, h = (unit >> 2) & 3, sl = unit & 3;
    const int d = tid & 127, tq = tid >> 7;
    const bf16_t* qg = (const bf16_t*)(ws + WS_HQ) + (size_t)b * SEQ * 512 + h * 128 + d;
    const bf16_t* zg = (const bf16_t*)(ws + WS_HF) + (size_t)b * SEQ * 512 + h * 128 + d;
    bf16_t* vg = (bf16_t*)(ws + WS_HI) + (size_t)b * SEQ * 512 + h * 128 + sl * 32;
    float lb = 0.f;
    if (layer == 1) lb = sigm(p.lb_logits[512 + h * 128 + d] - p.lb_logits[h * 128 + d]);
    const float omlb = 1.0f - lb;
    const int vv = tid & 31, sq = tid >> 5;
    const int tt = wave & 3, vt = wave >> 2;
    LAS float* TOT = (LAS float*)(lds + HG_TOT); LAS float* DEC = (LAS float*)(lds + HG_DEC);
    f32x4 S[8];
#pragma unroll
    for (int i = 0; i < 8; ++i) S[i] = (f32x4){0.f, 0.f, 0.f, 0.f};
    float s00;
    {
        LAS float* XR = (LAS float*)(lds + HG_KVER);
        LAS float* red0 = (LAS float*)(lds + HG_TOT);
        const float* nm = p.norm_mix + layer * DM;
        const float xa = (layer == 0) ? p.x[(size_t)b * SEQ * DM + tid] : ex_x2(p, b, tid);
        const float xb2 = (layer == 0) ? p.x[(size_t)b * SEQ * DM + 512 + tid] : ex_x2(p, b, 512 + tid);
        XR[tid] = xa * nm[tid]; XR[512 + tid] = xb2 * nm[512 + tid];
        const float ss = block_sum(xa * xa + xb2 * xb2, red0, tid);
        const float rstd = rsqrtf(ss * (1.0f / 1024.0f) + 1e-6f);
        __syncthreads();
        const float* W = p.w_in + (size_t)layer * DM * IN_COLS + h * 128 + d;
        float q0 = 0.f, z0 = 0.f;
#pragma unroll 4
        for (int k = tq * 256; k < tq * 256 + 256; ++k) { const float hk = XR[k]; q0 += hk * W[(size_t)k * IN_COLS]; z0 += hk * W[(size_t)k * IN_COLS + 512]; }
        LAS float* RED = (LAS float*)(lds + HG_QB);
        RED[tq * 128 + d] = q0; RED[512 + tq * 128 + d] = z0;
        __syncthreads();
        q0 = (RED[d] + RED[128 + d]) + (RED[256 + d] + RED[384 + d]); z0 = (RED[512 + d] + RED[640 + d]) + (RED[768 + d] + RED[896 + d]);
        q0 *= rstd; z0 *= rstd;
        float pr = q0 * (omlb / (1.0f + __expf(z0)));
#pragma unroll
        for (int o = 1; o < 64; o <<= 1) pr += __shfl_xor(pr, o);
        __syncthreads();
        if (lane == 0) RED[wave] = pr;
        __syncthreads();
        s00 = RED[0] + RED[1];
#ifdef DIAG_S00
        if (layer == 1 && tid == 0) atomicMin((unsigned*)(ws + 512), __float_as_uint(fabsf(s00)));
#endif
        __syncthreads();
    }
    const int d0 = 2 * lane, tg = wave, Jc = wave >> 1, hf = wave & 1;
    const unsigned* qg2 = (const unsigned*)((const bf16_t*)(ws + WS_HQ) + (size_t)b * SEQ * 512 + h * 128 + d0);
    const unsigned* zg2 = (const unsigned*)((const bf16_t*)(ws + WS_HF) + (size_t)b * SEQ * 512 + h * 128 + d0);
    float lbA = 0.f, lbB = 0.f;
    if (layer == 1) { lbA = sigm(p.lb_logits[512 + h * 128 + d0] - p.lb_logits[h * 128 + d0]); lbB = sigm(p.lb_logits[512 + h * 128 + d0 + 1] - p.lb_logits[h * 128 + d0 + 1]); }
    const float omA = 1.0f - lbA, omB = 1.0f - lbB;
    LAS float* PRODS = (LAS float*)(lds + HG_TOT);
    LAS float* LOGPS = (LAS float*)(lds + HG_TOT + 4096);
    unsigned qw[8], zw[8]; unsigned short vr[4];
#pragma unroll
    for (int i = 0; i < 8; ++i) { qw[i] = qg2[(size_t)(8 * tg + i) * 256]; zw[i] = zg2[(size_t)(8 * tg + i) * 256]; }
#pragma unroll
    for (int i = 0; i < 4; ++i) vr[i] = vg[(size_t)(4 * sq + i) * 512 + vv];
    for (int c = 0; c < 64; ++c) {
        float qA[8], qB[8], kA[8], kB[8], eA[8], eB[8]; unsigned short vcur[4];
        {
            float pA = 1.f, pB = 1.f;
#pragma unroll
            for (int i = 0; i < 8; ++i) {
                qA[i] = bf_lo(qw[i]); qB[i] = bf_hi(qw[i]);
                const float zA = bf_lo(zw[i]), zB = bf_hi(zw[i]);
                const float ea = __expf(-zA), eb = __expf(-zB);
                const float ia = __builtin_amdgcn_rcpf(1.0f + ea), ib = __builtin_amdgcn_rcpf(1.0f + eb);
                kA[i] = omA * (ea * ia); kB[i] = omB * (eb * ib);
                pA *= lbA + omA * ia; pB *= lbB + omB * ib; eA[i] = pA; eB[i] = pB;
            }
#pragma unroll
            for (int i = 0; i < 4; ++i) vcur[i] = vr[i];
            *(LAS f32x2c_t*)(PRODS + tg * 128 + d0) = (f32x2c_t){pA, pB};
            *(LAS f32x2c_t*)(LOGPS + tg * 128 + d0) = (f32x2c_t){__logf(fmaxf(pA, 1e-37f)), __logf(fmaxf(pB, 1e-37f))};
        }
        __syncthreads();
        float rJA = 0.f, rJB = 0.f, r1A = 0.f, r1B = 0.f, r2A = 0.f, r2B = 0.f, r3A = 0.f, r3B = 0.f, r4A, r4B;
        {
            float accA = 0.f, accB = 0.f;
#pragma unroll
            for (int w = 0; w < 8; ++w) {
                if (w == 2) { r1A = accA; r1B = accB; } if (w == 4) { r2A = accA; r2B = accB; } if (w == 6) { r3A = accA; r3B = accB; }
                const f32x2c_t lp = *(const LAS f32x2c_t*)(LOGPS + w * 128 + d0); accA += lp[0]; accB += lp[1];
            }
            r4A = accA; r4B = accB;
            rJA = (Jc == 0) ? 0.f : ((Jc == 1) ? r1A : ((Jc == 2) ? r2A : r3A)); rJB = (Jc == 0) ? 0.f : ((Jc == 1) ? r1B : ((Jc == 2) ? r2B : r3B));
        }
        if (hf) {
            const f32x2c_t pp = *(const LAS f32x2c_t*)(PRODS + (tg - 1) * 128 + d0);
#pragma unroll
            for (int i = 0; i < 8; ++i) { eA[i] *= pp[0]; eB[i] *= pp[1]; }
        }
        if (tg == 0) *(LAS f32x2c_t*)(DEC + d0) = (f32x2c_t){__expf(r4A), __expf(r4B)};
        {
            LAS unsigned* QB = (LAS unsigned*)(lds + HG_QB); LAS unsigned* QS = (LAS unsigned*)(lds + HG_QS); LAS unsigned* KV_ = (LAS unsigned*)(lds + HG_KVER);
            float riA[8], riB[8];
            const float eJA = __expf(rJA), eJB = __expf(rJB), c4A = __expf(r4A - rJA), c4B = __expf(r4B - rJB);
#pragma unroll
            for (int i = 0; i < 8; ++i) {
                const int t = 8 * tg + i;
                riA[i] = kA[i] * __builtin_amdgcn_rcpf(fmaxf(eA[i], 1e-30f)); riB[i] = kB[i] * __builtin_amdgcn_rcpf(fmaxf(eB[i], 1e-30f));
                const float sA = qA[i] * eA[i], sB = qB[i] * eB[i];
                QS[t * 68 + lane] = cvt_pk_bf16(sA, sB);
                QB[t * 68 + lane] = cvt_pk_bf16(sA * eJA, sB * eJB);
            }
#pragma unroll
            for (int I = 0; I < 4; ++I) {
                if (I >= Jc) {
                    const float rIA = (I == 0) ? 0.f : ((I == 1) ? r1A : ((I == 2) ? r2A : r3A)), rIB = (I == 0) ? 0.f : ((I == 1) ? r1B : ((I == 2) ? r2B : r3B));
                    const int voff = (I == 0) ? 0 : ((I == 1) ? 16 : ((I == 2) ? 48 : 96));
                    const float cA = __expf(rIA - rJA), cB = __expf(rIB - rJB);
#pragma unroll
                    for (int i = 0; i < 8; ++i) KV_[(voff + 8 * tg + i) * 68 + lane] = cvt_pk_bf16(riA[i] * cA, riB[i] * cB);
                }
            }
            LAS unsigned char* KHT = lds + HG_KHT;
            u32x4 w0, w1;
            w0.x = cvt_pk_bf16(riA[0] * c4A, riA[1] * c4A); w0.y = cvt_pk_bf16(riA[2] * c4A, riA[3] * c4A); w0.z = cvt_pk_bf16(riA[4] * c4A, riA[5] * c4A); w0.w = cvt_pk_bf16(riA[6] * c4A, riA[7] * c4A);
            w1.x = cvt_pk_bf16(riB[0] * c4B, riB[1] * c4B); w1.y = cvt_pk_bf16(riB[2] * c4B, riB[3] * c4B); w1.z = cvt_pk_bf16(riB[4] * c4B, riB[5] * c4B); w1.w = cvt_pk_bf16(riB[6] * c4B, riB[7] * c4B);
            *(LAS u32x4*)(KHT + d0 * 144 + tg * 16) = w0; *(LAS u32x4*)(KHT + (d0 + 1) * 144 + tg * 16) = w1;
            LAS unsigned char* VT = lds + HG_VT;
            u32x2 wv; wv.x = (unsigned)vcur[0] | ((unsigned)vcur[1] << 16); wv.y = (unsigned)vcur[2] | ((unsigned)vcur[3] << 16);
            *(LAS u32x2*)(VT + vv * 144 + sq * 8) = wv;
            LAS u32x4* AMz = (LAS u32x4*)(lds + HG_AM);
            AMz[tid] = (u32x4){0u, 0u, 0u, 0u}; if (tid < 64) AMz[512 + tid] = (u32x4){0u, 0u, 0u, 0u};
        }
        __syncthreads();
        if (c + 1 < 64) {
            const size_t ro = (size_t)(c + 1) * 64 * 512;
#pragma unroll
            for (int i = 0; i < 8; ++i) { qw[i] = qg2[(ro >> 1) + (size_t)(8 * tg + i) * 256]; zw[i] = zg2[(ro >> 1) + (size_t)(8 * tg + i) * 256]; }
#pragma unroll
            for (int i = 0; i < 4; ++i) vr[i] = vg[ro + (size_t)(4 * sq + i) * 512 + vv];
        }
        for (int pi = wave; pi < 10; pi += 8) {
            int I, J;
            if (pi == 0) { I = 0; J = 0; } else if (pi < 3) { I = 1; J = pi - 1; } else if (pi < 6) { I = 2; J = pi - 3; } else { I = 3; J = pi - 6; }
            const int voff = (I == 0) ? 0 : ((I == 1) ? 16 : ((I == 2) ? 48 : 96));
            const LAS unsigned char* qa = lds + HG_QS + (16 * I + l16) * 272 + quad * 16;
            const LAS unsigned char* kb = lds + HG_KVER + (voff + 16 * J + l16) * 272 + quad * 16;
            f32x4 a = (f32x4){0.f, 0.f, 0.f, 0.f};
#pragma unroll
            for (int ks = 0; ks < 4; ++ks) a = MFMA16(lds_ld8(qa + ks * 64), lds_ld8(kb + ks * 64), a);
            LAS bf16_t* AM = (LAS bf16_t*)(lds + HG_AM);
#pragma unroll
            for (int j = 0; j < 4; ++j) {
                float v = a[j]; if (I == J && l16 > quad * 4 + j) v = 0.f;
                if (c == 0 && pi == 0 && lane == 0 && j == 0) v = s00;
                AM[(16 * I + quad * 4 + j) * 72 + 16 * J + l16] = bf1(v);
            }
        }
        __syncthreads();
        {
            f32x4 o = (f32x4){0.f, 0.f, 0.f, 0.f};
            const LAS unsigned char* qb = lds + HG_QB + (16 * tt + l16) * 272 + quad * 8;
#pragma unroll
            for (int s2 = 0; s2 < 4; ++s2) o = MFMA16(lds_ld4x2(qb + s2 * 64, qb + s2 * 64 + 32), pack8(S[2 * s2], S[2 * s2 + 1]), o);
            const LAS unsigned char* am = lds + HG_AM + (16 * tt + l16) * 144 + quad * 16;
            const LAS unsigned char* vb = lds + HG_VT + (16 * vt + l16) * 144 + quad * 16;
            const bf16x8 vb0 = lds_ld8(vb), vb1 = lds_ld8(vb + 64);
            o = MFMA16(lds_ld8(am), vb0, o); o = MFMA16(lds_ld8(am + 64), vb1, o);
            bf16_t* og = (bf16_t*)(ws + WS_TMP) + (size_t)b * SEQ * 512 + h * 128 + sl * 32 + (size_t)(c * 64 + 16 * tt + quad * 4) * 512 + 16 * vt + l16;
#pragma unroll
            for (int j = 0; j < 4; ++j) og[(size_t)j * 512] = bf1(o[j]);
#pragma unroll
            for (int dt = 0; dt < 8; ++dt) {
                const f32x4 dc = *(const LAS f32x4*)(DEC + 16 * dt + quad * 4);
                const LAS unsigned char* ka = lds + HG_KHT + (16 * dt + l16) * 144 + quad * 16;
                f32x4 s = S[dt] * dc;
                s = MFMA16(lds_ld8(ka), vb0, s); s = MFMA16(lds_ld8(ka + 64), vb1, s);
                S[dt] = s;
            }
        }
        __syncthreads();
    }
}

__device__ __forceinline__ void hgrn_finalize(const Params& p, int layer) {
    unsigned char* ws = p.ws;
    const int tid = tid_opaque(), lane = tid & 63, wave = tid >> 6;
    const float* gain = p.hg_gain + layer * 128 + (lane & 15) * 8;
    float gn[8];
#pragma unroll
    for (int e = 0; e < 8; ++e) gn[e] = gain[e];
    for (int row = blockIdx.x * 8 + wave; row < T_TOK; row += gridDim.x * 8) {
        u32x4* op = (u32x4*)((bf16_t*)(ws + WS_HI) + (size_t)row * 512) + lane;
        const u32x4 ov = *((const u32x4*)((const bf16_t*)(ws + WS_TMP) + (size_t)row * 512) + lane), gv = *((const u32x4*)((const bf16_t*)(ws + WS_HG) + (size_t)row * 512) + lane);
        float o[8], g[8];
        o[0] = bf_lo(ov.x); o[1] = bf_hi(ov.x); o[2] = bf_lo(ov.y); o[3] = bf_hi(ov.y); o[4] = bf_lo(ov.z); o[5] = bf_hi(ov.z); o[6] = bf_lo(ov.w); o[7] = bf_hi(ov.w);
        g[0] = bf_lo(gv.x); g[1] = bf_hi(gv.x); g[2] = bf_lo(gv.y); g[3] = bf_hi(gv.y); g[4] = bf_lo(gv.z); g[5] = bf_hi(gv.z); g[6] = bf_lo(gv.w); g[7] = bf_hi(gv.w);
        float s = 0.f;
#pragma unroll
        for (int e = 0; e < 8; ++e) s += o[e] * o[e];
        s += __shfl_xor(s, 1); s += __shfl_xor(s, 2); s += __shfl_xor(s, 4); s += __shfl_xor(s, 8);
        const float rstd = rsqrtf(s * (1.0f / 128.0f) + 1e-6f);
#pragma unroll
        for (int e = 0; e < 8; ++e) o[e] = o[e] * rstd * gn[e] * (g[e] * sigm(g[e]));
        u32x4 w; w.x = cvt_pk_bf16(o[0], o[1]); w.y = cvt_pk_bf16(o[2], o[3]); w.z = cvt_pk_bf16(o[4], o[5]); w.w = cvt_pk_bf16(o[6], o[7]);
        *op = w;
    }
}

constexpr int CM_A = 0, CM_W = 9216, CM_H = CM_W + 18432, CM_W2 = CM_H + 17408, CM_END = CM_W2 + 17408;
__device__ __forceinline__ void cmp_unit(const Params& p, int layer, int unit, LAS unsigned char* lds) {
    unsigned char* ws = p.ws;
    const int tid = tid_opaque(), lane = tid & 63, wave = tid >> 6, l16 = lane & 15, quad = lane >> 4;
    const int ct = unit & 3, kv = (unit >> 2) & 1, g = (unit >> 3) & 1, b = unit >> 4;
    const bf16_t* src = (const bf16_t*)(ws + WS_KV) + (size_t)b * SEQ * 768 + kv * 128 + g * 64;
    const bf16_t* W1T = (const bf16_t*)(ws + WS_CW1T) + (size_t)(layer * 2 + kv) * 128 * 2048;
    const bf16_t* W2T = (const bf16_t*)(ws + WS_CW2T) + (size_t)(layer * 2 + kv) * 64 * 128;
    const float* cbias = p.cmp_b1 + (layer * 2 + kv) * 128;
    const float* cpos = p.cmp_pos + (size_t)(layer * 2 + kv) * 2048 + (tid & 7) * 8;
    {
        const int n = tid >> 3, ch = tid & 7;
        *(LAS u32x4*)(lds + CM_W2 + n * 272 + ch * 32) = *(const u32x4*)(W2T + n * 128 + ch * 16);
        *(LAS u32x4*)(lds + CM_W2 + n * 272 + ch * 32 + 16) = *(const u32x4*)(W2T + n * 128 + ch * 16 + 8);
    }
    const int arow = tid >> 3, ach = tid & 7, ac = ct * 64 + arow;
    const bool aval = ac < 255;
    const bf16_t* ap = src + (size_t)(16 * (aval ? ac : 0)) * 768 + ach * 8;
    const int mi = wave & 3, nh = wave >> 2;
    f32x4 acc[4];
#pragma unroll
    for (int i = 0; i < 4; ++i) acc[i] = (f32x4){0.f, 0.f, 0.f, 0.f};
    u32x4 ar, wr0, wr1;
    ar = aval ? *(const u32x4*)ap : (u32x4){0u, 0u, 0u, 0u};
    wr0 = *(const u32x4*)(W1T + (size_t)(tid >> 3) * 2048 + (tid & 7) * 8);
    wr1 = *(const u32x4*)(W1T + (size_t)(64 + (tid >> 3)) * 2048 + (tid & 7) * 8);
    for (int tok = 0; tok < 32; ++tok) {
        __syncthreads();
        {
            const f32x4 p0 = *(const f32x4*)(cpos + tok * 64), p1 = *(const f32x4*)(cpos + tok * 64 + 4);
            ar.x = cvt_pk_bf16(bf_lo(ar.x) + p0[0], bf_hi(ar.x) + p0[1]); ar.y = cvt_pk_bf16(bf_lo(ar.y) + p0[2], bf_hi(ar.y) + p0[3]);
            ar.z = cvt_pk_bf16(bf_lo(ar.z) + p1[0], bf_hi(ar.z) + p1[1]); ar.w = cvt_pk_bf16(bf_lo(ar.w) + p1[2], bf_hi(ar.w) + p1[3]);
        }
        *(LAS u32x4*)(lds + CM_A + arow * 144 + ach * 16) = ar;
        *(LAS u32x4*)(lds + CM_W + (tid >> 3) * 144 + (tid & 7) * 16) = wr0;
        *(LAS u32x4*)(lds + CM_W + (64 + (tid >> 3)) * 144 + (tid & 7) * 16) = wr1;
        __syncthreads();
        if (tok + 1 < 32) {
            ar = aval ? *(const u32x4*)(ap + (size_t)(tok + 1) * 768) : (u32x4){0u, 0u, 0u, 0u};
            wr0 = *(const u32x4*)(W1T + (size_t)(tid >> 3) * 2048 + (tok + 1) * 64 + (tid & 7) * 8);
            wr1 = *(const u32x4*)(W1T + (size_t)(64 + (tid >> 3)) * 2048 + (tok + 1) * 64 + (tid & 7) * 8);
        }
#pragma unroll
        for (int ks = 0; ks < 2; ++ks) {
            const bf16x8 a = lds_ld8(lds + CM_A + (mi * 16 + l16) * 144 + ks * 64 + quad * 16);
#pragma unroll
            for (int ni = 0; ni < 4; ++ni) acc[ni] = MFMA16(a, lds_ld8(lds + CM_W + ((nh * 4 + ni) * 16 + l16) * 144 + ks * 64 + quad * 16), acc[ni]);
        }
    }
    {
        LAS bf16_t* H = (LAS bf16_t*)(lds + CM_H);
#pragma unroll
        for (int ni = 0; ni < 4; ++ni) {
            const int n = (nh * 4 + ni) * 16 + l16; const float cb = cbias[n];
#pragma unroll
            for (int j = 0; j < 4; ++j) {
                const float x = acc[ni][j] + cb;
                const float u = 0.7978845608028654f * (x + 0.044715f * x * x * x);
                const float th = 1.0f - 2.0f / (__expf(2.0f * u) + 1.0f);
                H[(mi * 16 + quad * 4 + j) * 136 + n] = bf1(0.5f * x * (1.0f + th));
            }
        }
    }
    __syncthreads();
    if (wave < 4) {
        f32x4 a2[4];
#pragma unroll
        for (int i = 0; i < 4; ++i) a2[i] = (f32x4){0.f, 0.f, 0.f, 0.f};
#pragma unroll
        for (int ks = 0; ks < 4; ++ks) {
            const bf16x8 a = lds_ld8(lds + CM_H + (wave * 16 + l16) * 272 + ks * 64 + quad * 16);
#pragma unroll
            for (int ni = 0; ni < 4; ++ni) a2[ni] = MFMA16(a, lds_ld8(lds + CM_W2 + (ni * 16 + l16) * 272 + ks * 64 + quad * 16), a2[ni]);
        }
        if (kv == 0) {
            bf16_t* KC = (bf16_t*)(ws + WS_KCMP) + (size_t)(b * 2 + g) * 256 * 64;
            const float* gain = p.qk_gain + (layer * 4 + 1) * 64;
#pragma unroll
            for (int j = 0; j < 4; ++j) {
                float s = (a2[0][j] * a2[0][j] + a2[1][j] * a2[1][j]) + (a2[2][j] * a2[2][j] + a2[3][j] * a2[3][j]);
                s += __shfl_xor(s, 1); s += __shfl_xor(s, 2); s += __shfl_xor(s, 4); s += __shfl_xor(s, 8);
                const float rstd = rsqrtf(s * (1.0f / 64.0f) + 1e-6f);
                const int c = ct * 64 + wave * 16 + quad * 4 + j;
#pragma unroll
                for (int ni = 0; ni < 4; ++ni) KC[(size_t)c * 64 + ni * 16 + l16] = (c < 255) ? bf1(a2[ni][j] * rstd * gain[ni * 16 + l16]) : (bf16_t)0;
            }
        } else {
            bf16_t* VC = (bf16_t*)(ws + WS_VCMPT) + (size_t)(b * 2 + g) * 64 * 256;
#pragma unroll
            for (int j = 0; j < 4; ++j) {
                const int c = ct * 64 + wave * 16 + quad * 4 + j;
#pragma unroll
                for (int ni = 0; ni < 4; ++ni) VC[(size_t)(ni * 16 + l16) * 256 + c] = (c < 255) ? bf1(a2[ni][j]) : (bf16_t)0;
            }
        }
    }
    __syncthreads();
}

constexpr int AT_TAB = 0, AT_TABW = 13824, AT_K = 23296, AT_V = AT_K + 18432, AT_PS = AT_V + 18432, AT_MASK = AT_PS + 65536, AT_END = AT_MASK + 512;
static_assert(AT_END <= LDS_BYTES, "attn lds");

struct AttnCtx {
    const bf16_t* ksrc; const bf16_t* vsrc; int ldk, ldv; const float* kgain;
    int tpos[2]; int h;
};

template <int BR>
__device__ __forceinline__ void attn_branch(const AttnCtx& cx, const bf16x8 (&qf)[2][2], int qt, unsigned long long selu, const unsigned long long (&selm)[2], unsigned long long wact0, unsigned long long wact1,
                                            f32x4 (&of)[2][4], const float (&gate)[2], LAS unsigned char* lds, float (&m_out)[2], float (&il_out)[2]) {
    const int tid = tid_opaque(), lane = tid & 63, l16 = lane & 15, quad = lane >> 4;
    const int srow = tid >> 3, sch = tid & 7;
    float kg[8];
    if (BR != 0) {
#pragma unroll
        for (int e = 0; e < 8; ++e) kg[e] = cx.kgain[sch * 8 + e];
    }
    unsigned long long rem;
    if (BR == 0) rem = (1ull << (((qt * 64 + 32) >> 10) + 1)) - 1ull;
    else if (BR == 1) rem = selu & ((qt >= 63) ? ~0ull : ((2ull << qt) - 1ull));
    else { const int lo = qt > 8 ? qt - 8 : 0; rem = ((qt >= 63) ? ~0ull : ((2ull << qt) - 1ull)) & ~((1ull << lo) - 1ull); }
    f32x4 o[2][4]; float l[2];
#pragma unroll
    for (int mi = 0; mi < 2; ++mi) { l[mi] = 0.f;
#pragma unroll
        for (int di = 0; di < 4; ++di) o[mi][di] = (f32x4){0.f, 0.f, 0.f, 0.f}; }
    int cur = rem ? __builtin_ctzll(rem) : -1; if (rem) rem &= rem - 1ull;
    u32x4 kr, vr;
    auto gload = [&](int jt) {
        kr = *(const u32x4*)(cx.ksrc + (size_t)(jt * 64 + srow) * cx.ldk + sch * 8);
        vr = *(const u32x4*)(cx.vsrc + (size_t)srow * cx.ldv + jt * 64 + sch * 8);
    };
    auto lstore = [&](int buf) {
        u32x4 kw = kr;
        if (BR != 0) {
            float f[8]; f[0] = bf_lo(kr.x); f[1] = bf_hi(kr.x); f[2] = bf_lo(kr.y); f[3] = bf_hi(kr.y); f[4] = bf_lo(kr.z); f[5] = bf_hi(kr.z); f[6] = bf_lo(kr.w); f[7] = bf_hi(kr.w);
            float s = 0.f;
#pragma unroll
            for (int e = 0; e < 8; ++e) s += f[e] * f[e];
            s += __shfl_xor(s, 1); s += __shfl_xor(s, 2); s += __shfl_xor(s, 4);
            const float rstd = rsqrtf(s * (1.0f / 64.0f) + 1e-6f);
#pragma unroll
            for (int e = 0; e < 8; ++e) f[e] = f[e] * rstd * kg[e];
            kw.x = cvt_pk_bf16(f[0], f[1]); kw.y = cvt_pk_bf16(f[2], f[3]); kw.z = cvt_pk_bf16(f[4], f[5]); kw.w = cvt_pk_bf16(f[6], f[7]);
        }
        *(LAS u32x4*)(lds + AT_K + buf * 9216 + srow * 144 + sch * 16) = kw;
        *(LAS u32x4*)(lds + AT_V + buf * 9216 + srow * 144 + sch * 16) = vr;
    };
    if (cur >= 0) { gload(cur); lstore(0); }
    __syncthreads();
    int buf = 0;
    const LAS f32x4* TAB = (const LAS f32x4*)(lds + AT_TAB);
    const LAS float* TABf = (const LAS float*)(lds + AT_TAB);
#pragma nounroll
    while (cur >= 0) {
        const int nxt = rem ? __builtin_ctzll(rem) : -1; if (rem) rem &= rem - 1ull;
        if (nxt >= 0) gload(nxt);
        const LAS unsigned char* Kb = lds + AT_K + buf * 9216; const LAS unsigned char* Vb = lds + AT_V + buf * 9216;
        f32x4 st[2][4];
        const bool far_tile = (BR == 1) && (cur * 64 + 63 + 790 <= qt * 64);
        const bool ok0 = (BR != 1) || ((selm[0] >> cur) & 1ull), ok1 = (BR != 1) || ((selm[1] >> cur) & 1ull);
        const float c31 = TABf[863 * 4 + cx.h];
        const float cb0 = ok0 ? c31 : -INFINITY, cb1 = ok1 ? c31 : -INFINITY;
        const int bs0 = ok0 ? ((BR == 0) ? (cx.tpos[0] + 33 - 16 * (cur * 64 + quad * 4)) : (cx.tpos[0] + 64 - cur * 64 - quad * 4)) : -(1 << 20);
        const int bs1 = ok1 ? ((BR == 0) ? (cx.tpos[1] + 33 - 16 * (cur * 64 + quad * 4)) : (cx.tpos[1] + 64 - cur * 64 - quad * 4)) : -(1 << 20);
        const LAS unsigned char* tb = lds + ((BR == 2) ? AT_TABW : AT_TAB) + cx.h * 4;
        constexpr int MAXI = (BR == 2) ? 576 : 863;
        const bool act0 = (BR != 1) || ((wact0 >> cur) & 1ull), act1 = (BR != 1) || ((wact1 >> cur) & 1ull);
        if (act0 || act1) {
#pragma unroll
        for (int ni = 0; ni < 4; ++ni) {
            const bf16x8 k0 = lds_ld8(Kb + (ni * 16 + l16) * 144 + quad * 16), k1 = lds_ld8(Kb + (ni * 16 + l16) * 144 + 64 + quad * 16);
            f32x4 a0, a1;
            if (far_tile) { a0 = (f32x4){cb0, cb0, cb0, cb0}; a1 = (f32x4){cb1, cb1, cb1, cb1}; }
            else {
                constexpr int CM = (BR == 0) ? 16 : 1;
                const int i00 = clampi(bs0 - CM * (ni * 16 + 0), 0, MAXI), i01 = clampi(bs0 - CM * (ni * 16 + 1), 0, MAXI), i02 = clampi(bs0 - CM * (ni * 16 + 2), 0, MAXI), i03 = clampi(bs0 - CM * (ni * 16 + 3), 0, MAXI);
                const int i10 = clampi(bs1 - CM * (ni * 16 + 0), 0, MAXI), i11 = clampi(bs1 - CM * (ni * 16 + 1), 0, MAXI), i12 = clampi(bs1 - CM * (ni * 16 + 2), 0, MAXI), i13 = clampi(bs1 - CM * (ni * 16 + 3), 0, MAXI);
                a0 = (f32x4){*(const LAS float*)(tb + i00 * 16), *(const LAS float*)(tb + i01 * 16), *(const LAS float*)(tb + i02 * 16), *(const LAS float*)(tb + i03 * 16)};
                a1 = (f32x4){*(const LAS float*)(tb + i10 * 16), *(const LAS float*)(tb + i11 * 16), *(const LAS float*)(tb + i12 * 16), *(const LAS float*)(tb + i13 * 16)};
            }
            if (act0) { a0 = MFMA16(k0, qf[0][0], a0); a0 = MFMA16(k1, qf[0][1], a0); } st[0][ni] = a0;
            if (act1) { a1 = MFMA16(k0, qf[1][0], a1); a1 = MFMA16(k1, qf[1][1], a1); } st[1][ni] = a1;
            __builtin_amdgcn_sched_barrier(0);
        }
        bf16x8 pb[2][2];
#pragma unroll
        for (int mi = 0; mi < 2; ++mi) {
            if (mi == 0 ? act0 : act1) {
                float ls = 0.f;
#pragma unroll
                for (int ni = 0; ni < 4; ++ni)
#pragma unroll
                    for (int j = 0; j < 4; ++j) { const float pv = __builtin_amdgcn_exp2f(st[mi][ni][j]); st[mi][ni][j] = pv; ls += pv; }
                l[mi] += ls;
                pb[mi][0] = pack8(st[mi][0], st[mi][1]); pb[mi][1] = pack8(st[mi][2], st[mi][3]);
            } else { pb[mi][0] = (bf16x8){0, 0, 0, 0, 0, 0, 0, 0}; pb[mi][1] = (bf16x8){0, 0, 0, 0, 0, 0, 0, 0}; }
        }
#pragma unroll
        for (int di = 0; di < 4; ++di)
#pragma unroll
            for (int s2 = 0; s2 < 2; ++s2) {
                const LAS unsigned char* vp = Vb + (di * 16 + l16) * 144 + s2 * 64 + quad * 8;
                const bf16x8 vf = lds_ld4x2(vp, vp + 32);
                if (act0) o[0][di] = MFMA16(vf, pb[0][s2], o[0][di]);
                if (act1) o[1][di] = MFMA16(vf, pb[1][s2], o[1][di]);
            }
        }
        if (nxt >= 0) lstore(buf ^ 1);
        __syncthreads();
        cur = nxt; buf ^= 1;
    }
#pragma unroll
    for (int mi = 0; mi < 2; ++mi) {
        float lt = l[mi]; lt += __shfl_xor(lt, 16); lt += __shfl_xor(lt, 32);
        const float il = lt > 0.f ? 1.0f / lt : 0.f;
        const float sc = il * gate[mi];
#pragma unroll
        for (int di = 0; di < 4; ++di) of[mi][di] = of[mi][di] + o[mi][di] * sc;
        m_out[mi] = 0.f; il_out[mi] = il;
    }
    (void)TAB;
}

__device__ __forceinline__ void attn_cmp_probs(const AttnCtx& cx, const bf16x8 (&qf)[2][2], const float (&mrow)[2], const float (&ilrow)[2], int ntile, LAS unsigned char* lds) {
    const int tid = tid_opaque(), lane = tid & 63, wave = tid >> 6, l16 = lane & 15, quad = lane >> 4;
    const int srow = tid >> 3, sch = tid & 7;
    const LAS float* TABf = (const LAS float*)(lds + AT_TAB);
    LAS float* PS = (LAS float*)(lds + AT_PS);
#pragma nounroll
    for (int jt = 0; jt < ntile; ++jt) {
        const u32x4 kr = *(const u32x4*)(cx.ksrc + (size_t)(jt * 64 + srow) * cx.ldk + sch * 8);
        __syncthreads();
        *(LAS u32x4*)(lds + AT_K + srow * 144 + sch * 16) = kr;
        __syncthreads();
        const LAS unsigned char* Kb = lds + AT_K;
#pragma unroll
        for (int ni = 0; ni < 4; ++ni) {
            const bf16x8 k0 = lds_ld8(Kb + (ni * 16 + l16) * 144 + quad * 16), k1 = lds_ld8(Kb + (ni * 16 + l16) * 144 + 64 + quad * 16);
#pragma unroll
            for (int mi = 0; mi < 2; ++mi) {
                f32x4 a = (f32x4){0.f, 0.f, 0.f, 0.f}; a = MFMA16(k0, qf[mi][0], a); a = MFMA16(k1, qf[mi][1], a);
                const int tp = cx.tpos[mi];
                f32x4 pr;
#pragma unroll
                for (int j = 0; j < 4; ++j) {
                    const int kidx = jt * 64 + ni * 16 + quad * 4 + j;
                    int idx = tp + 33 - 16 * kidx; idx = idx < 0 ? 0 : (idx > 863 ? 863 : idx);
                    float pv = __builtin_amdgcn_exp2f(a[j] + TABf[idx * 4 + cx.h] - mrow[mi]) * ilrow[mi];
                    pv += __shfl_xor(pv, 1); pv += __shfl_xor(pv, 2);
                    pr[j] = pv;
                }
                if ((l16 & 3) == 0) *(LAS f32x4*)(PS + (wave * 8 + mi * 4 + (l16 >> 2)) * 256 + jt * 64 + ni * 16 + quad * 4) = pr;
            }
        }
    }
    __syncthreads();
}

__device__ __forceinline__ void attn_unit(const Params& p, int layer, int b, int g, int qt, LAS unsigned char* lds) {
    unsigned char* ws = p.ws;
    const int tid = tid_opaque(), lane = tid & 63, wave = tid >> 6, l16 = lane & 15, quad = lane >> 4;
    const int t0 = qt * 64;
    __syncthreads();
    {
        const f32x4* TABG = (const f32x4*)(ws + WS_CBIAS) + g * 864;
        LAS f32x4* TABw = (LAS f32x4*)(lds + AT_TAB); LAS f32x4* TABW2 = (LAS f32x4*)(lds + AT_TABW);
        const f32x4 ninf = (f32x4){-INFINITY, -INFINITY, -INFINITY, -INFINITY};
#pragma unroll
        for (int k = 0; k < 2; ++k) {
            const int i = tid + k * 512;
            if (i < 864) { const f32x4 v = TABG[i]; TABw[i] = v; if (i < 577) TABW2[i] = (i < 576) ? v : ninf; }
        }
    }
    AttnCtx cx; cx.h = l16 & 3;
    bf16x8 qf[2][2]; float gates[3][2];
    bf16_t* nq = (bf16_t*)(ws + WS_NQ);
    const bf16_t* ng = (const bf16_t*)(ws + WS_NG);
    const float* qgain = p.qk_gain + (layer * 4 + 0) * 64;
#pragma unroll
    for (int mi = 0; mi < 2; ++mi) {
        const int tl = wave * 8 + mi * 4 + (l16 >> 2); const int tp = t0 + tl; cx.tpos[mi] = tp;
        const size_t row = (size_t)b * SEQ + tp;
        const bf16_t* qp = nq + row * 512 + g * 256 + cx.h * 64 + quad * 8;
        const u32x4 q0 = *(const u32x4*)qp, q1 = *(const u32x4*)(qp + 32);
        float f[16];
        f[0] = bf_lo(q0.x); f[1] = bf_hi(q0.x); f[2] = bf_lo(q0.y); f[3] = bf_hi(q0.y); f[4] = bf_lo(q0.z); f[5] = bf_hi(q0.z); f[6] = bf_lo(q0.w); f[7] = bf_hi(q0.w);
        f[8] = bf_lo(q1.x); f[9] = bf_hi(q1.x); f[10] = bf_lo(q1.y); f[11] = bf_hi(q1.y); f[12] = bf_lo(q1.z); f[13] = bf_hi(q1.z); f[14] = bf_lo(q1.w); f[15] = bf_hi(q1.w);
        float s = 0.f;
#pragma unroll
        for (int e = 0; e < 16; ++e) s += f[e] * f[e];
        s += __shfl_xor(s, 16); s += __shfl_xor(s, 32);
        const float rstd = rsqrtf(s * (1.0f / 64.0f) + 1e-6f) * (0.125f * 1.4426950408889634f);
#pragma unroll
        for (int e = 0; e < 8; ++e) { f[e] = f[e] * rstd * qgain[quad * 8 + e]; f[8 + e] = f[8 + e] * rstd * qgain[32 + quad * 8 + e]; }
        u32x4 w0, w1;
        w0.x = cvt_pk_bf16(f[0], f[1]); w0.y = cvt_pk_bf16(f[2], f[3]); w0.z = cvt_pk_bf16(f[4], f[5]); w0.w = cvt_pk_bf16(f[6], f[7]);
        w1.x = cvt_pk_bf16(f[8], f[9]); w1.y = cvt_pk_bf16(f[10], f[11]); w1.z = cvt_pk_bf16(f[12], f[13]); w1.w = cvt_pk_bf16(f[14], f[15]);
        qf[mi][0] = __builtin_bit_cast(bf16x8, w0); qf[mi][1] = __builtin_bit_cast(bf16x8, w1);
#pragma unroll
        for (int br = 0; br < 3; ++br) gates[br][mi] = bfu(ng[row * 256 + g * 12 + cx.h * 3 + br]);
    }
    __syncthreads();
    f32x4 of[2][4];
#pragma unroll
    for (int mi = 0; mi < 2; ++mi)
#pragma unroll
        for (int di = 0; di < 4; ++di) of[mi][di] = (f32x4){0.f, 0.f, 0.f, 0.f};
    const unsigned long long nomask[2] = {0ull, 0ull};
    float mrow[2], ilrow[2];
    cx.ksrc = (const bf16_t*)(ws + WS_KCMP) + (size_t)(b * 2 + g) * 256 * 64; cx.ldk = 64;
    cx.vsrc = (const bf16_t*)(ws + WS_VCMPT) + (size_t)(b * 2 + g) * 64 * 256; cx.ldv = 256; cx.kgain = nullptr;
    { const float gt[2] = {gates[0][0], gates[0][1]}; attn_branch<0>(cx, qf, qt, 0ull, nomask, ~0ull, ~0ull, of, gt, lds, mrow, ilrow); }
    const int ncmp = ((qt * 64 + 32) >> 10) + 1;
    attn_cmp_probs(cx, qf, mrow, ilrow, ncmp, lds);
    {
        const LAS float* PS = (const LAS float*)(lds + AT_PS);
        LAS unsigned long long* MK = (LAS unsigned long long*)(lds + AT_MASK);
        for (int ti = 0; ti < 8; ++ti) {
            const int tl = wave * 8 + ti, tp = t0 + tl, jcur = tp >> 6, j = lane;
            float imp = 0.f;
#pragma unroll
            for (int e = -1; e < 4; ++e) { const int c = 4 * j + e; if (c >= 0 && c < 255 && c < ncmp * 64) imp += PS[tl * 256 + c]; }
            const bool forced = (j == 0) || (j == jcur) || (j == jcur - 1);
            imp = (64 * j <= tp) ? (imp + (forced ? 1000.0f : 0.f)) : -1.0f;
            const unsigned key = (imp < 0.f) ? 0u : (__float_as_uint(imp) + 1u);
            unsigned T = 0u;
#pragma unroll
            for (int bit = 31; bit >= 0; --bit) {
                const unsigned cand = T | (1u << bit);
                if (__builtin_popcountll(__ballot(key >= cand)) >= 8) T = cand;
            }
            unsigned long long mk = __ballot(key > T);
            unsigned long long eq = __ballot(key == T);
            int need = 8 - __builtin_popcountll(mk);
            while (need > 0 && eq) { const unsigned long long lo = eq & (0ull - eq); mk |= lo; eq ^= lo; --need; }
            if (lane == 0) MK[tl] = mk;
        }
    }
    __syncthreads();
    unsigned long long selu = 0ull, selm[2];
    {
        const LAS unsigned long long* MK = (const LAS unsigned long long*)(lds + AT_MASK);
#pragma unroll 4
        for (int i = 0; i < 64; ++i) selu |= MK[i];
        selm[0] = MK[wave * 8 + (l16 >> 2)]; selm[1] = MK[wave * 8 + 4 + (l16 >> 2)];
    }
    unsigned long long wact0, wact1;
    {
        const LAS unsigned long long* MK = (const LAS unsigned long long*)(lds + AT_MASK);
        const unsigned long long a = (MK[wave * 8 + 0] | MK[wave * 8 + 1]) | (MK[wave * 8 + 2] | MK[wave * 8 + 3]), b2 = (MK[wave * 8 + 4] | MK[wave * 8 + 5]) | (MK[wave * 8 + 6] | MK[wave * 8 + 7]);
        wact0 = ((unsigned long long)(unsigned)__builtin_amdgcn_readfirstlane((int)(a >> 32)) << 32) | (unsigned)__builtin_amdgcn_readfirstlane((int)a);
        wact1 = ((unsigned long long)(unsigned)__builtin_amdgcn_readfirstlane((int)(b2 >> 32)) << 32) | (unsigned)__builtin_amdgcn_readfirstlane((int)b2);
    }
    float md[2], ild[2];
    cx.ksrc = (const bf16_t*)(ws + WS_KV) + (size_t)b * SEQ * 768 + 256 + g * 64; cx.ldk = 768;
    cx.vsrc = (const bf16_t*)(ws + WS_VST) + (size_t)(b * 2 + g) * 64 * 4096; cx.ldv = 4096; cx.kgain = p.qk_gain + (layer * 4 + 2) * 64;
    { const float gt[2] = {gates[1][0], gates[1][1]}; attn_branch<1>(cx, qf, qt, selu, selm, wact0, wact1, of, gt, lds, md, ild); }
    cx.ksrc = (const bf16_t*)(ws + WS_KV) + (size_t)b * SEQ * 768 + 512 + g * 64; cx.ldk = 768;
    cx.vsrc = (const bf16_t*)(ws + WS_VWT) + (size_t)(b * 2 + g) * 64 * 4096; cx.ldv = 4096; cx.kgain = p.qk_gain + (layer * 4 + 3) * 64;
    { const float gt[2] = {gates[2][0], gates[2][1]}; attn_branch<2>(cx, qf, qt, 0ull, nomask, ~0ull, ~0ull, of, gt, lds, md, ild); }
#pragma unroll
    for (int mi = 0; mi < 2; ++mi) {
        bf16_t* op = nq + ((size_t)b * SEQ + cx.tpos[mi]) * 512 + g * 256 + cx.h * 64 + quad * 4;
#pragma unroll
        for (int di = 0; di < 4; ++di) { u32x2 w; w.x = cvt_pk_bf16(of[mi][di][0], of[mi][di][1]); w.y = cvt_pk_bf16(of[mi][di][2], of[mi][di][3]); *(u32x2*)(op + di * 16) = w; }
    }
}

#define XB_TMO      128
#define XB_XCNT(j)  (256  + 64 * (j))
#define XB_XSUB(j)  (1280 + 64 * (j))
#define XB_XGEN(j)  (2304 + 64 * (j))
#define XB_TOP      3328
#define XB_TOPGEN   3392
#define XCD_BAR_WORDS 3456
#define XB_SPIN_CAP (1u << 18)

__device__ __forceinline__ unsigned xb_ld(unsigned* p)              { return __hip_atomic_load(p, __ATOMIC_RELAXED, __HIP_MEMORY_SCOPE_AGENT); }
__device__ __forceinline__ unsigned xb_add(unsigned* p, unsigned v) { return __hip_atomic_fetch_add(p, v, __ATOMIC_RELAXED, __HIP_MEMORY_SCOPE_AGENT); }
__device__ __forceinline__ unsigned xb_xcc_id() { return (unsigned)__builtin_amdgcn_s_getreg((3 << 11) | 20) & 0xFu; }
#define XB_SPIN(cond, bar) do { unsigned _sp = 0; while (cond) { __builtin_amdgcn_s_sleep(1); \
    if ((++_sp & 255u) == 0u) { if (xb_ld(&(bar)[XB_TMO])) break; if (_sp > XB_SPIN_CAP) { atomicAdd(&(bar)[XB_TMO], 1u); break; } } } } while (0)

struct XcdBarrier {
    unsigned* bar; unsigned x;
    volatile LAS unsigned* st;
};

__device__ __forceinline__ XcdBarrier xcd_barrier_post(unsigned* bar, volatile LAS unsigned* st) {
    XcdBarrier b; b.bar = bar; b.x = xb_xcc_id(); b.st = st;
    if (threadIdx.x == 0) (void)xb_add(&bar[XB_XCNT(b.x)], 1u);
    return b;
}
__device__ __forceinline__ void xcd_barrier_complete(unsigned* bar, unsigned x, unsigned& nloc, unsigned& nx) {
    const unsigned G = gridDim.x * gridDim.y * gridDim.z;
    unsigned sum, cnt, mine, sp = 0u;
    for (;;) {
        sum = 0u; cnt = 0u; mine = 0u;
#pragma unroll
        for (unsigned j = 0; j < 16; ++j) { const unsigned c = xb_ld(&bar[XB_XCNT(j)]); sum += c; cnt += (c > 0u) ? 1u : 0u; mine = (j == x) ? c : mine; }
        if (sum == G) break;
        __builtin_amdgcn_s_sleep(1);
        if ((++sp & 255u) == 0u) { if (xb_ld(&bar[XB_TMO])) break; if (sp > XB_SPIN_CAP) { atomicAdd(&bar[XB_TMO], 1u); break; } }
    }
    nloc = mine > 0u ? mine : 1u; nx = cnt > 0u ? cnt : 1u;
}

__device__ __forceinline__ void xcd_barrier(const XcdBarrier& b) {
    asm volatile("s_waitcnt vmcnt(0)" ::: "memory");
    __syncthreads();
    if (tid_opaque() == 0) {
        unsigned* bar = b.bar;
        __builtin_amdgcn_s_waitcnt(0);
        unsigned nloc = b.st[0], nx = b.st[1];
        if (nloc == 0u) { xcd_barrier_complete(bar, b.x, nloc, nx); b.st[0] = nloc; b.st[1] = nx; }
        const unsigned old = xb_add(&bar[XB_XSUB(b.x)], 1u);
        const unsigned gen = old / nloc;
        if (old + 1u == (gen + 1u) * nloc) {
            __builtin_amdgcn_fence(__ATOMIC_RELEASE, "agent");
            asm volatile("s_waitcnt vmcnt(0)" ::: "memory");
            const unsigned og = xb_add(&bar[XB_TOP], 1u);
            const unsigned tg = og / nx;
            if (og + 1u == (tg + 1u) * nx) xb_add(&bar[XB_TOPGEN], 1u);
            else XB_SPIN(xb_ld(&bar[XB_TOPGEN]) == tg, bar);
            __builtin_amdgcn_fence(__ATOMIC_ACQUIRE, "agent");
            xb_add(&bar[XB_XGEN(b.x)], 1u);
            asm volatile("s_waitcnt vmcnt(0)" ::: "memory");
        } else {
            XB_SPIN(xb_ld(&bar[XB_XGEN(b.x)]) == gen, bar);
            __builtin_amdgcn_fence(__ATOMIC_ACQUIRE, "agent");
            asm volatile("s_waitcnt vmcnt(0)" ::: "memory");
        }
    }
    __syncthreads();
}


#ifndef ST_MASK
#define ST_MASK 0xff
#endif
#define ST_ON(k) ((ST_MASK >> (k)) & 1)
__global__ void __launch_bounds__(512, 2) fwd_kernel(Params pin) {
    extern __shared__ __attribute__((aligned(16))) unsigned char lds_raw[];
    LAS unsigned char* lds = (LAS unsigned char*)lds_raw;
    cg::grid_group grid = cg::this_grid();
    volatile LAS unsigned* bar_st = (volatile LAS unsigned*)(lds + 140000);
    if (threadIdx.x == 0) { bar_st[0] = 0u; bar_st[1] = 0u; }
    __syncthreads();
    const XcdBarrier xbar = xcd_barrier_post((unsigned*)pin.ws, bar_st);
    const int G = gridDim.x;
    for (int ph = pin.ph_lo; ph < pin.ph_hi; ++ph) {
        Params p = pin;
        asm volatile("" : "+s"(p.x), "+s"(p.rel_bias), "+s"(p.lb_logits), "+s"(p.norm_mix), "+s"(p.w_in), "+s"(p.hg_gain), "+s"(p.qk_gain));
        asm volatile("" : "+s"(p.cmp_pos), "+s"(p.cmp_w1), "+s"(p.cmp_b1), "+s"(p.cmp_w2), "+s"(p.w_a), "+s"(p.w_b), "+s"(p.w_out));
        asm volatile("" : "+s"(p.norm_mlp), "+s"(p.w_up), "+s"(p.w_down), "+s"(p.out), "+s"(p.ws));
        unsigned char* ws = p.ws;
        const int bx = bid_opaque();

#ifndef NO_PRO
        if (ph == 0) { prologue(p, lds);
#ifdef DUP_MISC
            __syncthreads(); prologue(p, lds);
#endif
#ifdef DIAG_S00
            if (bx == 0 && threadIdx.x == 0) *(unsigned*)(ws + 512) = 0x7f000000u;
#endif
        }
#else
        if (ph == 0) {}
#endif

#ifdef DIAG_S00
        else if (ph == 15) { if (bx == 0 && threadIdx.x == 0) { const float v = __uint_as_float(__hip_atomic_load((unsigned*)(ws + 512), __ATOMIC_RELAXED, __HIP_MEMORY_SCOPE_AGENT)); p.out[0] += 1000.0f * v + 5.0f; } }
#endif
        else {
            const int layer = (ph - 1) / 7, st = (ph - 1) % 7;
            float* sumsq = (float*)(ws + WS_SUMSQ);
            bf16_t* xb = (bf16_t*)(ws + WS_XB);
            if (st == 0 && ST_ON(0)) {
                pg8::Gemm g{xb, (const bf16_t*)(ws + WS_WIN) + (size_t)layer * NP_IN * DM, T_TOK, NP_IN, DM}; pg8::StaticOrder S; S.init(T_TOK, NP_IN, G, bx);
                pg8::EpiIn E{sumsq, (bf16_t*)(ws + WS_HQ), (bf16_t*)(ws + WS_NQ), (bf16_t*)(ws + WS_KV), (bf16_t*)(ws + WS_NG), (bf16_t*)(ws + WS_SGA), (bf16_t*)(ws + WS_VST), (bf16_t*)(ws + WS_VWT)};
                pg8::gemm_phase<pg8::EpiIn, pg8::StaticOrder, true, true>(lds, g, S, E);
#ifdef DUP_G1
                __syncthreads(); pg8::gemm_phase<pg8::EpiIn, pg8::StaticOrder, true, true>(lds, g, S, E);
#endif
                if (layer == 0) {
                    __syncthreads();
                    const float* EH = (const float*)(ws + WS_EX + EX_H);
                    exact_stage(p.w_in, p.w_in, 99, DM, IN_COLS, (float*)(ws + WS_EX + EX_PP), [=](int r, int k) { return EH[r * 1024 + k]; }, lds);
                }
            } else if (st == 1 && ST_ON(1)) {
                {
                    const int x = bx & 7, i = bx >> 3;
                    const int unit = ((x * 8 + (i >> 2)) << 2) | (i & 3);

#ifndef NO_HGRN
                    if (bx < 256) hgrn_unit(p, layer, unit, lds);
#ifdef DUP_HGRN
                    if (bx < 256) hgrn_unit(p, layer, unit, lds);
#endif
#endif

                }

#ifndef NO_CMP
                for (int u = bx; u < 256; u += G) cmp_unit(p, layer, u, lds);
#ifdef DUP_MISC
                for (int u = bx; u < 256; u += G) cmp_unit(p, layer, u, lds);
#endif
#endif
                if (layer == 0 && bx < 16) exact_mixers(p, bx, lds);

            } else if (st == 2 && ST_ON(2)) {
                hgrn_finalize(p, layer);
#ifdef DUP_MISC
                hgrn_finalize(p, layer);
#endif
                {
                    const int x = bx & 7, i = bx >> 3;
#ifdef DUP_ATTN
                    for (int r2 = 0; r2 < 16; ++r2) { const int r = r2 & 7;
#else
                    for (int r = 0; r < 8; ++r) {
#endif
                        const int pair = x * 4 + (r >> 1);
                        const int qt = (r & 1) ? (63 - i) : i;

#ifndef NO_ATTN
                        attn_unit(p, layer, pair >> 1, pair & 1, qt, lds);
#endif

                    }
                }
                if (layer == 0) {
                    __syncthreads();
                    const float* OAB = (const float*)(ws + WS_EX + EX_OAB);
                    exact_stage(p.w_a, p.w_b, 2, 1024, DM, (float*)(ws + WS_EX + EX_YP), [=](int r, int k) { return OAB[r * 1024 + k]; }, lds);
                }
            } else if (st == 3 && ST_ON(3)) {
                {
                    pg8::Gemm g{(const bf16_t*)(ws + WS_HI), (const bf16_t*)(ws + WS_WA) + (size_t)layer * DM * 512, T_TOK, DM, 512}; pg8::StaticOrder S; S.init(T_TOK, DM, G, bx);
                    pg8::EpiMix<false> E{(const bf16_t*)(ws + WS_SGA), (bf16_t*)(ws + WS_MIXED)};
                    pg8::gemm_phase<pg8::EpiMix<false>, pg8::StaticOrder, true, true>(lds, g, S, E);
                }
                __syncthreads();
                {
                    pg8::Gemm g{(const bf16_t*)(ws + WS_NQ), (const bf16_t*)(ws + WS_WB) + (size_t)layer * DM * 512, T_TOK, DM, 512}; pg8::StaticOrder S; S.init(T_TOK, DM, G, bx);
                    pg8::EpiMix<true> E{(const bf16_t*)(ws + WS_SGB), (bf16_t*)(ws + WS_MIXED)};
                    pg8::gemm_phase<pg8::EpiMix<true>, pg8::StaticOrder, true, true>(lds, g, S, E);
                }
                if (layer == 0) {
                    __syncthreads();
                    const float* PP = (const float*)(ws + WS_EX + EX_PP); const float* YP = (const float*)(ws + WS_EX + EX_YP);
                    exact_stage(p.w_out, p.w_out, 99, DM, DM, (float*)(ws + WS_EX + EX_XP), [=](int r, int k) {
                        const float ga = ex_pp(PP, r, 3352 + k), gb = ex_pp(PP, r, 4376 + k);
                        const float ya = YP[(size_t)r * 1024 + k] + YP[(size_t)(16 + r) * 1024 + k], yb = YP[(size_t)(32 + r) * 1024 + k] + YP[(size_t)(48 + r) * 1024 + k];
                        return ya / (1.0f + __expf(-ga)) + yb / (1.0f + __expf(-gb)); }, lds);
                }
            } else if ((st == 4 || st == 6) && ST_ON(4)) {
                const bool down = (st == 6);
                pg8::Gemm g{down ? (const bf16_t*)(ws + WS_HID) : (const bf16_t*)(ws + WS_MIXED),
                            down ? (const bf16_t*)(ws + WS_WDN) + (size_t)layer * DM * DFF : (const bf16_t*)(ws + WS_WO) + (size_t)layer * DM * DM, T_TOK, DM, down ? DFF : DM};
                pg8::StaticOrder S; S.init(T_TOK, DM, G, bx);
                pg8::EpiRes E{p.out, xb, sumsq, down && layer == 1};
                pg8::gemm_phase<pg8::EpiRes, pg8::StaticOrder, true, true>(lds, g, S, E);
                if (layer == 0 && !down) {
                    __syncthreads();
                    LAS float* RS = (LAS float*)(lds + 16384); LAS float* red = (LAS float*)(lds + 32768);
                    const int tid2 = threadIdx.x;
#pragma unroll 1
                    for (int r = 0; r < ((bx < 32) ? 16 : 0); ++r) {
                        const float a = ex_x1(p, r, tid2), b2 = ex_x1(p, r, 512 + tid2);
                        const float ss = block_sum(a * a + b2 * b2, red, tid2);
                        if (tid2 == 0) RS[r] = rsqrtf(ss * (1.0f / 1024.0f) + 1e-6f);
                    }
                    __syncthreads();
                    const Params pc = p; const float* nm2 = p.norm_mlp;
                    exact_stage(p.w_up, p.w_up, 99, DM, DFF, (float*)(ws + WS_EX + EX_UP), [=](int r, int k) { return ex_x1(pc, r, k) * RS[r] * nm2[k]; }, lds);
                }
            } else if (st == 5 && ST_ON(5)) {
                pg8::Gemm g{xb, (const bf16_t*)(ws + WS_WUP) + (size_t)layer * DFF * DM, T_TOK, DFF, DM}; pg8::StaticOrder S; S.init(T_TOK, DFF, G, bx);
                pg8::EpiUp E{sumsq, (bf16_t*)(ws + WS_HID)};
                pg8::gemm_phase<pg8::EpiUp, pg8::StaticOrder, true, true>(lds, g, S, E);
#ifdef DUP_G4
                __syncthreads(); pg8::gemm_phase<pg8::EpiUp, pg8::StaticOrder, true, true>(lds, g, S, E);
#endif
                if (layer == 0) {
                    __syncthreads();
                    const float* UP = (const float*)(ws + WS_EX + EX_UP);
                    exact_stage(p.w_down, p.w_down, 99, DFF, DM, (float*)(ws + WS_EX + EX_DP), [=](int r, int k) {
                        const float u = (UP[(size_t)r * DFF + k] + UP[(size_t)(16 + r) * DFF + k]) + (UP[(size_t)(32 + r) * DFF + k] + UP[(size_t)(48 + r) * DFF + k]);
                        const float t = fmaxf(u, 0.f); return t * t; }, lds);
                }
            }
        }
        if (ph + 1 < pin.ph_hi) {
            if (ph == pin.ph_lo) {
                asm volatile("s_waitcnt vmcnt(0) lgkmcnt(0)" ::: "memory");
                grid.sync();
                __builtin_amdgcn_fence(__ATOMIC_ACQUIRE, "agent");
                asm volatile("s_waitcnt vmcnt(0)" ::: "memory");
            } else {
                xcd_barrier(xbar);
#ifdef DUP_SYNC
                xcd_barrier(xbar); xcd_barrier(xbar);
#endif
            }
        }
    }
}

#ifdef DIAG_S00
constexpr int N_PHASES = 16;
#else
constexpr int N_PHASES = 15;
#endif
#ifndef ONE_LAUNCH
#define ONE_LAUNCH 1
#endif

extern "C" void kernel_launch(void* const* d_in, const int* in_sizes, int n_in, void* d_out, int out_size, void* d_ws, size_t ws_size, hipStream_t stream) {
    static int ready = 0;
    if (ready == 0) {
        if (n_in != 17 || out_size != T_TOK * DM || ws_size < WS_END) { fprintf(stderr, "kernel_launch: unexpected shapes: n_in %d out %d ws %zu (need %zu)\n", n_in, out_size, ws_size, (size_t)WS_END); ready = -1; return; }
        if (hipFuncSetAttribute((const void*)fwd_kernel, hipFuncAttributeMaxDynamicSharedMemorySize, LDS_BYTES) != hipSuccess) { fprintf(stderr, "kernel_launch: hipFuncSetAttribute failed\n"); ready = -1; return; }
        int per_cu = 0;
        if (hipOccupancyMaxActiveBlocksPerMultiprocessor(&per_cu, (const void*)fwd_kernel, 512, LDS_BYTES) != hipSuccess || per_cu < 1) fprintf(stderr, "kernel_launch: occupancy query says %d blocks per CU\n", per_cu);
        (void)hipGetLastError();
        ready = 1;
    }
    if (ready < 0) return;
    Params p{};
    p.x = (const float*)d_in[0]; p.rel_bias = (const float*)d_in[1]; p.lb_logits = (const float*)d_in[2]; p.norm_mix = (const float*)d_in[3]; p.w_in = (const float*)d_in[4];
    p.hg_gain = (const float*)d_in[5]; p.qk_gain = (const float*)d_in[6]; p.cmp_pos = (const float*)d_in[7]; p.cmp_w1 = (const float*)d_in[8]; p.cmp_b1 = (const float*)d_in[9];
    p.cmp_w2 = (const float*)d_in[10]; p.w_a = (const float*)d_in[11]; p.w_b = (const float*)d_in[12]; p.w_out = (const float*)d_in[13]; p.norm_mlp = (const float*)d_in[14];
    p.w_up = (const float*)d_in[15]; p.w_down = (const float*)d_in[16];
    p.out = (float*)d_out; p.ws = (unsigned char*)d_ws;
    if (hipMemsetAsync(d_ws, 0, 16384, stream) != hipSuccess) { fprintf(stderr, "kernel_launch: hipMemsetAsync failed\n"); return; }
#if ONE_LAUNCH
    p.ph_lo = 0; p.ph_hi = N_PHASES;
    void* args[] = {&p};
    hipError_t e = hipLaunchCooperativeKernel((const void*)fwd_kernel, dim3(256), dim3(512), args, LDS_BYTES, stream);
    if (e != hipSuccess) fprintf(stderr, "kernel_launch: cooperative launch failed: %s\n", hipGetErrorString(e));
#else
    for (int ph = 0; ph < N_PHASES; ++ph) {
        p.ph_lo = ph; p.ph_hi = ph + 1;
        hipLaunchKernelGGL(fwd_kernel, dim3(256), dim3(512), LDS_BYTES, stream, p);
    }
#endif
}
```

```cpp
#include <hip/hip_runtime.h>
#include <hip/hip_cooperative_groups.h>
#include <cstdio>
#include <cstdint>
namespace cg = cooperative_groups;
namespace pg8 {
#define PG8_LAS __attribute__((address_space(3)))
typedef unsigned short bf16_t;
typedef short bf16x8 __attribute__((ext_vector_type(8)));
typedef float f32x4 __attribute__((ext_vector_type(4)));
typedef unsigned u32x4 __attribute__((ext_vector_type(4)));
constexpr int BM = 256, BK = 64, HALF = 128, HTB = HALF * BK * 2  , STAGE_BYTES = 8 * HTB, NXCD = 8, WGM = 8;

__host__ __device__ __forceinline__ int lds_byte(int r, int c) { const int st = (r >> 4) * 2 + (c >> 5), rr = r & 15, cc = c & 31, ob = rr * 64 + cc * 2; return st * 1024 + (ob ^ (((ob >> 9) & 1) << 5)); }
__host__ __device__ __forceinline__ void stage_rc(int b, int& R, int& C) { const int st = b / 1024, sb = b % 1024, swz = sb ^ (((sb >> 9) & 1) << 5); R = (st >> 1) * 16 + swz / 64; C = (st & 1) * 32 + (swz % 64) / 2; }
__host__ __device__ __forceinline__ int perm32(int rho) { const int n = rho >> 4, i = rho & 15; return 8 * (i >> 2) + 4 * n + (i & 3); }

struct Unit { int pm, pn; };
struct Gemm { const bf16_t* A; const bf16_t* Bt; int M, N, K; };

struct StaticOrder {
    int nM, nN, nwg, G, c;
    __host__ __device__ void init(int M, int N, int G_, int c_) { nM = M / BM; nN = N / BM; nwg = nM * nN; G = G_; c = c_; }
    __host__ __device__ bool next(int i, Unit& u) const {
        const long L = (long)i * G + c; if (L >= nwg) return false;
        int wgid = (int)L; { const int q = nwg / NXCD, r = nwg % NXCD, xcd = wgid % NXCD, off = wgid / NXCD; wgid = (xcd < r ? xcd * (q + 1) : r * (q + 1) + (xcd - r) * q) + off; }
        const int nig = WGM * nN, gid = wgid / nig, fm = gid * WGM, gsz = (nM - fm) < WGM ? (nM - fm) : WGM;
        u.pm = fm + ((wgid % nig) % gsz); u.pn = (wgid % nig) / gsz; return true;
    }
    __device__ __forceinline__ void a_ready(const Unit&) const {}
    __device__ __forceinline__ void done(const Unit&) const {}
};

typedef float f32x2c __attribute__((ext_vector_type(2)));
typedef __bf16 bf16x2c __attribute__((ext_vector_type(2)));
__device__ __forceinline__ unsigned cvt_pk_bf16(float lo, float hi) { const f32x2c v = {lo, hi}; const bf16x2c b = __builtin_convertvector(v, bf16x2c); return __builtin_bit_cast(unsigned, b); }
__device__ __forceinline__ float bf_lo(unsigned w) { return __uint_as_float(w << 16); }
__device__ __forceinline__ float bf_hi(unsigned w) { return __uint_as_float(w & 0xffff0000u); }
__device__ __forceinline__ float sigm(float v) { return __builtin_amdgcn_rcpf(1.0f + __expf(-v)); }

__device__ __forceinline__ void row_rstd8(const float* sumsq, const Unit& u, int wr, int fr, int fq, float (&rs)[2][4]) {
#pragma unroll
    for (int ai = 0; ai < 2; ++ai)
#pragma unroll
        for (int m = 0; m < 4; ++m) {
            const int row = u.pm * BM + ai * HALF + wr * 64 + m * 16 + fr;
            const f32x4 v = *(const f32x4*)(sumsq + (size_t)row * 16 + fq * 4);
            float s = (v[0] + v[1]) + (v[2] + v[3]);
            s += __shfl_xor(s, 16); s += __shfl_xor(s, 32);
            rs[ai][m] = rsqrtf(s * (1.0f / 1024.0f) + 1e-6f);
            if (m == 3) asm volatile("" ::: "memory");
        }
}

struct EpiIn {
    static constexpr bool PERM = true, AFTER_DRAIN = false;
    const float* sumsq; bf16_t *HQ, *NQ, *KV, *NG, *SGA, *VST, *VWT;
    __device__ __forceinline__ void operator()(const f32x4 (&acc)[2][2][4][2], const Unit& u, int wr, int wc, int fr, int fq) const {
        float rs[2][4]; row_rstd8(sumsq, u, wr, fr, fq, rs);
        const int pn = u.pn; bf16_t* base; int ldc, colt; bool sg = false;
        if (pn < 8) { base = HQ + (size_t)(pn >> 1) * ((size_t)65536 * 512); ldc = 512; colt = (pn & 1) * 256; }
        else if (pn < 10) { base = NQ; ldc = 512; colt = (pn - 8) * 256; }
        else if (pn < 13) { base = KV; ldc = 768; colt = (pn - 10) * 256; }
        else if (pn == 13) { base = NG; ldc = 256; colt = 0; sg = true; }
        else { const int q = pn - 14; base = SGA + (size_t)(q >> 2) * ((size_t)65536 * 1024); ldc = 1024; colt = (q & 3) * 256; sg = true; }
        const int col0 = colt + wc * 32 + 8 * fq;
        bf16_t* vt = (pn == 11) ? VST : ((pn == 12) ? VWT : nullptr);
#pragma unroll
        for (int ai = 0; ai < 2; ++ai)
#pragma unroll
            for (int m = 0; m < 4; ++m) {
                const int row = u.pm * BM + ai * HALF + wr * 64 + m * 16 + fr;
                bf16_t* rowp = base + (size_t)row * ldc + col0; const float r = rs[ai][m];
#pragma unroll
                for (int bj = 0; bj < 2; ++bj) {
                    f32x4 v0 = acc[ai][bj][m][0] * r, v1 = acc[ai][bj][m][1] * r;
                    if (sg) {
#pragma unroll
                        for (int e = 0; e < 4; ++e) { v0[e] = sigm(v0[e]); v1[e] = sigm(v1[e]); }
                    }
                    u32x4 w; w.x = cvt_pk_bf16(v0[0], v0[1]); w.y = cvt_pk_bf16(v0[2], v0[3]); w.z = cvt_pk_bf16(v1[0], v1[1]); w.w = cvt_pk_bf16(v1[2], v1[3]);
                    *(u32x4*)(rowp + bj * HALF) = w;
                    if (vt != nullptr && bj == 1) {
                        const int cv = wc * 32 + 8 * fq, g = cv >> 6, d0 = cv & 63, b = row >> 12, t = row & 4095;
                        bf16_t* tp = vt + (((size_t)(b * 2 + g) * 64 + d0) << 12) + t;
                        tp[0 * 4096] = (bf16_t)(w.x & 0xffffu); tp[1 * 4096] = (bf16_t)(w.x >> 16); tp[2 * 4096] = (bf16_t)(w.y & 0xffffu); tp[3 * 4096] = (bf16_t)(w.y >> 16);
                        tp[4 * 4096] = (bf16_t)(w.z & 0xffffu); tp[5 * 4096] = (bf16_t)(w.z >> 16); tp[6 * 4096] = (bf16_t)(w.w & 0xffffu); tp[7 * 4096] = (bf16_t)(w.w >> 16);
                    }
                }
                asm volatile("" ::: "memory");
            }
    }
};

template <bool ACCUM> struct EpiMix {
    static constexpr bool PERM = true, AFTER_DRAIN = false;
    const bf16_t* gate; bf16_t* mixed;
    __device__ __forceinline__ void operator()(const f32x4 (&acc)[2][2][4][2], const Unit& u, int wr, int wc, int fr, int fq) const {
        const int col0 = u.pn * BM + wc * 32 + 8 * fq;
#pragma unroll
        for (int ai = 0; ai < 2; ++ai)
#pragma unroll
            for (int m = 0; m < 4; ++m) {
                const size_t off = (size_t)(u.pm * BM + ai * HALF + wr * 64 + m * 16 + fr) * 1024 + col0;
#pragma unroll
                for (int bj = 0; bj < 2; ++bj) {
                    const u32x4 gq = *(const u32x4*)(gate + off + bj * HALF);
                    f32x4 v0 = acc[ai][bj][m][0], v1 = acc[ai][bj][m][1];
                    v0[0] *= bf_lo(gq.x); v0[1] *= bf_hi(gq.x); v0[2] *= bf_lo(gq.y); v0[3] *= bf_hi(gq.y);
                    v1[0] *= bf_lo(gq.z); v1[1] *= bf_hi(gq.z); v1[2] *= bf_lo(gq.w); v1[3] *= bf_hi(gq.w);
                    if (ACCUM) {
                        const u32x4 mq = *(const u32x4*)(mixed + off + bj * HALF);
                        v0[0] += bf_lo(mq.x); v0[1] += bf_hi(mq.x); v0[2] += bf_lo(mq.y); v0[3] += bf_hi(mq.y);
                        v1[0] += bf_lo(mq.z); v1[1] += bf_hi(mq.z); v1[2] += bf_lo(mq.w); v1[3] += bf_hi(mq.w);
                    }
                    u32x4 w; w.x = cvt_pk_bf16(v0[0], v0[1]); w.y = cvt_pk_bf16(v0[2], v0[3]); w.z = cvt_pk_bf16(v1[0], v1[1]); w.w = cvt_pk_bf16(v1[2], v1[3]);
                    *(u32x4*)(mixed + off + bj * HALF) = w;
                }
                asm volatile("" ::: "memory");
            }
    }
};

struct EpiRes {
    static constexpr bool PERM = true, AFTER_DRAIN = false;
    float* out; bf16_t* xb; float* sumsq; bool FINAL;
    __device__ __forceinline__ void operator()(const f32x4 (&acc)[2][2][4][2], const Unit& u, int wr, int wc, int fr, int fq) const {
        const int col0 = u.pn * BM + wc * 32 + 8 * fq;
#pragma unroll
        for (int ai = 0; ai < 2; ++ai)
#pragma unroll
            for (int m = 0; m < 4; ++m) {
                const int row = u.pm * BM + ai * HALF + wr * 64 + m * 16 + fr;
                const size_t off = (size_t)row * 1024 + col0; float ss = 0.f;
#pragma unroll
                for (int bj = 0; bj < 2; ++bj) {
                    const u32x4 xq = *(const u32x4*)(xb + off + bj * HALF);
                    f32x4 v0 = acc[ai][bj][m][0], v1 = acc[ai][bj][m][1];
                    v0[0] += bf_lo(xq.x); v0[1] += bf_hi(xq.x); v0[2] += bf_lo(xq.y); v0[3] += bf_hi(xq.y);
                    v1[0] += bf_lo(xq.z); v1[1] += bf_hi(xq.z); v1[2] += bf_lo(xq.w); v1[3] += bf_hi(xq.w);
                    if (FINAL) { *(f32x4*)(out + off + bj * HALF) = v0; *(f32x4*)(out + off + bj * HALF + 4) = v1; }
                    else {
                        u32x4 w; w.x = cvt_pk_bf16(v0[0], v0[1]); w.y = cvt_pk_bf16(v0[2], v0[3]); w.z = cvt_pk_bf16(v1[0], v1[1]); w.w = cvt_pk_bf16(v1[2], v1[3]);
                        *(u32x4*)(xb + off + bj * HALF) = w;
                        ss += (v0[0] * v0[0] + v0[1] * v0[1]) + (v0[2] * v0[2] + v0[3] * v0[3]) + (v1[0] * v1[0] + v1[1] * v1[1]) + (v1[2] * v1[2] + v1[3] * v1[3]);
                    }
                }
                if (!FINAL) { ss += __shfl_xor(ss, 16); ss += __shfl_xor(ss, 32); if (fq == 0) sumsq[(size_t)row * 16 + u.pn * 4 + wc] = ss; }
                asm volatile("" ::: "memory");
            }
    }
};

struct EpiUp {
    static constexpr bool PERM = true, AFTER_DRAIN = false;
    const float* sumsq; bf16_t* hid;
    __device__ __forceinline__ void operator()(const f32x4 (&acc)[2][2][4][2], const Unit& u, int wr, int wc, int fr, int fq) const {
        float rs[2][4]; row_rstd8(sumsq, u, wr, fr, fq, rs);
        const int col0 = u.pn * BM + wc * 32 + 8 * fq;
#pragma unroll
        for (int ai = 0; ai < 2; ++ai)
#pragma unroll
            for (int m = 0; m < 4; ++m) {
                bf16_t* rowp = hid + (size_t)(u.pm * BM + ai * HALF + wr * 64 + m * 16 + fr) * 4096 + col0; const float r = rs[ai][m];
#pragma unroll
                for (int bj = 0; bj < 2; ++bj) {
                    f32x4 v0 = acc[ai][bj][m][0] * r, v1 = acc[ai][bj][m][1] * r;
#pragma unroll
                    for (int e = 0; e < 4; ++e) { const float a = fmaxf(v0[e], 0.f), b = fmaxf(v1[e], 0.f); v0[e] = a * a; v1[e] = b * b; }
                    u32x4 w; w.x = cvt_pk_bf16(v0[0], v0[1]); w.y = cvt_pk_bf16(v0[2], v0[3]); w.z = cvt_pk_bf16(v1[0], v1[1]); w.w = cvt_pk_bf16(v1[2], v1[3]);
                    *(u32x4*)(rowp + bj * HALF) = w;
                }
                asm volatile("" ::: "memory");
            }
    }
};

template <class Epi, class Sched, bool ALIGN_EPI = false, bool SP2 = false>
__device__ __forceinline__ void gemm_phase(PG8_LAS unsigned char* lds, const Gemm g, const Sched& S, const Epi& E) {
    int tid_ = threadIdx.x; asm volatile("" : "+v"(tid_));
    const int tid = tid_, wid = __builtin_amdgcn_readfirstlane(tid >> 6), lane = tid & 63, wr = wid >> 2, wc = wid & 3, fr = lane & 15, fq = lane >> 4;
    const int K = g.K, nt = K / BK;
    unsigned voffA[2], voffB[2];
#pragma unroll
    for (int i = 0; i < 2; ++i) { int R, C; stage_rc(tid * 16 + i * 8192, R, C); const int Rb = Epi::PERM ? ((R & ~31) + perm32(R & 31)) : R;
        voffA[i] = (unsigned)(R * K + C) * 2u; voffB[i] = (unsigned)(Rb * K + C) * 2u; }
    const size_t kstep = (size_t)(BK * 2);
    const size_t hstep = (size_t)HALF * K * 2;
    const size_t tstep = 2 * hstep;
    const unsigned ldsw = (unsigned)wid * 1024u;
    const int aoff = lds_byte(wr * 64 + fr, fq * 8), boff = lds_byte(wc * 32 + fr, fq * 8);
#define PG8_SA(b, h) (((b) * 2 + (h)) * HTB)
#define PG8_SB(b, h) ((4 + (b) * 2 + (h)) * HTB)
#define PG8_STAGE(bufoff, gbase, voff) do { _Pragma("unroll") for (int _i = 0; _i < 2; ++_i) \
        __builtin_amdgcn_global_load_lds((const unsigned*)((const char*)(gbase) + (voff)[_i]), (PG8_LAS unsigned*)(lds + (bufoff) + ldsw + _i * 8192), 16, 0, 0); } while (0)
#define PG8_LDA(dst, b, h) do { _Pragma("unroll") for (int m = 0; m < 4; ++m) _Pragma("unroll") for (int k = 0; k < 2; ++k) dst[m][k] = *(const PG8_LAS bf16x8*)(lds + PG8_SA(b, h) + aoff + m * 2048 + k * 1024); } while (0)
#define PG8_LDB(dst, b, h) do { _Pragma("unroll") for (int n = 0; n < 2; ++n) _Pragma("unroll") for (int k = 0; k < 2; ++k) dst[n][k] = *(const PG8_LAS bf16x8*)(lds + PG8_SB(b, h) + boff + n * 2048 + k * 1024); } while (0)
#define PG8_MMA(ai, bj, At, Bt) do { __builtin_amdgcn_s_setprio(1); _Pragma("unroll") for (int m = 0; m < 4; ++m) _Pragma("unroll") for (int n = 0; n < 2; ++n) _Pragma("unroll") for (int k = 0; k < 2; ++k) \
        acc[ai][bj][m][n] = __builtin_amdgcn_mfma_f32_16x16x32_bf16(Bt[n][k], At[m][k], acc[ai][bj][m][n], 0, 0, 0); __builtin_amdgcn_s_setprio(0); } while (0)
#define PG8_WAIT_V(n) asm volatile("s_waitcnt vmcnt(" #n ")" ::: "memory")
#define PG8_WAIT_L(n) asm volatile("s_waitcnt lgkmcnt(" #n ")" ::: "memory")
#define PG8_BAR __builtin_amdgcn_s_barrier()
#define PG8_SCHED __builtin_amdgcn_sched_barrier(0)
    Unit cur, nxt; int ui = 0;
    if (!S.next(0, cur)) return;
    f32x4 acc[2][2][4][2];
#pragma unroll
    for (int a = 0; a < 2; ++a)
#pragma unroll
        for (int b = 0; b < 2; ++b)
#pragma unroll
            for (int m = 0; m < 4; ++m)
#pragma unroll
                for (int n = 0; n < 2; ++n) acc[a][b][m][n] = (f32x4){0.f, 0.f, 0.f, 0.f};
    bf16x8 At[4][2], B0[2][2], B1[2][2];
    const char* cA = (const char*)g.A + (size_t)cur.pm * tstep; const char* cB = (const char*)g.Bt + (size_t)cur.pn * tstep;
    S.a_ready(cur);
    if constexpr (SP2) {
        PG8_STAGE(PG8_SB(0, 0), cB, voffB); PG8_STAGE(PG8_SB(0, 1), cB + hstep, voffB); PG8_STAGE(PG8_SA(0, 0), cA, voffA); PG8_STAGE(PG8_SA(0, 1), cA + hstep, voffA);
        if (wr == 1) PG8_BAR;
        PG8_WAIT_V(2); PG8_BAR;
        PG8_STAGE(PG8_SB(1, 0), cB + kstep, voffB); PG8_STAGE(PG8_SA(1, 0), cA + kstep, voffA); PG8_STAGE(PG8_SB(1, 1), cB + hstep + kstep, voffB);
        PG8_WAIT_V(6); PG8_BAR;
    } else {
        PG8_STAGE(PG8_SB(0, 0), cB, voffB); PG8_STAGE(PG8_SA(0, 0), cA, voffA); PG8_STAGE(PG8_SB(0, 1), cB + hstep, voffB); PG8_STAGE(PG8_SA(0, 1), cA + hstep, voffA);
        if (wr == 1) PG8_BAR;
        PG8_WAIT_V(4); PG8_BAR;
        PG8_STAGE(PG8_SB(1, 0), cB + kstep, voffB); PG8_STAGE(PG8_SA(1, 0), cA + kstep, voffA); PG8_STAGE(PG8_SB(1, 1), cB + hstep + kstep, voffB);
        PG8_WAIT_V(6); PG8_BAR;
    }
    for (;;) {
        const bool has_next = S.next(ui + 1, nxt);
        const char* nA = has_next ? (const char*)g.A + (size_t)nxt.pm * tstep : cA; const char* nB = has_next ? (const char*)g.Bt + (size_t)nxt.pn * tstep : cB;
        for (int t = 0; t < nt; t += 2) {
            const bool last = (t == nt - 2);
            const char* a1 = cA + (size_t)(t + 1) * kstep;
            const char* a2 = last ? nA : cA + (size_t)(t + 2) * kstep; const char* b2 = last ? nB : cB + (size_t)(t + 2) * kstep;
            const char* a3 = a2 + kstep; const char* b3 = b2 + kstep;
            if (last && has_next) S.a_ready(nxt);
            if constexpr (SP2) {
            PG8_LDB(B0, 0, 0); PG8_LDB(B1, 0, 1); PG8_SCHED; PG8_LDA(At, 0, 0); PG8_STAGE(PG8_SA(1, 1), a1 + hstep, voffA);
            PG8_WAIT_V(8); PG8_WAIT_L(0); PG8_BAR; PG8_MMA(0, 0, At, B0); PG8_MMA(0, 1, At, B1); PG8_BAR; PG8_SCHED;
            PG8_LDA(At, 0, 1); PG8_STAGE(PG8_SB(0, 0), b2, voffB); PG8_STAGE(PG8_SB(0, 1), b2 + hstep, voffB); PG8_STAGE(PG8_SA(0, 0), a2, voffA);
            PG8_WAIT_V(8); PG8_WAIT_L(0); PG8_BAR; PG8_MMA(1, 0, At, B0); PG8_MMA(1, 1, At, B1); PG8_BAR; PG8_SCHED;
            PG8_LDB(B0, 1, 0); PG8_LDB(B1, 1, 1); PG8_SCHED; PG8_LDA(At, 1, 0); PG8_STAGE(PG8_SA(0, 1), a2 + hstep, voffA);
            PG8_WAIT_V(8); PG8_WAIT_L(0); PG8_BAR; PG8_MMA(0, 0, At, B0); PG8_MMA(0, 1, At, B1); PG8_BAR; PG8_SCHED;
            PG8_LDA(At, 1, 1); PG8_STAGE(PG8_SB(1, 0), b3, voffB); PG8_STAGE(PG8_SB(1, 1), b3 + hstep, voffB); PG8_STAGE(PG8_SA(1, 0), a3, voffA);
            PG8_WAIT_V(8); PG8_WAIT_L(0); PG8_BAR; PG8_MMA(1, 0, At, B0); PG8_MMA(1, 1, At, B1); PG8_BAR; PG8_SCHED;
            } else {
            PG8_LDB(B0, 0, 0); PG8_SCHED; PG8_LDA(At, 0, 0); PG8_STAGE(PG8_SA(1, 1), a1 + hstep, voffA);
            PG8_WAIT_L(8); PG8_BAR; PG8_WAIT_L(0); PG8_MMA(0, 0, At, B0); PG8_BAR; PG8_SCHED;
            PG8_LDB(B1, 0, 1); PG8_STAGE(PG8_SB(0, 0), b2, voffB);
            PG8_BAR; PG8_WAIT_L(0); PG8_MMA(0, 1, At, B1); PG8_BAR;
            PG8_LDA(At, 0, 1); PG8_STAGE(PG8_SA(0, 0), a2, voffA);
            PG8_BAR; PG8_WAIT_L(0); PG8_MMA(1, 0, At, B0); PG8_BAR; PG8_SCHED;
            PG8_STAGE(PG8_SB(0, 1), b2 + hstep, voffB);
            PG8_WAIT_V(6); PG8_BAR; PG8_MMA(1, 1, At, B1); PG8_BAR;
            PG8_LDB(B0, 1, 0); PG8_SCHED; PG8_LDA(At, 1, 0); PG8_STAGE(PG8_SA(0, 1), a2 + hstep, voffA);
            PG8_WAIT_L(8); PG8_BAR; PG8_WAIT_L(0); PG8_MMA(0, 0, At, B0); PG8_BAR; PG8_SCHED;
            PG8_LDB(B1, 1, 1); PG8_STAGE(PG8_SB(1, 0), b3, voffB);
            PG8_BAR; PG8_WAIT_L(0); PG8_MMA(0, 1, At, B1); PG8_BAR;
            PG8_LDA(At, 1, 1); PG8_STAGE(PG8_SA(1, 0), a3, voffA);
            PG8_BAR; PG8_WAIT_L(0); PG8_MMA(1, 0, At, B0); PG8_BAR; PG8_SCHED;
            PG8_STAGE(PG8_SB(1, 1), b3 + hstep, voffB);
            PG8_WAIT_V(6); PG8_BAR; PG8_MMA(1, 1, At, B1); PG8_BAR;
            }
        }
        if constexpr (ALIGN_EPI) { if (wr == 0) PG8_BAR; }
        if constexpr (!Epi::AFTER_DRAIN) { E(acc, cur, wr, wc, fr, fq); S.done(cur); }
        if (!has_next) break;
#pragma unroll
        for (int a = 0; a < 2; ++a)
#pragma unroll
            for (int b = 0; b < 2; ++b)
#pragma unroll
                for (int m = 0; m < 4; ++m)
#pragma unroll
                    for (int n = 0; n < 2; ++n) acc[a][b][m][n] = (f32x4){0.f, 0.f, 0.f, 0.f};
        cur = nxt; cA = nA; cB = nB; ++ui;
        if constexpr (ALIGN_EPI) { if (wr == 1) PG8_BAR; }
    }
    PG8_WAIT_V(0);
    if constexpr (!ALIGN_EPI) { if (wr == 0) PG8_BAR; }
    PG8_BAR;
    if constexpr (Epi::AFTER_DRAIN) { E.fused(acc, cur, wr, wc, fr, fq, lds, wid, lane); S.done(cur); }
#undef PG8_SA
#undef PG8_SB
#undef PG8_STAGE
#undef PG8_LDA
#undef PG8_LDB
#undef PG8_MMA
#undef PG8_WAIT_V
#undef PG8_WAIT_L
#undef PG8_BAR
#undef PG8_SCHED
}
}

#define LAS __attribute__((address_space(3)))
typedef unsigned short bf16_t;
typedef short bf16x8 __attribute__((ext_vector_type(8)));
typedef short bf16x4 __attribute__((ext_vector_type(4)));
typedef float f32x4 __attribute__((ext_vector_type(4)));
typedef unsigned u32x4 __attribute__((ext_vector_type(4)));
typedef unsigned u32x2 __attribute__((ext_vector_type(2)));
using pg8::cvt_pk_bf16; using pg8::bf_lo; using pg8::bf_hi; using pg8::sigm;

constexpr int T_TOK = 65536, DM = 1024, SEQ = 4096, NB = 16, DFF = 4096, NP_IN = 5632, IN_COLS = 5400;
constexpr int LDS_BYTES = 147456;
constexpr size_t MiB = (size_t)1 << 20;
constexpr size_t WS_CBIAS = 1 * MiB, WS_CW2T = 1 * MiB + 65536;
constexpr size_t WS_WIN = 2 * MiB, WS_WA = 24 * MiB, WS_WB = 26 * MiB, WS_WO = 28 * MiB, WS_WUP = 32 * MiB, WS_WDN = 48 * MiB, WS_CW1T = 64 * MiB;
constexpr size_t WS_SUMSQ = 66 * MiB, WS_KCMP = 70 * MiB, WS_VCMPT = 71 * MiB, WS_VST = 72 * MiB, WS_VWT = 88 * MiB, WS_XB = 104 * MiB;
constexpr size_t WS_HQ = 232 * MiB, WS_HF = 296 * MiB, WS_HI = 360 * MiB, WS_HG = 424 * MiB, WS_NQ = 488 * MiB, WS_KV = 552 * MiB, WS_NG = 648 * MiB, WS_SGA = 680 * MiB, WS_SGB = 808 * MiB;
constexpr size_t WS_MIXED = 232 * MiB, WS_HID = 232 * MiB, WS_EX = 936 * MiB, WS_TMP = 944 * MiB, WS_END = 1008 * MiB;
constexpr size_t EX_H = 0, EX_PP = 1 * MiB, EX_OAB = 2 * MiB + 524288, EX_YP = EX_OAB + 65536, EX_XP = EX_OAB + 524288, EX_UP = 3 * MiB + 524288, EX_DP = 4 * MiB + 524288;

struct Params {
    const float *x, *rel_bias, *lb_logits, *norm_mix, *w_in, *hg_gain, *qk_gain, *cmp_pos, *cmp_w1, *cmp_b1, *cmp_w2, *w_a, *w_b, *w_out, *norm_mlp, *w_up, *w_down;
    float* out; unsigned char* ws; int ph_lo, ph_hi;
};

__device__ __forceinline__ bf16x8 lds_ld8(const LAS unsigned char* p) { return *(const LAS bf16x8*)p; }
__device__ __forceinline__ bf16x8 lds_ld4x2(const LAS unsigned char* p0, const LAS unsigned char* p1) {
    const bf16x4 a = *(const LAS bf16x4*)p0, b = *(const LAS bf16x4*)p1; bf16x8 r;
    r[0] = a[0]; r[1] = a[1]; r[2] = a[2]; r[3] = a[3]; r[4] = b[0]; r[5] = b[1]; r[6] = b[2]; r[7] = b[3]; return r;
}
__device__ __forceinline__ bf16x8 pack8(const f32x4& a, const f32x4& b) {
    u32x4 w; w.x = cvt_pk_bf16(a[0], a[1]); w.y = cvt_pk_bf16(a[2], a[3]); w.z = cvt_pk_bf16(b[0], b[1]); w.w = cvt_pk_bf16(b[2], b[3]);
    return __builtin_bit_cast(bf16x8, w);
}
__device__ __forceinline__ unsigned short bf1(float v) { return (unsigned short)(cvt_pk_bf16(v, 0.f) & 0xffffu); }
__device__ __forceinline__ float bfu(unsigned short h) { return __uint_as_float(((unsigned)h) << 16); }
__device__ __forceinline__ int tid_opaque() { int t = threadIdx.x; asm volatile("" : "+v"(t)); return t; }
__device__ __forceinline__ int clampi(int v, int lo, int hi) { return v < lo ? lo : (v > hi ? hi : v); }
typedef float f32x2c_t __attribute__((ext_vector_type(2)));
__device__ __forceinline__ int bid_opaque() { int t = blockIdx.x; asm volatile("" : "+s"(t)); return t; }
#define MFMA16(a, b, c) __builtin_amdgcn_mfma_f32_16x16x32_bf16((a), (b), (c), 0, 0, 0)

__device__ __forceinline__ float block_sum(float v, LAS float* red, int tid);
__device__ __forceinline__ void conv_matrix(const float* W, int K, int N, bf16_t* WT, const float* scale, int nshift_from, int nshift, LAS unsigned char* lds) {
    LAS float* tile = (LAS float*)lds;
    const int tid = tid_opaque(), nnb = (N + 63) / 64, items = (K / 64) * nnb;
#pragma unroll 1
    for (int it = blockIdx.x; it < items; it += gridDim.x) {
        const int kb = it / nnb, nb = it % nnb, k0 = kb * 64, n0 = nb * 64;
#pragma unroll
        for (int i = 0; i < 8; ++i) {
            const int k = i * 8 + (tid >> 6), n = tid & 63;
            float v = 0.f;
            if (n0 + n < N) { v = W[(size_t)(k0 + k) * N + n0 + n]; if (scale) v *= scale[k0 + k]; }
            tile[k * 65 + n] = v;
        }
        __syncthreads();
        {
            const int n = tid >> 3, kc = tid & 7;
            if (n0 + n < N) {
                const LAS float* s = tile + (kc * 8) * 65 + n;
                u32x4 o; o.x = cvt_pk_bf16(s[0], s[65]); o.y = cvt_pk_bf16(s[2 * 65], s[3 * 65]); o.z = cvt_pk_bf16(s[4 * 65], s[5 * 65]); o.w = cvt_pk_bf16(s[6 * 65], s[7 * 65]);
                int nn = n0 + n; if (nn >= nshift_from) nn += nshift;
                *(u32x4*)(WT + (size_t)nn * K + k0 + kc * 8) = o;
            }
        }
        __syncthreads();
    }
}

__device__ __forceinline__ void prologue(const Params& p, LAS unsigned char* lds) {
    unsigned char* ws = p.ws;
    const int tid = tid_opaque(), lane = tid & 63, wave = tid >> 6; const int bidx = bid_opaque();
#pragma unroll 1
    for (int mj = 0; mj < 20; ++mj) {
        const int l = mj / 10, m = mj % 10;
        const float* W; int K, N; bf16_t* WT; const float* scale = nullptr; int sfrom = 1 << 30, sh = 0;
        if (m == 0) { W = p.w_in + (size_t)l * DM * IN_COLS; K = DM; N = IN_COLS; WT = (bf16_t*)(ws + WS_WIN) + (size_t)l * NP_IN * DM; scale = p.norm_mix + l * DM; sfrom = 3352; sh = 232; }
        else if (m == 1) { W = p.w_a + (size_t)l * 512 * DM; K = 512; N = DM; WT = (bf16_t*)(ws + WS_WA) + (size_t)l * DM * 512; }
        else if (m == 2) { W = p.w_b + (size_t)l * 512 * DM; K = 512; N = DM; WT = (bf16_t*)(ws + WS_WB) + (size_t)l * DM * 512; }
        else if (m == 3) { W = p.w_out + (size_t)l * DM * DM; K = DM; N = DM; WT = (bf16_t*)(ws + WS_WO) + (size_t)l * DM * DM; }
        else if (m == 4) { W = p.w_up + (size_t)l * DM * DFF; K = DM; N = DFF; WT = (bf16_t*)(ws + WS_WUP) + (size_t)l * DFF * DM; scale = p.norm_mlp + l * DM; }
        else if (m == 5) { W = p.w_down + (size_t)l * DFF * DM; K = DFF; N = DM; WT = (bf16_t*)(ws + WS_WDN) + (size_t)l * DM * DFF; }
        else if (m < 8) { const int j = m - 6; W = p.cmp_w1 + (size_t)(l * 2 + j) * 2048 * 128; K = 2048; N = 128; WT = (bf16_t*)(ws + WS_CW1T) + (size_t)(l * 2 + j) * 128 * 2048; }
        else { const int j = m - 8; W = p.cmp_w2 + (size_t)(l * 2 + j) * 128 * 64; K = 128; N = 64; WT = (bf16_t*)(ws + WS_CW2T) + (size_t)(l * 2 + j) * 64 * 128; }
        conv_matrix(W, K, N, WT, scale, sfrom, sh, lds);
    }
    for (int l = 0; l < 2; ++l) {
        u32x4* z = (u32x4*)((bf16_t*)(ws + WS_WIN) + (size_t)l * NP_IN * DM + (size_t)3352 * DM);
        for (int i = bidx * 512 + tid; i < 232 * DM / 8; i += gridDim.x * 512) z[i] = (u32x4){0u, 0u, 0u, 0u};
    }
    if (bidx == 40) {
        float* TABG = (float*)(ws + WS_CBIAS);
        for (int i = tid; i < 2 * 3456; i += 512) {
            const int g = i / 3456, r = i % 3456, dist = (r >> 2) - 64, hh = r & 3;
            int bk;
            if (dist < 16) bk = dist < 0 ? 0 : dist;
            else { bk = 16 + (dist >= 21) + (dist >= 27) + (dist >= 35) + (dist >= 46) + (dist >= 59) + (dist >= 77) + (dist >= 99) + (dist >= 128) + (dist >= 166) + (dist >= 216) + (dist >= 280) + (dist >= 363) + (dist >= 470) + (dist >= 609) + (dist >= 790); }
            TABG[i] = (dist < 0) ? -INFINITY : p.rel_bias[bk * 8 + g * 4 + hh] * 1.4426950408889634f;
        }
    }
    if (bidx >= 16 && bidx < 32) {
        const int r = bidx - 16; float* EH = (float*)(ws + WS_EX + EX_H);
        const float xa = p.x[(size_t)r * SEQ * DM + tid], xb2 = p.x[(size_t)r * SEQ * DM + 512 + tid];
        const float ss = block_sum(xa * xa + xb2 * xb2, (LAS float*)(lds + 32768), tid);
        const float rstd = rsqrtf(ss * (1.0f / 1024.0f) + 1e-6f);
        EH[r * 1024 + tid] = xa * rstd * p.norm_mix[tid]; EH[r * 1024 + 512 + tid] = xb2 * rstd * p.norm_mix[512 + tid];
        __syncthreads();
    }
    {
        bf16_t* xb = (bf16_t*)(ws + WS_XB); float* sumsq = (float*)(ws + WS_SUMSQ);
#pragma unroll 1
        for (int row = bidx * 8 + wave; row < T_TOK; row += gridDim.x * 8) {
            const f32x4* xr = (const f32x4*)(p.x + (size_t)row * DM) + lane;
            f32x4 v[4]; float s = 0.f;
#pragma unroll
            for (int j = 0; j < 4; ++j) { v[j] = xr[64 * j]; s += (v[j][0] * v[j][0] + v[j][1] * v[j][1]) + (v[j][2] * v[j][2] + v[j][3] * v[j][3]); }
#pragma unroll
            for (int o = 1; o < 64; o <<= 1) s += __shfl_xor(s, o);
            u32x2* o8 = (u32x2*)(xb + (size_t)row * DM) + lane;
#pragma unroll
            for (int j = 0; j < 4; ++j) { u32x2 w; w.x = cvt_pk_bf16(v[j][0], v[j][1]); w.y = cvt_pk_bf16(v[j][2], v[j][3]); o8[64 * j] = w; }
            if (lane < 16) sumsq[(size_t)row * 16 + lane] = (lane == 0) ? s : 0.f;
        }
    }
}

template <class InFn>
__device__ __forceinline__ void exact_stage(const float* W0, const float* W1, int wsplit, int K, int N, float* part, InFn in_fn, LAS unsigned char* lds) {
    const int tid = tid_opaque(), lane = tid & 63, wave = tid >> 6;
    const int nsl = K / 256, ncg = (N + 511) / 512, ntasks = nsl * ncg;
    LAS float* IN = (LAS float*)lds;
#pragma unroll 1
    for (int task = blockIdx.x; task < ntasks; task += gridDim.x) {
        const int sl = task % nsl, cg = task / nsl;
        __syncthreads();
#pragma unroll 1
        for (int idx = tid; idx < 4096; idx += 512) IN[idx] = in_fn(idx >> 8, sl * 256 + (idx & 255));
        __syncthreads();
        const int col = (cg * 8 + wave) * 64 + lane;
#ifdef DUP_SIDE
        for (int rep = 0; rep < 2; ++rep)
#endif
        if (col < N) {
            const float* Wp = ((sl < wsplit) ? W0 + (size_t)sl * 256 * N : W1 + (size_t)(sl - wsplit) * 256 * N) + col;
            float acc[16];
#pragma unroll
            for (int r = 0; r < 16; ++r) acc[r] = 0.f;
#pragma unroll 2
            for (int k = 0; k < 256; k += 4) {
                const float w0 = Wp[(size_t)k * N], w1 = Wp[(size_t)(k + 1) * N], w2 = Wp[(size_t)(k + 2) * N], w3 = Wp[(size_t)(k + 3) * N];
#pragma unroll
                for (int r = 0; r < 16; ++r) { const f32x4 v = *(const LAS f32x4*)(IN + r * 256 + k); acc[r] += (v[0] * w0 + v[1] * w1) + (v[2] * w2 + v[3] * w3); }
            }
#pragma unroll
            for (int r = 0; r < 16; ++r) part[((size_t)sl * 16 + r) * N + col] = acc[r];
        }
    }
    __syncthreads();
}
__device__ __forceinline__ float block_sum(float v, LAS float* red, int tid) {
#pragma unroll
    for (int o = 1; o < 64; o <<= 1) v += __shfl_xor(v, o);
    __syncthreads();
    if ((tid & 63) == 0) red[tid >> 6] = v;
    __syncthreads();
    float s = 0.f;
#pragma unroll
    for (int i = 0; i < 8; ++i) s += red[i];
    return s;
}
__device__ __forceinline__ float ex_pp(const float* PP, int r, int c) { return (PP[(size_t)r * IN_COLS + c] + PP[(size_t)(16 + r) * IN_COLS + c]) + (PP[(size_t)(32 + r) * IN_COLS + c] + PP[(size_t)(48 + r) * IN_COLS + c]); }
__device__ __forceinline__ void exact_mixers(const Params& p, int r, LAS unsigned char* lds) {
    const int tid = tid_opaque();
    const float* PP = (const float*)(p.ws + WS_EX + EX_PP); float* OAB = (float*)(p.ws + WS_EX + EX_OAB);
    LAS float* red = (LAS float*)(lds + 32768);
    const int j = tid, h = j >> 7, e = j & 127;
    const float q = ex_pp(PP, r, j), z = ex_pp(PP, r, 512 + j), iv = ex_pp(PP, r, 1024 + j), g = ex_pp(PP, r, 1536 + j);
    float pr = q * (1.0f / (1.0f + __expf(z)));
#pragma unroll
    for (int o = 1; o < 64; o <<= 1) pr += __shfl_xor(pr, o);
    __syncthreads();
    if ((tid & 63) == 0) red[tid >> 6] = pr;
    __syncthreads();
    const float sh = red[2 * h] + red[2 * h + 1];
    const float o = sh * iv;
    float sq = o * o;
#pragma unroll
    for (int o2 = 1; o2 < 64; o2 <<= 1) sq += __shfl_xor(sq, o2);
    __syncthreads();
    if ((tid & 63) == 0) red[tid >> 6] = sq;
    __syncthreads();
    const float rstd = rsqrtf((red[2 * h] + red[2 * h + 1]) * (1.0f / 128.0f) + 1e-6f);
    OAB[(size_t)r * 1024 + j] = o * rstd * p.hg_gain[e] * (g / (1.0f + __expf(-g)));
    const int hh = j >> 6, d = j & 63, gg = hh >> 2, hp = hh & 3;
    const float vs = ex_pp(PP, r, 2944 + gg * 64 + d), vw = ex_pp(PP, r, 3200 + gg * 64 + d);
    const float gs = ex_pp(PP, r, 3328 + gg * 12 + hp * 3 + 1), gw = ex_pp(PP, r, 3328 + gg * 12 + hp * 3 + 2);
    OAB[(size_t)r * 1024 + 512 + j] = vs / (1.0f + __expf(-gs)) + vw / (1.0f + __expf(-gw));
    __syncthreads();
}
__device__ __forceinline__ float ex_x1(const Params& p, int r, int k) {
    const float* XP = (const float*)(p.ws + WS_EX + EX_XP);
    return p.x[(size_t)r * SEQ * DM + k] + ((XP[(size_t)r * 1024 + k] + XP[(size_t)(16 + r) * 1024 + k]) + (XP[(size_t)(32 + r) * 1024 + k] + XP[(size_t)(48 + r) * 1024 + k]));
}
__device__ __forceinline__ float ex_x2(const Params& p, int r, int k) {
    const float* DP = (const float*)(p.ws + WS_EX + EX_DP);
    float s = 0.f;
#pragma unroll
    for (int i = 0; i < 16; ++i) s += DP[((size_t)i * 16 + r) * 1024 + k];
    return ex_x1(p, r, k) + s;
}

constexpr int HG_TOT = 0, HG_DEC = 8192, HG_QB = 8704, HG_QS = HG_QB + 17408, HG_KVER = HG_QS + 17408, HG_KHT = HG_KVER + 43520, HG_VT = HG_KHT + 18432, HG_AM = HG_VT + 4608, HG_END = HG_AM + 9216;
static_assert(HG_END <= LDS_BYTES, "hgrn lds");
__device__ __forceinline__ void hgrn_unit(const Params& p, int layer, int unit, LAS unsigned char* lds) {
    unsigned char* ws = p.ws;
    const int tid = tid_opaque(), lane = tid & 63, wave = tid >> 6, l16 = lane & 15, quad = lane >> 4;
    const int b = unit >> 4, h = (unit >> 2) & 3, sl = unit & 3;
    const int d = tid & 127, tq = tid >> 7;
    const bf16_t* qg = (const bf16_t*)(ws + WS_HQ) + (size_t)b * SEQ * 512 + h * 128 + d;
    const bf16_t* zg = (const bf16_t*)(ws + WS_HF) + (size_t)b * SEQ * 512 + h * 128 + d;
    bf16_t* vg = (bf16_t*)(ws + WS_HI) + (size_t)b * SEQ * 512 + h * 128 + sl * 32;
    float lb = 0.f;
    if (layer == 1) lb = sigm(p.lb_logits[512 + h * 128 + d] - p.lb_logits[h * 128 + d]);
    const float omlb = 1.0f - lb;
    const int vv = tid & 31, sq = tid >> 5;
    const int tt = wave & 3, vt = wave >> 2;
    LAS float* TOT = (LAS float*)(lds + HG_TOT); LAS float* DEC = (LAS float*)(lds + HG_DEC);
    f32x4 S[8];
#pragma unroll
    for (int i = 0; i < 8; ++i) S[i] = (f32x4){0.f, 0.f, 0.f, 0.f};
    float s00;
    {
        LAS float* XR = (LAS float*)(lds + HG_KVER);
        LAS float* red0 = (LAS float*)(lds + HG_TOT);
        const float* nm = p.norm_mix + layer * DM;
        const float xa = (layer == 0) ? p.x[(size_t)b * SEQ * DM + tid] : ex_x2(p, b, tid);
        const float xb2 = (layer == 0) ? p.x[(size_t)b * SEQ * DM + 512 + tid] : ex_x2(p, b, 512 + tid);
        XR[tid] = xa * nm[tid]; XR[512 + tid] = xb2 * nm[512 + tid];
        const float ss = block_sum(xa * xa + xb2 * xb2, red0, tid);
        const float rstd = rsqrtf(ss * (1.0f / 1024.0f) + 1e-6f);
        __syncthreads();
        const float* W = p.w_in + (size_t)layer * DM * IN_COLS + h * 128 + d;
        float q0 = 0.f, z0 = 0.f;
#pragma unroll 16
        for (int k = tq * 256; k < tq * 256 + 256; ++k) { const float hk = XR[k]; q0 += hk * W[(size_t)k * IN_COLS]; z0 += hk * W[(size_t)k * IN_COLS + 512]; }
        LAS float* RED = (LAS float*)(lds + HG_QB);
        RED[tq * 128 + d] = q0; RED[512 + tq * 128 + d] = z0;
        __syncthreads();
        q0 = (RED[d] + RED[128 + d]) + (RED[256 + d] + RED[384 + d]); z0 = (RED[512 + d] + RED[640 + d]) + (RED[768 + d] + RED[896 + d]);
        q0 *= rstd; z0 *= rstd;
        float pr = q0 * (omlb / (1.0f + __expf(z0)));
#pragma unroll
        for (int o = 1; o < 64; o <<= 1) pr += __shfl_xor(pr, o);
        __syncthreads();
        if (lane == 0) RED[wave] = pr;
        __syncthreads();
        s00 = RED[0] + RED[1];
#ifdef DIAG_S00
        if (layer == 1 && tid == 0) atomicMin((unsigned*)(ws + 512), __float_as_uint(fabsf(s00)));
#endif
        __syncthreads();
    }
    const int d0 = 2 * lane, tg = wave, Jc = wave >> 1, hf = wave & 1;
    const unsigned* qg2 = (const unsigned*)((const bf16_t*)(ws + WS_HQ) + (size_t)b * SEQ * 512 + h * 128 + d0);
    const unsigned* zg2 = (const unsigned*)((const bf16_t*)(ws + WS_HF) + (size_t)b * SEQ * 512 + h * 128 + d0);
    float lbA = 0.f, lbB = 0.f;
    if (layer == 1) { lbA = sigm(p.lb_logits[512 + h * 128 + d0] - p.lb_logits[h * 128 + d0]); lbB = sigm(p.lb_logits[512 + h * 128 + d0 + 1] - p.lb_logits[h * 128 + d0 + 1]); }
    const float omA = 1.0f - lbA, omB = 1.0f - lbB;
    LAS float* PRODS = (LAS float*)(lds + HG_TOT);
    LAS float* LOGPS = (LAS float*)(lds + HG_TOT + 4096);
    unsigned qw[8], zw[8]; unsigned short vr[4];
#pragma unroll
    for (int i = 0; i < 8; ++i) { qw[i] = qg2[(size_t)(8 * tg + i) * 256]; zw[i] = zg2[(size_t)(8 * tg + i) * 256]; }
#pragma unroll
    for (int i = 0; i < 4; ++i) vr[i] = vg[(size_t)(4 * sq + i) * 512 + vv];
    for (int c = 0; c < 64; ++c) {
        float qA[8], qB[8], kA[8], kB[8], eA[8], eB[8]; unsigned short vcur[4];
        {
            float pA = 1.f, pB = 1.f;
#pragma unroll
            for (int i = 0; i < 8; ++i) {
                qA[i] = bf_lo(qw[i]); qB[i] = bf_hi(qw[i]);
                const float zA = bf_lo(zw[i]), zB = bf_hi(zw[i]);
                const float ea = __expf(-zA), eb = __expf(-zB);
                const float ia = __builtin_amdgcn_rcpf(1.0f + ea), ib = __builtin_amdgcn_rcpf(1.0f + eb);
                kA[i] = omA * (ea * ia); kB[i] = omB * (eb * ib);
                pA *= lbA + omA * ia; pB *= lbB + omB * ib; eA[i] = pA; eB[i] = pB;
            }
#pragma unroll
            for (int i = 0; i < 4; ++i) vcur[i] = vr[i];
            *(LAS f32x2c_t*)(PRODS + tg * 128 + d0) = (f32x2c_t){pA, pB};
            *(LAS f32x2c_t*)(LOGPS + tg * 128 + d0) = (f32x2c_t){__logf(fmaxf(pA, 1e-37f)), __logf(fmaxf(pB, 1e-37f))};
        }
        __syncthreads();
        float rJA = 0.f, rJB = 0.f, r1A = 0.f, r1B = 0.f, r2A = 0.f, r2B = 0.f, r3A = 0.f, r3B = 0.f, r4A, r4B;
        {
            float accA = 0.f, accB = 0.f;
#pragma unroll
            for (int w = 0; w < 8; ++w) {
                if (w == 2) { r1A = accA; r1B = accB; } if (w == 4) { r2A = accA; r2B = accB; } if (w == 6) { r3A = accA; r3B = accB; }
                const f32x2c_t lp = *(const LAS f32x2c_t*)(LOGPS + w * 128 + d0); accA += lp[0]; accB += lp[1];
            }
            r4A = accA; r4B = accB;
            rJA = (Jc == 0) ? 0.f : ((Jc == 1) ? r1A : ((Jc == 2) ? r2A : r3A)); rJB = (Jc == 0) ? 0.f : ((Jc == 1) ? r1B : ((Jc == 2) ? r2B : r3B));
        }
        if (hf) {
            const f32x2c_t pp = *(const LAS f32x2c_t*)(PRODS + (tg - 1) * 128 + d0);
#pragma unroll
            for (int i = 0; i < 8; ++i) { eA[i] *= pp[0]; eB[i] *= pp[1]; }
        }
        if (tg == 0) *(LAS f32x2c_t*)(DEC + d0) = (f32x2c_t){__expf(r4A), __expf(r4B)};
        {
            LAS unsigned* QB = (LAS unsigned*)(lds + HG_QB); LAS unsigned* QS = (LAS unsigned*)(lds + HG_QS); LAS unsigned* KV_ = (LAS unsigned*)(lds + HG_KVER);
            float riA[8], riB[8];
            const float eJA = __expf(rJA), eJB = __expf(rJB), c4A = __expf(r4A - rJA), c4B = __expf(r4B - rJB);
#pragma unroll
            for (int i = 0; i < 8; ++i) {
                const int t = 8 * tg + i;
                riA[i] = kA[i] * __builtin_amdgcn_rcpf(fmaxf(eA[i], 1e-30f)); riB[i] = kB[i] * __builtin_amdgcn_rcpf(fmaxf(eB[i], 1e-30f));
                const float sA = qA[i] * eA[i], sB = qB[i] * eB[i];
                QS[t * 68 + lane] = cvt_pk_bf16(sA, sB);
                QB[t * 68 + lane] = cvt_pk_bf16(sA * eJA, sB * eJB);
            }
#pragma unroll
            for (int I = 0; I < 4; ++I) {
                if (I >= Jc) {
                    const float rIA = (I == 0) ? 0.f : ((I == 1) ? r1A : ((I == 2) ? r2A : r3A)), rIB = (I == 0) ? 0.f : ((I == 1) ? r1B : ((I == 2) ? r2B : r3B));
                    const int voff = (I == 0) ? 0 : ((I == 1) ? 16 : ((I == 2) ? 48 : 96));
                    const float cA = __expf(rIA - rJA), cB = __expf(rIB - rJB);
#pragma unroll
                    for (int i = 0; i < 8; ++i) KV_[(voff + 8 * tg + i) * 68 + lane] = cvt_pk_bf16(riA[i] * cA, riB[i] * cB);
                }
            }
            LAS unsigned char* KHT = lds + HG_KHT;
            u32x4 w0, w1;
            w0.x = cvt_pk_bf16(riA[0] * c4A, riA[1] * c4A); w0.y = cvt_pk_bf16(riA[2] * c4A, riA[3] * c4A); w0.z = cvt_pk_bf16(riA[4] * c4A, riA[5] * c4A); w0.w = cvt_pk_bf16(riA[6] * c4A, riA[7] * c4A);
            w1.x = cvt_pk_bf16(riB[0] * c4B, riB[1] * c4B); w1.y = cvt_pk_bf16(riB[2] * c4B, riB[3] * c4B); w1.z = cvt_pk_bf16(riB[4] * c4B, riB[5] * c4B); w1.w = cvt_pk_bf16(riB[6] * c4B, riB[7] * c4B);
            *(LAS u32x4*)(KHT + d0 * 144 + tg * 16) = w0; *(LAS u32x4*)(KHT + (d0 + 1) * 144 + tg * 16) = w1;
            LAS unsigned char* VT = lds + HG_VT;
            u32x2 wv; wv.x = (unsigned)vcur[0] | ((unsigned)vcur[1] << 16); wv.y = (unsigned)vcur[2] | ((unsigned)vcur[3] << 16);
            *(LAS u32x2*)(VT + vv * 144 + sq * 8) = wv;
            LAS u32x4* AMz = (LAS u32x4*)(lds + HG_AM);
            AMz[tid] = (u32x4){0u, 0u, 0u, 0u}; if (tid < 64) AMz[512 + tid] = (u32x4){0u, 0u, 0u, 0u};
        }
        __syncthreads();
        if (c + 1 < 64) {
            const size_t ro = (size_t)(c + 1) * 64 * 512;
#pragma unroll
            for (int i = 0; i < 8; ++i) { qw[i] = qg2[(ro >> 1) + (size_t)(8 * tg + i) * 256]; zw[i] = zg2[(ro >> 1) + (size_t)(8 * tg + i) * 256]; }
#pragma unroll
            for (int i = 0; i < 4; ++i) vr[i] = vg[ro + (size_t)(4 * sq + i) * 512 + vv];
        }
        for (int pi = wave; pi < 10; pi += 8) {
            int I, J;
            if (pi == 0) { I = 0; J = 0; } else if (pi < 3) { I = 1; J = pi - 1; } else if (pi < 6) { I = 2; J = pi - 3; } else { I = 3; J = pi - 6; }
            const int voff = (I == 0) ? 0 : ((I == 1) ? 16 : ((I == 2) ? 48 : 96));
            const LAS unsigned char* qa = lds + HG_QS + (16 * I + l16) * 272 + quad * 16;
            const LAS unsigned char* kb = lds + HG_KVER + (voff + 16 * J + l16) * 272 + quad * 16;
            f32x4 a = (f32x4){0.f, 0.f, 0.f, 0.f};
#pragma unroll
            for (int ks = 0; ks < 4; ++ks) a = MFMA16(lds_ld8(qa + ks * 64), lds_ld8(kb + ks * 64), a);
            LAS bf16_t* AM = (LAS bf16_t*)(lds + HG_AM);
#pragma unroll
            for (int j = 0; j < 4; ++j) {
                float v = a[j]; if (I == J && l16 > quad * 4 + j) v = 0.f;
                if (c == 0 && pi == 0 && lane == 0 && j == 0) v = s00;
                AM[(16 * I + quad * 4 + j) * 72 + 16 * J + l16] = bf1(v);
            }
        }
        __syncthreads();
        {
            f32x4 o = (f32x4){0.f, 0.f, 0.f, 0.f};
            const LAS unsigned char* qb = lds + HG_QB + (16 * tt + l16) * 272 + quad * 8;
#pragma unroll
            for (int s2 = 0; s2 < 4; ++s2) o = MFMA16(lds_ld4x2(qb + s2 * 64, qb + s2 * 64 + 32), pack8(S[2 * s2], S[2 * s2 + 1]), o);
            const LAS unsigned char* am = lds + HG_AM + (16 * tt + l16) * 144 + quad * 16;
            const LAS unsigned char* vb = lds + HG_VT + (16 * vt + l16) * 144 + quad * 16;
            const bf16x8 vb0 = lds_ld8(vb), vb1 = lds_ld8(vb + 64);
            o = MFMA16(lds_ld8(am), vb0, o); o = MFMA16(lds_ld8(am + 64), vb1, o);
            bf16_t* og = (bf16_t*)(ws + WS_TMP) + (size_t)b * SEQ * 512 + h * 128 + sl * 32 + (size_t)(c * 64 + 16 * tt + quad * 4) * 512 + 16 * vt + l16;
#pragma unroll
            for (int j = 0; j < 4; ++j) og[(size_t)j * 512] = bf1(o[j]);
#pragma unroll
            for (int dt = 0; dt < 8; ++dt) {
                const f32x4 dc = *(const LAS f32x4*)(DEC + 16 * dt + quad * 4);
                const LAS unsigned char* ka = lds + HG_KHT + (16 * dt + l16) * 144 + quad * 16;
                f32x4 s = S[dt] * dc;
                s = MFMA16(lds_ld8(ka), vb0, s); s = MFMA16(lds_ld8(ka + 64), vb1, s);
                S[dt] = s;
            }
        }
        __syncthreads();
    }
}

__device__ __forceinline__ void hgrn_finalize(const Params& p, int layer) {
    unsigned char* ws = p.ws;
    const int tid = tid_opaque(), lane = tid & 63, wave = tid >> 6;
    const float* gain = p.hg_gain + layer * 128 + (lane & 15) * 8;
    float gn[8];
#pragma unroll
    for (int e = 0; e < 8; ++e) gn[e] = gain[e];
    for (int row = blockIdx.x * 8 + wave; row < T_TOK; row += gridDim.x * 8) {
        u32x4* op = (u32x4*)((bf16_t*)(ws + WS_HI) + (size_t)row * 512) + lane;
        const u32x4 ov = *((const u32x4*)((const bf16_t*)(ws + WS_TMP) + (size_t)row * 512) + lane), gv = *((const u32x4*)((const bf16_t*)(ws + WS_HG) + (size_t)row * 512) + lane);
        float o[8], g[8];
        o[0] = bf_lo(ov.x); o[1] = bf_hi(ov.x); o[2] = bf_lo(ov.y); o[3] = bf_hi(ov.y); o[4] = bf_lo(ov.z); o[5] = bf_hi(ov.z); o[6] = bf_lo(ov.w); o[7] = bf_hi(ov.w);
        g[0] = bf_lo(gv.x); g[1] = bf_hi(gv.x); g[2] = bf_lo(gv.y); g[3] = bf_hi(gv.y); g[4] = bf_lo(gv.z); g[5] = bf_hi(gv.z); g[6] = bf_lo(gv.w); g[7] = bf_hi(gv.w);
        float s = 0.f;
#pragma unroll
        for (int e = 0; e < 8; ++e) s += o[e] * o[e];
        s += __builtin_bit_cast(float, __builtin_amdgcn_update_dpp(0, __builtin_bit_cast(int, s), 0xB1, 0xF, 0xF, true));
        s += __builtin_bit_cast(float, __builtin_amdgcn_update_dpp(0, __builtin_bit_cast(int, s), 0x4E, 0xF, 0xF, true));
        s += __builtin_bit_cast(float, __builtin_amdgcn_update_dpp(0, __builtin_bit_cast(int, s), 0x141, 0xF, 0xF, true));
        s += __builtin_bit_cast(float, __builtin_amdgcn_update_dpp(0, __builtin_bit_cast(int, s), 0x140, 0xF, 0xF, true));
        const float rstd = rsqrtf(s * (1.0f / 128.0f) + 1e-6f);
#pragma unroll
        for (int e = 0; e < 8; ++e) o[e] = o[e] * rstd * gn[e] * (g[e] * sigm(g[e]));
        u32x4 w; w.x = cvt_pk_bf16(o[0], o[1]); w.y = cvt_pk_bf16(o[2], o[3]); w.z = cvt_pk_bf16(o[4], o[5]); w.w = cvt_pk_bf16(o[6], o[7]);
        *op = w;
    }
}

constexpr int CM_A = 0, CM_W = 18432, CM_H = CM_W + 36864, CM_W2 = CM_H + 17408, CM_END = CM_W2 + 17408;
__device__ __forceinline__ void cmp_unit(const Params& p, int layer, int unit, LAS unsigned char* lds) {
    unsigned char* ws = p.ws;
    const int tid = tid_opaque(), lane = tid & 63, wave = tid >> 6, l16 = lane & 15, quad = lane >> 4;
    const int ct = unit & 3, kv = (unit >> 2) & 1, g = (unit >> 3) & 1, b = unit >> 4;
    const bf16_t* src = (const bf16_t*)(ws + WS_KV) + (size_t)b * SEQ * 768 + kv * 128 + g * 64;
    const bf16_t* W1T = (const bf16_t*)(ws + WS_CW1T) + (size_t)(layer * 2 + kv) * 128 * 2048;
    const bf16_t* W2T = (const bf16_t*)(ws + WS_CW2T) + (size_t)(layer * 2 + kv) * 64 * 128;
    const float* cbias = p.cmp_b1 + (layer * 2 + kv) * 128;
    const float* cpos = p.cmp_pos + (size_t)(layer * 2 + kv) * 2048 + (tid & 7) * 8;
    {
        const int n = tid >> 3, ch = tid & 7;
        *(LAS u32x4*)(lds + CM_W2 + n * 272 + ch * 32) = *(const u32x4*)(W2T + n * 128 + ch * 16);
        *(LAS u32x4*)(lds + CM_W2 + n * 272 + ch * 32 + 16) = *(const u32x4*)(W2T + n * 128 + ch * 16 + 8);
    }
    const int arow = tid >> 3, ach = tid & 7, ac = ct * 64 + arow;
    const bool aval = ac < 255;
    const bf16_t* ap = src + (size_t)(16 * (aval ? ac : 0)) * 768 + ach * 8;
    const int mi = wave & 3, nh = wave >> 2;
    f32x4 acc[4];
#pragma unroll
    for (int i = 0; i < 4; ++i) acc[i] = (f32x4){0.f, 0.f, 0.f, 0.f};
    u32x4 ar, wr0, wr1;
    ar = aval ? *(const u32x4*)ap : (u32x4){0u, 0u, 0u, 0u};
    wr0 = *(const u32x4*)(W1T + (size_t)(tid >> 3) * 2048 + (tid & 7) * 8);
    wr1 = *(const u32x4*)(W1T + (size_t)(64 + (tid >> 3)) * 2048 + (tid & 7) * 8);
#define CM_STORE(tk, bufi) do { \
        const f32x4 p0 = *(const f32x4*)(cpos + (tk) * 64), p1 = *(const f32x4*)(cpos + (tk) * 64 + 4); \
        ar.x = cvt_pk_bf16(bf_lo(ar.x) + p0[0], bf_hi(ar.x) + p0[1]); ar.y = cvt_pk_bf16(bf_lo(ar.y) + p0[2], bf_hi(ar.y) + p0[3]); \
        ar.z = cvt_pk_bf16(bf_lo(ar.z) + p1[0], bf_hi(ar.z) + p1[1]); ar.w = cvt_pk_bf16(bf_lo(ar.w) + p1[2], bf_hi(ar.w) + p1[3]); \
        *(LAS u32x4*)(lds + CM_A + (bufi) * 9216 + arow * 144 + ach * 16) = ar; \
        *(LAS u32x4*)(lds + CM_W + (bufi) * 18432 + (tid >> 3) * 144 + (tid & 7) * 16) = wr0; \
        *(LAS u32x4*)(lds + CM_W + (bufi) * 18432 + (64 + (tid >> 3)) * 144 + (tid & 7) * 16) = wr1; } while (0)
    __syncthreads();
    CM_STORE(0, 0);
    __syncthreads();
#pragma nounroll
    for (int tok = 0; tok < 32; ++tok) {
        const int bufc = tok & 1;
        if (tok + 1 < 32) {
            ar = aval ? *(const u32x4*)(ap + (size_t)(tok + 1) * 768) : (u32x4){0u, 0u, 0u, 0u};
            wr0 = *(const u32x4*)(W1T + (size_t)(tid >> 3) * 2048 + (tok + 1) * 64 + (tid & 7) * 8);
            wr1 = *(const u32x4*)(W1T + (size_t)(64 + (tid >> 3)) * 2048 + (tok + 1) * 64 + (tid & 7) * 8);
        }
#pragma unroll
        for (int ks = 0; ks < 2; ++ks) {
            const bf16x8 a = lds_ld8(lds + CM_A + bufc * 9216 + (mi * 16 + l16) * 144 + ks * 64 + quad * 16);
#pragma unroll
            for (int ni = 0; ni < 4; ++ni) acc[ni] = MFMA16(a, lds_ld8(lds + CM_W + bufc * 18432 + ((nh * 4 + ni) * 16 + l16) * 144 + ks * 64 + quad * 16), acc[ni]);
        }
        if (tok + 1 < 32) CM_STORE(tok + 1, bufc ^ 1);
        __syncthreads();
    }
#undef CM_STORE
    {
        LAS bf16_t* H = (LAS bf16_t*)(lds + CM_H);
#pragma unroll
        for (int ni = 0; ni < 4; ++ni) {
            const int n = (nh * 4 + ni) * 16 + l16; const float cb = cbias[n];
#pragma unroll
            for (int j = 0; j < 4; ++j) {
                const float x = acc[ni][j] + cb;
                const float u = 0.7978845608028654f * (x + 0.044715f * x * x * x);
                const float th = 1.0f - 2.0f / (__expf(2.0f * u) + 1.0f);
                H[(mi * 16 + quad * 4 + j) * 136 + n] = bf1(0.5f * x * (1.0f + th));
            }
        }
    }
    __syncthreads();
    if (wave < 4) {
        f32x4 a2[4];
#pragma unroll
        for (int i = 0; i < 4; ++i) a2[i] = (f32x4){0.f, 0.f, 0.f, 0.f};
#pragma unroll
        for (int ks = 0; ks < 4; ++ks) {
            const bf16x8 a = lds_ld8(lds + CM_H + (wave * 16 + l16) * 272 + ks * 64 + quad * 16);
#pragma unroll
            for (int ni = 0; ni < 4; ++ni) a2[ni] = MFMA16(a, lds_ld8(lds + CM_W2 + (ni * 16 + l16) * 272 + ks * 64 + quad * 16), a2[ni]);
        }
        if (kv == 0) {
            bf16_t* KC = (bf16_t*)(ws + WS_KCMP) + (size_t)(b * 2 + g) * 256 * 64;
            const float* gain = p.qk_gain + (layer * 4 + 1) * 64;
#pragma unroll
            for (int j = 0; j < 4; ++j) {
                float s = (a2[0][j] * a2[0][j] + a2[1][j] * a2[1][j]) + (a2[2][j] * a2[2][j] + a2[3][j] * a2[3][j]);
                s += __shfl_xor(s, 1); s += __shfl_xor(s, 2); s += __shfl_xor(s, 4); s += __shfl_xor(s, 8);
                const float rstd = rsqrtf(s * (1.0f / 64.0f) + 1e-6f);
                const int c = ct * 64 + wave * 16 + quad * 4 + j;
#pragma unroll
                for (int ni = 0; ni < 4; ++ni) KC[(size_t)c * 64 + ni * 16 + l16] = (c < 255) ? bf1(a2[ni][j] * rstd * gain[ni * 16 + l16]) : (bf16_t)0;
            }
        } else {
            bf16_t* VC = (bf16_t*)(ws + WS_VCMPT) + (size_t)(b * 2 + g) * 64 * 256;
#pragma unroll
            for (int j = 0; j < 4; ++j) {
                const int c = ct * 64 + wave * 16 + quad * 4 + j;
#pragma unroll
                for (int ni = 0; ni < 4; ++ni) VC[(size_t)(ni * 16 + l16) * 256 + c] = (c < 255) ? bf1(a2[ni][j]) : (bf16_t)0;
            }
        }
    }
    __syncthreads();
}

constexpr int AT_TAB = 0, AT_TABW = 13824, AT_K = 23296, AT_V = AT_K + 18432, AT_PS = AT_V + 18432, AT_MASK = AT_PS + 65536, AT_END = AT_MASK + 512;
static_assert(AT_END <= LDS_BYTES, "attn lds");

struct AttnCtx {
    const bf16_t* ksrc; const bf16_t* vsrc; int ldk, ldv; const float* kgain;
    int tpos[2]; int h;
};

template <int BR>
__device__ __forceinline__ void attn_branch(const AttnCtx& cx, const bf16x8 (&qf)[2][2], int qt, unsigned long long selu, const unsigned long long (&selm)[2], unsigned long long wact0, unsigned long long wact1,
                                            f32x4 (&of)[2][4], const float (&gate)[2], LAS unsigned char* lds, float (&m_out)[2], float (&il_out)[2]) {
    const int tid = tid_opaque(), lane = tid & 63, l16 = lane & 15, quad = lane >> 4;
    const int srow = tid >> 3, sch = tid & 7;
    float kg[8];
    if (BR != 0) {
#pragma unroll
        for (int e = 0; e < 8; ++e) kg[e] = cx.kgain[sch * 8 + e];
    }
    unsigned long long rem;
    if (BR == 0) rem = (1ull << (((qt * 64 + 32) >> 10) + 1)) - 1ull;
    else if (BR == 1) rem = selu & ((qt >= 63) ? ~0ull : ((2ull << qt) - 1ull));
    else { const int lo = qt > 8 ? qt - 8 : 0; rem = ((qt >= 63) ? ~0ull : ((2ull << qt) - 1ull)) & ~((1ull << lo) - 1ull); }
    f32x4 o[2][4]; float l[2];
#pragma unroll
    for (int mi = 0; mi < 2; ++mi) { l[mi] = 0.f;
#pragma unroll
        for (int di = 0; di < 4; ++di) o[mi][di] = (f32x4){0.f, 0.f, 0.f, 0.f}; }
    int cur = rem ? __builtin_ctzll(rem) : -1; if (rem) rem &= rem - 1ull;
    u32x4 kr, vr;
    auto gload = [&](int jt) {
        kr = *(const u32x4*)(cx.ksrc + (size_t)(jt * 64 + srow) * cx.ldk + sch * 8);
        vr = *(const u32x4*)(cx.vsrc + (size_t)srow * cx.ldv + jt * 64 + sch * 8);
    };
    auto lstore = [&](int buf) {
        u32x4 kw = kr;
        if (BR != 0) {
            float f[8]; f[0] = bf_lo(kr.x); f[1] = bf_hi(kr.x); f[2] = bf_lo(kr.y); f[3] = bf_hi(kr.y); f[4] = bf_lo(kr.z); f[5] = bf_hi(kr.z); f[6] = bf_lo(kr.w); f[7] = bf_hi(kr.w);
            float s = 0.f;
#pragma unroll
            for (int e = 0; e < 8; ++e) s += f[e] * f[e];
            s += __builtin_bit_cast(float, __builtin_amdgcn_update_dpp(0, __builtin_bit_cast(int, s), 0xB1, 0xF, 0xF, true));
            s += __builtin_bit_cast(float, __builtin_amdgcn_update_dpp(0, __builtin_bit_cast(int, s), 0x4E, 0xF, 0xF, true));
            s += __builtin_bit_cast(float, __builtin_amdgcn_update_dpp(0, __builtin_bit_cast(int, s), 0x141, 0xF, 0xF, true));
            const float rstd = rsqrtf(s * (1.0f / 64.0f) + 1e-6f);
#pragma unroll
            for (int e = 0; e < 8; ++e) f[e] = f[e] * rstd * kg[e];
            kw.x = cvt_pk_bf16(f[0], f[1]); kw.y = cvt_pk_bf16(f[2], f[3]); kw.z = cvt_pk_bf16(f[4], f[5]); kw.w = cvt_pk_bf16(f[6], f[7]);
        }
        *(LAS u32x4*)(lds + AT_K + buf * 9216 + srow * 144 + sch * 16) = kw;
        *(LAS u32x4*)(lds + AT_V + buf * 9216 + srow * 144 + sch * 16) = vr;
    };
    if (cur >= 0) { gload(cur); lstore(0); }
    __syncthreads();
    int buf = 0;
    const LAS f32x4* TAB = (const LAS f32x4*)(lds + AT_TAB);
    const LAS float* TABf = (const LAS float*)(lds + AT_TAB);
#pragma nounroll
    while (cur >= 0) {
        const int nxt = rem ? __builtin_ctzll(rem) : -1; if (rem) rem &= rem - 1ull;
        if (nxt >= 0) gload(nxt);
        const LAS unsigned char* Kb = lds + AT_K + buf * 9216; const LAS unsigned char* Vb = lds + AT_V + buf * 9216;
        f32x4 st[2][4];
        const bool far_tile = (BR == 1) && (cur * 64 + 63 + 790 <= qt * 64);
        const bool ok0 = (BR != 1) || ((selm[0] >> cur) & 1ull), ok1 = (BR != 1) || ((selm[1] >> cur) & 1ull);
        const float c31 = TABf[863 * 4 + cx.h];
        const float cb0 = ok0 ? c31 : -INFINITY, cb1 = ok1 ? c31 : -INFINITY;
        const int bs0 = ok0 ? ((BR == 0) ? (cx.tpos[0] + 33 - 16 * (cur * 64 + quad * 4)) : (cx.tpos[0] + 64 - cur * 64 - quad * 4)) : -(1 << 20);
        const int bs1 = ok1 ? ((BR == 0) ? (cx.tpos[1] + 33 - 16 * (cur * 64 + quad * 4)) : (cx.tpos[1] + 64 - cur * 64 - quad * 4)) : -(1 << 20);
        const LAS unsigned char* tb = lds + ((BR == 2) ? AT_TABW : AT_TAB) + cx.h * 4;
        constexpr int MAXI = (BR == 2) ? 576 : 863;
        const bool act0 = (BR != 1) || ((wact0 >> cur) & 1ull), act1 = (BR != 1) || ((wact1 >> cur) & 1ull);
        if (act0 || act1) {
#pragma unroll
        for (int ni = 0; ni < 4; ++ni) {
            const bf16x8 k0 = lds_ld8(Kb + (ni * 16 + l16) * 144 + quad * 16), k1 = lds_ld8(Kb + (ni * 16 + l16) * 144 + 64 + quad * 16);
            f32x4 a0, a1;
            if (far_tile) { a0 = (f32x4){cb0, cb0, cb0, cb0}; a1 = (f32x4){cb1, cb1, cb1, cb1}; }
            else {
                constexpr int CM = (BR == 0) ? 16 : 1;
                const int i00 = clampi(bs0 - CM * (ni * 16 + 0), 0, MAXI), i01 = clampi(bs0 - CM * (ni * 16 + 1), 0, MAXI), i02 = clampi(bs0 - CM * (ni * 16 + 2), 0, MAXI), i03 = clampi(bs0 - CM * (ni * 16 + 3), 0, MAXI);
                const int i10 = clampi(bs1 - CM * (ni * 16 + 0), 0, MAXI), i11 = clampi(bs1 - CM * (ni * 16 + 1), 0, MAXI), i12 = clampi(bs1 - CM * (ni * 16 + 2), 0, MAXI), i13 = clampi(bs1 - CM * (ni * 16 + 3), 0, MAXI);
                a0 = (f32x4){*(const LAS float*)(tb + i00 * 16), *(const LAS float*)(tb + i01 * 16), *(const LAS float*)(tb + i02 * 16), *(const LAS float*)(tb + i03 * 16)};
                a1 = (f32x4){*(const LAS float*)(tb + i10 * 16), *(const LAS float*)(tb + i11 * 16), *(const LAS float*)(tb + i12 * 16), *(const LAS float*)(tb + i13 * 16)};
            }
            if (act0) { a0 = MFMA16(k0, qf[0][0], a0); a0 = MFMA16(k1, qf[0][1], a0); } st[0][ni] = a0;
            if (act1) { a1 = MFMA16(k0, qf[1][0], a1); a1 = MFMA16(k1, qf[1][1], a1); } st[1][ni] = a1;
            __builtin_amdgcn_sched_barrier(0);
        }
        bf16x8 pb[2][2];
#pragma unroll
        for (int mi = 0; mi < 2; ++mi) {
            if (mi == 0 ? act0 : act1) {
                float ls = 0.f;
#pragma unroll
                for (int ni = 0; ni < 4; ++ni)
#pragma unroll
                    for (int j = 0; j < 4; ++j) { const float pv = __builtin_amdgcn_exp2f(st[mi][ni][j]); st[mi][ni][j] = pv; ls += pv; }
                l[mi] += ls;
                pb[mi][0] = pack8(st[mi][0], st[mi][1]); pb[mi][1] = pack8(st[mi][2], st[mi][3]);
            } else { pb[mi][0] = (bf16x8){0, 0, 0, 0, 0, 0, 0, 0}; pb[mi][1] = (bf16x8){0, 0, 0, 0, 0, 0, 0, 0}; }
        }
#pragma unroll
        for (int di = 0; di < 4; ++di)
#pragma unroll
            for (int s2 = 0; s2 < 2; ++s2) {
                const LAS unsigned char* vp = Vb + (di * 16 + l16) * 144 + s2 * 64 + quad * 8;
                const bf16x8 vf = lds_ld4x2(vp, vp + 32);
                if (act0) o[0][di] = MFMA16(vf, pb[0][s2], o[0][di]);
                if (act1) o[1][di] = MFMA16(vf, pb[1][s2], o[1][di]);
            }
        }
        if (nxt >= 0) lstore(buf ^ 1);
        __syncthreads();
        cur = nxt; buf ^= 1;
    }
#pragma unroll
    for (int mi = 0; mi < 2; ++mi) {
        float lt = l[mi]; lt += __shfl_xor(lt, 16); lt += __shfl_xor(lt, 32);
        const float il = lt > 0.f ? 1.0f / lt : 0.f;
        const float sc = il * gate[mi];
#pragma unroll
        for (int di = 0; di < 4; ++di) of[mi][di] = of[mi][di] + o[mi][di] * sc;
        m_out[mi] = 0.f; il_out[mi] = il;
    }
    (void)TAB;
}

__device__ __forceinline__ void attn_cmp_probs(const AttnCtx& cx, const bf16x8 (&qf)[2][2], const float (&mrow)[2], const float (&ilrow)[2], int ntile, LAS unsigned char* lds) {
    const int tid = tid_opaque(), lane = tid & 63, wave = tid >> 6, l16 = lane & 15, quad = lane >> 4;
    const int srow = tid >> 3, sch = tid & 7;
    const LAS float* TABf = (const LAS float*)(lds + AT_TAB);
    LAS float* PS = (LAS float*)(lds + AT_PS);
#pragma nounroll
    for (int jt = 0; jt < ntile; ++jt) {
        const u32x4 kr = *(const u32x4*)(cx.ksrc + (size_t)(jt * 64 + srow) * cx.ldk + sch * 8);
        __syncthreads();
        *(LAS u32x4*)(lds + AT_K + srow * 144 + sch * 16) = kr;
        __syncthreads();
        const LAS unsigned char* Kb = lds + AT_K;
#pragma unroll
        for (int ni = 0; ni < 4; ++ni) {
            const bf16x8 k0 = lds_ld8(Kb + (ni * 16 + l16) * 144 + quad * 16), k1 = lds_ld8(Kb + (ni * 16 + l16) * 144 + 64 + quad * 16);
#pragma unroll
            for (int mi = 0; mi < 2; ++mi) {
                f32x4 a = (f32x4){0.f, 0.f, 0.f, 0.f}; a = MFMA16(k0, qf[mi][0], a); a = MFMA16(k1, qf[mi][1], a);
                const int tp = cx.tpos[mi];
                f32x4 pr;
#pragma unroll
                for (int j = 0; j < 4; ++j) {
                    const int kidx = jt * 64 + ni * 16 + quad * 4 + j;
                    int idx = tp + 33 - 16 * kidx; idx = idx < 0 ? 0 : (idx > 863 ? 863 : idx);
                    float pv = __builtin_amdgcn_exp2f(a[j] + TABf[idx * 4 + cx.h] - mrow[mi]) * ilrow[mi];
                    pv += __builtin_bit_cast(float, __builtin_amdgcn_update_dpp(0, __builtin_bit_cast(int, pv), 0xB1, 0xF, 0xF, true));
                    pv += __builtin_bit_cast(float, __builtin_amdgcn_update_dpp(0, __builtin_bit_cast(int, pv), 0x4E, 0xF, 0xF, true));
                    pr[j] = pv;
                }
                if ((l16 & 3) == 0) *(LAS f32x4*)(PS + (wave * 8 + mi * 4 + (l16 >> 2)) * 256 + jt * 64 + ni * 16 + quad * 4) = pr;
            }
        }
    }
    __syncthreads();
}

__device__ __forceinline__ void attn_unit(const Params& p, int layer, int b, int g, int qt, LAS unsigned char* lds) {
    unsigned char* ws = p.ws;
    const int tid = tid_opaque(), lane = tid & 63, wave = tid >> 6, l16 = lane & 15, quad = lane >> 4;
    const int t0 = qt * 64;
    __syncthreads();
    {
        const f32x4* TABG = (const f32x4*)(ws + WS_CBIAS) + g * 864;
        LAS f32x4* TABw = (LAS f32x4*)(lds + AT_TAB); LAS f32x4* TABW2 = (LAS f32x4*)(lds + AT_TABW);
        const f32x4 ninf = (f32x4){-INFINITY, -INFINITY, -INFINITY, -INFINITY};
#pragma unroll
        for (int k = 0; k < 2; ++k) {
            const int i = tid + k * 512;
            if (i < 864) { const f32x4 v = TABG[i]; TABw[i] = v; if (i < 577) TABW2[i] = (i < 576) ? v : ninf; }
        }
    }
    AttnCtx cx; cx.h = l16 & 3;
    bf16x8 qf[2][2]; float gates[3][2];
    bf16_t* nq = (bf16_t*)(ws + WS_NQ);
    const bf16_t* ng = (const bf16_t*)(ws + WS_NG);
    const float* qgain = p.qk_gain + (layer * 4 + 0) * 64;
#pragma unroll
    for (int mi = 0; mi < 2; ++mi) {
        const int tl = wave * 8 + mi * 4 + (l16 >> 2); const int tp = t0 + tl; cx.tpos[mi] = tp;
        const size_t row = (size_t)b * SEQ + tp;
        const bf16_t* qp = nq + row * 512 + g * 256 + cx.h * 64 + quad * 8;
        const u32x4 q0 = *(const u32x4*)qp, q1 = *(const u32x4*)(qp + 32);
        float f[16];
        f[0] = bf_lo(q0.x); f[1] = bf_hi(q0.x); f[2] = bf_lo(q0.y); f[3] = bf_hi(q0.y); f[4] = bf_lo(q0.z); f[5] = bf_hi(q0.z); f[6] = bf_lo(q0.w); f[7] = bf_hi(q0.w);
        f[8] = bf_lo(q1.x); f[9] = bf_hi(q1.x); f[10] = bf_lo(q1.y); f[11] = bf_hi(q1.y); f[12] = bf_lo(q1.z); f[13] = bf_hi(q1.z); f[14] = bf_lo(q1.w); f[15] = bf_hi(q1.w);
        float s = 0.f;
#pragma unroll
        for (int e = 0; e < 16; ++e) s += f[e] * f[e];
        s += __shfl_xor(s, 16); s += __shfl_xor(s, 32);
        const float rstd = rsqrtf(s * (1.0f / 64.0f) + 1e-6f) * (0.125f * 1.4426950408889634f);
#pragma unroll
        for (int e = 0; e < 8; ++e) { f[e] = f[e] * rstd * qgain[quad * 8 + e]; f[8 + e] = f[8 + e] * rstd * qgain[32 + quad * 8 + e]; }
        u32x4 w0, w1;
        w0.x = cvt_pk_bf16(f[0], f[1]); w0.y = cvt_pk_bf16(f[2], f[3]); w0.z = cvt_pk_bf16(f[4], f[5]); w0.w = cvt_pk_bf16(f[6], f[7]);
        w1.x = cvt_pk_bf16(f[8], f[9]); w1.y = cvt_pk_bf16(f[10], f[11]); w1.z = cvt_pk_bf16(f[12], f[13]); w1.w = cvt_pk_bf16(f[14], f[15]);
        qf[mi][0] = __builtin_bit_cast(bf16x8, w0); qf[mi][1] = __builtin_bit_cast(bf16x8, w1);
#pragma unroll
        for (int br = 0; br < 3; ++br) gates[br][mi] = bfu(ng[row * 256 + g * 12 + cx.h * 3 + br]);
    }
    __syncthreads();
    f32x4 of[2][4];
#pragma unroll
    for (int mi = 0; mi < 2; ++mi)
#pragma unroll
        for (int di = 0; di < 4; ++di) of[mi][di] = (f32x4){0.f, 0.f, 0.f, 0.f};
    const unsigned long long nomask[2] = {0ull, 0ull};
    float mrow[2], ilrow[2];
    cx.ksrc = (const bf16_t*)(ws + WS_KCMP) + (size_t)(b * 2 + g) * 256 * 64; cx.ldk = 64;
    cx.vsrc = (const bf16_t*)(ws + WS_VCMPT) + (size_t)(b * 2 + g) * 64 * 256; cx.ldv = 256; cx.kgain = nullptr;
    { const float gt[2] = {gates[0][0], gates[0][1]}; attn_branch<0>(cx, qf, qt, 0ull, nomask, ~0ull, ~0ull, of, gt, lds, mrow, ilrow); }
    const int ncmp = ((qt * 64 + 32) >> 10) + 1;
    attn_cmp_probs(cx, qf, mrow, ilrow, ncmp, lds);
    {
        const LAS float* PS = (const LAS float*)(lds + AT_PS);
        LAS unsigned long long* MK = (LAS unsigned long long*)(lds + AT_MASK);
        for (int ti = 0; ti < 8; ++ti) {
            const int tl = wave * 8 + ti, tp = t0 + tl, jcur = tp >> 6, j = lane;
            float imp = 0.f;
#pragma unroll
            for (int e = -1; e < 4; ++e) { const int c = 4 * j + e; if (c >= 0 && c < 255 && c < ncmp * 64) imp += PS[tl * 256 + c]; }
            const bool forced = (j == 0) || (j == jcur) || (j == jcur - 1);
            imp = (64 * j <= tp) ? (imp + (forced ? 1000.0f : 0.f)) : -1.0f;
            const unsigned key = (imp < 0.f) ? 0u : (__float_as_uint(imp) + 1u);
            unsigned T = 0u;
#pragma unroll
            for (int bit = 31; bit >= 0; --bit) {
                const unsigned cand = T | (1u << bit);
                if (__builtin_popcountll(__ballot(key >= cand)) >= 8) T = cand;
            }
            unsigned long long mk = __ballot(key > T);
            unsigned long long eq = __ballot(key == T);
            int need = 8 - __builtin_popcountll(mk);
            while (need > 0 && eq) { const unsigned long long lo = eq & (0ull - eq); mk |= lo; eq ^= lo; --need; }
            if (lane == 0) MK[tl] = mk;
        }
    }
    __syncthreads();
    unsigned long long selu = 0ull, selm[2];
    {
        const LAS unsigned long long* MK = (const LAS unsigned long long*)(lds + AT_MASK);
#pragma unroll 4
        for (int i = 0; i < 64; ++i) selu |= MK[i];
        selm[0] = MK[wave * 8 + (l16 >> 2)]; selm[1] = MK[wave * 8 + 4 + (l16 >> 2)];
    }
    unsigned long long wact0, wact1;
    {
        const LAS unsigned long long* MK = (const LAS unsigned long long*)(lds + AT_MASK);
        const unsigned long long a = (MK[wave * 8 + 0] | MK[wave * 8 + 1]) | (MK[wave * 8 + 2] | MK[wave * 8 + 3]), b2 = (MK[wave * 8 + 4] | MK[wave * 8 + 5]) | (MK[wave * 8 + 6] | MK[wave * 8 + 7]);
        wact0 = ((unsigned long long)(unsigned)__builtin_amdgcn_readfirstlane((int)(a >> 32)) << 32) | (unsigned)__builtin_amdgcn_readfirstlane((int)a);
        wact1 = ((unsigned long long)(unsigned)__builtin_amdgcn_readfirstlane((int)(b2 >> 32)) << 32) | (unsigned)__builtin_amdgcn_readfirstlane((int)b2);
    }
    float md[2], ild[2];
    cx.ksrc = (const bf16_t*)(ws + WS_KV) + (size_t)b * SEQ * 768 + 256 + g * 64; cx.ldk = 768;
    cx.vsrc = (const bf16_t*)(ws + WS_VST) + (size_t)(b * 2 + g) * 64 * 4096; cx.ldv = 4096; cx.kgain = p.qk_gain + (layer * 4 + 2) * 64;
    { const float gt[2] = {gates[1][0], gates[1][1]}; attn_branch<1>(cx, qf, qt, selu, selm, wact0, wact1, of, gt, lds, md, ild); }
    cx.ksrc = (const bf16_t*)(ws + WS_KV) + (size_t)b * SEQ * 768 + 512 + g * 64; cx.ldk = 768;
    cx.vsrc = (const bf16_t*)(ws + WS_VWT) + (size_t)(b * 2 + g) * 64 * 4096; cx.ldv = 4096; cx.kgain = p.qk_gain + (layer * 4 + 3) * 64;
    { const float gt[2] = {gates[2][0], gates[2][1]}; attn_branch<2>(cx, qf, qt, 0ull, nomask, ~0ull, ~0ull, of, gt, lds, md, ild); }
#pragma unroll
    for (int mi = 0; mi < 2; ++mi) {
        bf16_t* op = nq + ((size_t)b * SEQ + cx.tpos[mi]) * 512 + g * 256 + cx.h * 64 + quad * 4;
#pragma unroll
        for (int di = 0; di < 4; ++di) { u32x2 w; w.x = cvt_pk_bf16(of[mi][di][0], of[mi][di][1]); w.y = cvt_pk_bf16(of[mi][di][2], of[mi][di][3]); *(u32x2*)(op + di * 16) = w; }
    }
}

#define XB_TMO      128
#define XB_XCNT(j)  (256  + 64 * (j))
#define XB_XSUB(j)  (1280 + 64 * (j))
#define XB_XGEN(j)  (2304 + 64 * (j))
#define XB_TOP      3328
#define XB_TOPGEN   3392
#define XCD_BAR_WORDS 3456
#define XB_SPIN_CAP (1u << 18)

__device__ __forceinline__ unsigned xb_ld(unsigned* p)              { return __hip_atomic_load(p, __ATOMIC_RELAXED, __HIP_MEMORY_SCOPE_AGENT); }
__device__ __forceinline__ unsigned xb_add(unsigned* p, unsigned v) { return __hip_atomic_fetch_add(p, v, __ATOMIC_RELAXED, __HIP_MEMORY_SCOPE_AGENT); }
__device__ __forceinline__ unsigned xb_xcc_id() { return (unsigned)__builtin_amdgcn_s_getreg((3 << 11) | 20) & 0xFu; }
#define XB_SPIN(cond, bar) do { unsigned _sp = 0; while (cond) { __builtin_amdgcn_s_sleep(1); \
    if ((++_sp & 255u) == 0u) { if (xb_ld(&(bar)[XB_TMO])) break; if (_sp > XB_SPIN_CAP) { atomicAdd(&(bar)[XB_TMO], 1u); break; } } } } while (0)

struct XcdBarrier {
    unsigned* bar; unsigned x;
    volatile LAS unsigned* st;
};

__device__ __forceinline__ XcdBarrier xcd_barrier_post(unsigned* bar, volatile LAS unsigned* st) {
    XcdBarrier b; b.bar = bar; b.x = xb_xcc_id(); b.st = st;
    if (threadIdx.x == 0) (void)xb_add(&bar[XB_XCNT(b.x)], 1u);
    return b;
}
__device__ __forceinline__ void xcd_barrier_complete(unsigned* bar, unsigned x, unsigned& nloc, unsigned& nx) {
    const unsigned G = gridDim.x * gridDim.y * gridDim.z;
    unsigned sum, cnt, mine, sp = 0u;
    for (;;) {
        sum = 0u; cnt = 0u; mine = 0u;
#pragma unroll
        for (unsigned j = 0; j < 16; ++j) { const unsigned c = xb_ld(&bar[XB_XCNT(j)]); sum += c; cnt += (c > 0u) ? 1u : 0u; mine = (j == x) ? c : mine; }
        if (sum == G) break;
        __builtin_amdgcn_s_sleep(1);
        if ((++sp & 255u) == 0u) { if (xb_ld(&bar[XB_TMO])) break; if (sp > XB_SPIN_CAP) { atomicAdd(&bar[XB_TMO], 1u); break; } }
    }
    nloc = mine > 0u ? mine : 1u; nx = cnt > 0u ? cnt : 1u;
}

__device__ __forceinline__ void xcd_barrier(const XcdBarrier& b) {
    asm volatile("s_waitcnt vmcnt(0)" ::: "memory");
    __syncthreads();
    if (tid_opaque() == 0) {
        unsigned* bar = b.bar;
        __builtin_amdgcn_s_waitcnt(0);
        unsigned nloc = b.st[0], nx = b.st[1];
        if (nloc == 0u) { xcd_barrier_complete(bar, b.x, nloc, nx); b.st[0] = nloc; b.st[1] = nx; }
        const unsigned old = xb_add(&bar[XB_XSUB(b.x)], 1u);
        const unsigned gen = old / nloc;
        if (old + 1u == (gen + 1u) * nloc) {
            __builtin_amdgcn_fence(__ATOMIC_RELEASE, "agent");
            asm volatile("s_waitcnt vmcnt(0)" ::: "memory");
            const unsigned og = xb_add(&bar[XB_TOP], 1u);
            const unsigned tg = og / nx;
            if (og + 1u == (tg + 1u) * nx) xb_add(&bar[XB_TOPGEN], 1u);
            else XB_SPIN(xb_ld(&bar[XB_TOPGEN]) == tg, bar);
            __builtin_amdgcn_fence(__ATOMIC_ACQUIRE, "agent");
            xb_add(&bar[XB_XGEN(b.x)], 1u);
            asm volatile("s_waitcnt vmcnt(0)" ::: "memory");
        } else {
            XB_SPIN(xb_ld(&bar[XB_XGEN(b.x)]) == gen, bar);
            __builtin_amdgcn_fence(__ATOMIC_ACQUIRE, "agent");
            asm volatile("s_waitcnt vmcnt(0)" ::: "memory");
        }
    }
    __syncthreads();
}


#ifndef ST_MASK
#define ST_MASK 0xff
#endif
#define ST_ON(k) ((ST_MASK >> (k)) & 1)
__global__ void __launch_bounds__(512, 2) fwd_kernel(Params pin) {
    extern __shared__ __attribute__((aligned(16))) unsigned char lds_raw[];
    LAS unsigned char* lds = (LAS unsigned char*)lds_raw;
    cg::grid_group grid = cg::this_grid();
    volatile LAS unsigned* bar_st = (volatile LAS unsigned*)(lds + 140000);
    if (threadIdx.x == 0) { bar_st[0] = 0u; bar_st[1] = 0u; }
    __syncthreads();
    const XcdBarrier xbar = xcd_barrier_post((unsigned*)pin.ws, bar_st);
    const int G = gridDim.x;
    for (int ph = pin.ph_lo; ph < pin.ph_hi; ++ph) {
        Params p = pin;
        asm volatile("" : "+s"(p.x), "+s"(p.rel_bias), "+s"(p.lb_logits), "+s"(p.norm_mix), "+s"(p.w_in), "+s"(p.hg_gain), "+s"(p.qk_gain));
        asm volatile("" : "+s"(p.cmp_pos), "+s"(p.cmp_w1), "+s"(p.cmp_b1), "+s"(p.cmp_w2), "+s"(p.w_a), "+s"(p.w_b), "+s"(p.w_out));
        asm volatile("" : "+s"(p.norm_mlp), "+s"(p.w_up), "+s"(p.w_down), "+s"(p.out), "+s"(p.ws));
        unsigned char* ws = p.ws;
        const int bx = bid_opaque();

#ifndef NO_PRO
        if (ph == 0) { prologue(p, lds);
#ifdef DUP_MISC
            __syncthreads(); prologue(p, lds);
#endif
#ifdef DIAG_S00
            if (bx == 0 && threadIdx.x == 0) *(unsigned*)(ws + 512) = 0x7f000000u;
#endif
        }
#else
        if (ph == 0) {}
#endif

#ifdef DIAG_S00
        else if (ph == 15) { if (bx == 0 && threadIdx.x == 0) { const float v = __uint_as_float(__hip_atomic_load((unsigned*)(ws + 512), __ATOMIC_RELAXED, __HIP_MEMORY_SCOPE_AGENT)); p.out[0] += 1000.0f * v + 5.0f; } }
#endif
        else {
            const int layer = (ph - 1) / 7, st = (ph - 1) % 7;
            float* sumsq = (float*)(ws + WS_SUMSQ);
            bf16_t* xb = (bf16_t*)(ws + WS_XB);
            if (st == 0 && ST_ON(0)) {
                pg8::Gemm g{xb, (const bf16_t*)(ws + WS_WIN) + (size_t)layer * NP_IN * DM, T_TOK, NP_IN, DM}; pg8::StaticOrder S; S.init(T_TOK, NP_IN, G, bx);
                pg8::EpiIn E{sumsq, (bf16_t*)(ws + WS_HQ), (bf16_t*)(ws + WS_NQ), (bf16_t*)(ws + WS_KV), (bf16_t*)(ws + WS_NG), (bf16_t*)(ws + WS_SGA), (bf16_t*)(ws + WS_VST), (bf16_t*)(ws + WS_VWT)};
                pg8::gemm_phase<pg8::EpiIn, pg8::StaticOrder, true, true>(lds, g, S, E);
#ifdef DUP_G1
                __syncthreads(); pg8::gemm_phase<pg8::EpiIn, pg8::StaticOrder, true, true>(lds, g, S, E);
#endif
                if (layer == 0) {
                    __syncthreads();
                    const float* EH = (const float*)(ws + WS_EX + EX_H);
                    exact_stage(p.w_in, p.w_in, 99, DM, IN_COLS, (float*)(ws + WS_EX + EX_PP), [=](int r, int k) { return EH[r * 1024 + k]; }, lds);
                }
            } else if (st == 1 && ST_ON(1)) {
                {
                    const int x = bx & 7, i = bx >> 3;
                    const int unit = ((x * 8 + (i >> 2)) << 2) | (i & 3);

#ifndef NO_HGRN
                    if (bx < 256) hgrn_unit(p, layer, unit, lds);
#ifdef DUP_HGRN
                    if (bx < 256) hgrn_unit(p, layer, unit, lds);
#endif
#endif

                }

#ifndef NO_CMP
                for (int u = bx; u < 256; u += G) cmp_unit(p, layer, u, lds);
#ifdef DUP_MISC
                for (int u = bx; u < 256; u += G) cmp_unit(p, layer, u, lds);
#endif
#endif
                if (layer == 0 && bx < 16) exact_mixers(p, bx, lds);

            } else if (st == 2 && ST_ON(2)) {
                hgrn_finalize(p, layer);
#ifdef DUP_MISC
                hgrn_finalize(p, layer);
#endif
                {
                    const int x = bx & 7, i = bx >> 3;
#ifdef DUP_ATTN
                    for (int r2 = 0; r2 < 16; ++r2) { const int r = r2 & 7;
#else
                    for (int r = 0; r < 8; ++r) {
#endif
                        const int pair = x * 4 + (r >> 1);
                        const int qt = (r & 1) ? (63 - i) : i;

#ifndef NO_ATTN
                        attn_unit(p, layer, pair >> 1, pair & 1, qt, lds);
#endif

                    }
                }
                if (layer == 0) {
                    __syncthreads();
                    const float* OAB = (const float*)(ws + WS_EX + EX_OAB);
                    exact_stage(p.w_a, p.w_b, 2, 1024, DM, (float*)(ws + WS_EX + EX_YP), [=](int r, int k) { return OAB[r * 1024 + k]; }, lds);
                }
            } else if (st == 3 && ST_ON(3)) {
                {
                    pg8::Gemm g{(const bf16_t*)(ws + WS_HI), (const bf16_t*)(ws + WS_WA) + (size_t)layer * DM * 512, T_TOK, DM, 512}; pg8::StaticOrder S; S.init(T_TOK, DM, G, bx);
                    pg8::EpiMix<false> E{(const bf16_t*)(ws + WS_SGA), (bf16_t*)(ws + WS_MIXED)};
                    pg8::gemm_phase<pg8::EpiMix<false>, pg8::StaticOrder, true, true>(lds, g, S, E);
                }
                __syncthreads();
                {
                    pg8::Gemm g{(const bf16_t*)(ws + WS_NQ), (const bf16_t*)(ws + WS_WB) + (size_t)layer * DM * 512, T_TOK, DM, 512}; pg8::StaticOrder S; S.init(T_TOK, DM, G, bx);
                    pg8::EpiMix<true> E{(const bf16_t*)(ws + WS_SGB), (bf16_t*)(ws + WS_MIXED)};
                    pg8::gemm_phase<pg8::EpiMix<true>, pg8::StaticOrder, true, true>(lds, g, S, E);
                }
                if (layer == 0) {
                    __syncthreads();
                    const float* PP = (const float*)(ws + WS_EX + EX_PP); const float* YP = (const float*)(ws + WS_EX + EX_YP);
                    exact_stage(p.w_out, p.w_out, 99, DM, DM, (float*)(ws + WS_EX + EX_XP), [=](int r, int k) {
                        const float ga = ex_pp(PP, r, 3352 + k), gb = ex_pp(PP, r, 4376 + k);
                        const float ya = YP[(size_t)r * 1024 + k] + YP[(size_t)(16 + r) * 1024 + k], yb = YP[(size_t)(32 + r) * 1024 + k] + YP[(size_t)(48 + r) * 1024 + k];
                        return ya / (1.0f + __expf(-ga)) + yb / (1.0f + __expf(-gb)); }, lds);
                }
            } else if ((st == 4 || st == 6) && ST_ON(4)) {
                const bool down = (st == 6);
                pg8::Gemm g{down ? (const bf16_t*)(ws + WS_HID) : (const bf16_t*)(ws + WS_MIXED),
                            down ? (const bf16_t*)(ws + WS_WDN) + (size_t)layer * DM * DFF : (const bf16_t*)(ws + WS_WO) + (size_t)layer * DM * DM, T_TOK, DM, down ? DFF : DM};
                pg8::StaticOrder S; S.init(T_TOK, DM, G, bx);
                pg8::EpiRes E{p.out, xb, sumsq, down && layer == 1};
                pg8::gemm_phase<pg8::EpiRes, pg8::StaticOrder, true, true>(lds, g, S, E);
                if (layer == 0 && !down) {
                    __syncthreads();
                    LAS float* RS = (LAS float*)(lds + 16384); LAS float* red = (LAS float*)(lds + 32768);
                    const int tid2 = threadIdx.x;
#pragma unroll 1
                    for (int r = 0; r < ((bx < 32) ? 16 : 0); ++r) {
                        const float a = ex_x1(p, r, tid2), b2 = ex_x1(p, r, 512 + tid2);
                        const float ss = block_sum(a * a + b2 * b2, red, tid2);
                        if (tid2 == 0) RS[r] = rsqrtf(ss * (1.0f / 1024.0f) + 1e-6f);
                    }
                    __syncthreads();
                    const Params pc = p; const float* nm2 = p.norm_mlp;
                    exact_stage(p.w_up, p.w_up, 99, DM, DFF, (float*)(ws + WS_EX + EX_UP), [=](int r, int k) { return ex_x1(pc, r, k) * RS[r] * nm2[k]; }, lds);
                }
            } else if (st == 5 && ST_ON(5)) {
                pg8::Gemm g{xb, (const bf16_t*)(ws + WS_WUP) + (size_t)layer * DFF * DM, T_TOK, DFF, DM}; pg8::StaticOrder S; S.init(T_TOK, DFF, G, bx);
                pg8::EpiUp E{sumsq, (bf16_t*)(ws + WS_HID)};
                pg8::gemm_phase<pg8::EpiUp, pg8::StaticOrder, true, true>(lds, g, S, E);
#ifdef DUP_G4
                __syncthreads(); pg8::gemm_phase<pg8::EpiUp, pg8::StaticOrder, true, true>(lds, g, S, E);
#endif
                if (layer == 0) {
                    __syncthreads();
                    const float* UP = (const float*)(ws + WS_EX + EX_UP);
                    exact_stage(p.w_down, p.w_down, 99, DFF, DM, (float*)(ws + WS_EX + EX_DP), [=](int r, int k) {
                        const float u = (UP[(size_t)r * DFF + k] + UP[(size_t)(16 + r) * DFF + k]) + (UP[(size_t)(32 + r) * DFF + k] + UP[(size_t)(48 + r) * DFF + k]);
                        const float t = fmaxf(u, 0.f); return t * t; }, lds);
                }
            }
        }
        if (ph + 1 < pin.ph_hi) {
            if (ph == pin.ph_lo) {
                asm volatile("s_waitcnt vmcnt(0) lgkmcnt(0)" ::: "memory");
                grid.sync();
                __builtin_amdgcn_fence(__ATOMIC_ACQUIRE, "agent");
                asm volatile("s_waitcnt vmcnt(0)" ::: "memory");
            } else {
                xcd_barrier(xbar);
#ifdef DUP_SYNC
                xcd_barrier(xbar); xcd_barrier(xbar);
#endif
            }
        }
    }
}

#ifdef DIAG_S00
constexpr int N_PHASES = 16;
#else
constexpr int N_PHASES = 15;
#endif
#ifndef ONE_LAUNCH
#define ONE_LAUNCH 1
#endif

extern "C" void kernel_launch(void* const* d_in, const int* in_sizes, int n_in, void* d_out, int out_size, void* d_ws, size_t ws_size, hipStream_t stream) {
    static int ready = 0;
    if (ready == 0) {
        if (n_in != 17 || out_size != T_TOK * DM || ws_size < WS_END) { fprintf(stderr, "kernel_launch: unexpected shapes: n_in %d out %d ws %zu (need %zu)\n", n_in, out_size, ws_size, (size_t)WS_END); ready = -1; return; }
        if (hipFuncSetAttribute((const void*)fwd_kernel, hipFuncAttributeMaxDynamicSharedMemorySize, LDS_BYTES) != hipSuccess) { fprintf(stderr, "kernel_launch: hipFuncSetAttribute failed\n"); ready = -1; return; }
        int per_cu = 0;
        if (hipOccupancyMaxActiveBlocksPerMultiprocessor(&per_cu, (const void*)fwd_kernel, 512, LDS_BYTES) != hipSuccess || per_cu < 1) fprintf(stderr, "kernel_launch: occupancy query says %d blocks per CU\n", per_cu);
        (void)hipGetLastError();
        ready = 1;
    }
    if (ready < 0) return;
    Params p{};
    p.x = (const float*)d_in[0]; p.rel_bias = (const float*)d_in[1]; p.lb_logits = (const float*)d_in[2]; p.norm_mix = (const float*)d_in[3]; p.w_in = (const float*)d_in[4];
    p.hg_gain = (const float*)d_in[5]; p.qk_gain = (const float*)d_in[6]; p.cmp_pos = (const float*)d_in[7]; p.cmp_w1 = (const float*)d_in[8]; p.cmp_b1 = (const float*)d_in[9];
    p.cmp_w2 = (const float*)d_in[10]; p.w_a = (const float*)d_in[11]; p.w_b = (const float*)d_in[12]; p.w_out = (const float*)d_in[13]; p.norm_mlp = (const float*)d_in[14];
    p.w_up = (const float*)d_in[15]; p.w_down = (const float*)d_in[16];
    p.out = (float*)d_out; p.ws = (unsigned char*)d_ws;
    if (hipMemsetAsync(d_ws, 0, 16384, stream) != hipSuccess) { fprintf(stderr, "kernel_launch: hipMemsetAsync failed\n"); return; }
#if ONE_LAUNCH
    p.ph_lo = 0; p.ph_hi = N_PHASES;
    void* args[] = {&p};
    hipError_t e = hipLaunchCooperativeKernel((const void*)fwd_kernel, dim3(256), dim3(512), args, LDS_BYTES, stream);
    if (e != hipSuccess) fprintf(stderr, "kernel_launch: cooperative launch failed: %s\n", hipGetErrorString(e));
#else
    for (int ph = 0; ph < N_PHASES; ++ph) {
        p.ph_lo = ph; p.ph_hi = ph + 1;
        hipLaunchKernelGGL(fwd_kernel, dim3(256), dim3(512), LDS_BYTES, stream, p);
    }
#endif
}
```
